# Optimizing an MI355X kernel written in HIP

```python
import jax, jax.numpy as jnp
from jax import lax
import numpy as np

D_MODEL = 2048
BATCH = 8
SEQ = 4096
DEPTH = 2

MEM_LEN = 256
N_MIXERS = 2
CHUNK = 64
EPS = 1e-6

XA_HEADS = 4
XA_WIDTH = D_MODEL // 4
XA_HEAD_DIM = XA_WIDTH // XA_HEADS
MIX_WIDTH = D_MODEL - XA_WIDTH

A_HEADS = 4
A_V_DIM = MIX_WIDTH // A_HEADS
A_QK_DIM = A_V_DIM // 2
A_CONV = 4

B_EXPAND = 128
B_HEADS = MIX_WIDTH // B_EXPAND
B_K_DIM = B_EXPAND
B_V_DIM = MIX_WIDTH // B_HEADS

D_FF = 5632
FFN_CONV = 3

N_A = (DEPTH + 1) // 2
N_B = DEPTH // 2
COLS_A = 2 * A_HEADS * A_QK_DIM + 2 * MIX_WIDTH + 2 * A_HEADS + XA_WIDTH
COLS_B = 2 * B_HEADS * B_K_DIM + 2 * MIX_WIDTH + XA_WIDTH

kernel_name = 'hybrid_mlstm_hgrn2_memxattn_convffn'


def rmsnorm(x, g):
    xf = x.astype(jnp.float32)
    y = xf * lax.rsqrt(jnp.mean(xf * xf, axis=-1, keepdims=True) + EPS)
    return (y * g.astype(jnp.float32)).astype(x.dtype)


def head_rmsnorm(o, g):
    o = o * lax.rsqrt(jnp.mean(o * o, axis=-1, keepdims=True) + EPS)
    b, s, h, d = o.shape
    return o.reshape(b, s, h * d) * g.astype(jnp.float32)


def causal_dwconv(x, w, b):
    width = w.shape[0]
    s = x.shape[1]
    xp = jnp.pad(x, ((0, 0), (width - 1, 0), (0, 0)))
    y = b
    for k in range(width):
        y = y + w[k] * xp[:, k:k + s]
    return y


def _to_chunks(t):
    b, s = t.shape[:2]
    t = t.reshape((b, s // CHUNK, CHUNK) + t.shape[2:])
    return jnp.swapaxes(jnp.moveaxis(t, 1, 0), 2, 3)


def _from_chunks(t):
    t = jnp.moveaxis(jnp.swapaxes(t, 2, 3), 0, 1)
    b, nc, l = t.shape[:3]
    return t.reshape((b, nc * l) + t.shape[3:])


def mlstm_chunkwise(q, k, v, ig, lf):
    b, s, h, dk = q.shape
    dv = v.shape[-1]
    causal = jnp.tril(jnp.ones((CHUNK, CHUNK), dtype=bool))

    def step(carry, xs):
        c_st, n_st, m_st = carry
        qc, kc, vc, ic, fc = xs
        g = jnp.cumsum(fc, axis=-1)
        a = g + m_st[..., None]
        dmat = g[..., :, None] - g[..., None, :] + ic[..., None, :]
        dmat = jnp.where(causal, dmat, -jnp.inf)
        m_row = jnp.maximum(a, jnp.max(dmat, axis=-1))
        w_inter = jnp.exp(a - m_row)
        sc = jnp.einsum('bhld,bhsd->bhls', qc, kc) * jnp.exp(dmat - m_row[..., None])
        num = (w_inter[..., None] * jnp.einsum('bhld,bhdv->bhlv', qc, c_st)
               + jnp.einsum('bhls,bhsv->bhlv', sc, vc))
        den = w_inter * jnp.einsum('bhld,bhd->bhl', qc, n_st) + jnp.sum(sc, axis=-1)
        out = num / jnp.maximum(jnp.abs(den), jnp.exp(-m_row))[..., None]
        a_end = g[..., -1] + m_st
        w_end = g[..., -1:] - g + ic
        m_new = jnp.maximum(a_end, jnp.max(w_end, axis=-1))
        decay = jnp.exp(a_end - m_new)
        ws = jnp.exp(w_end - m_new[..., None])
        c_new = decay[..., None, None] * c_st + jnp.einsum('bhl,bhld,bhlv->bhdv', ws, kc, vc)
        n_new = decay[..., None] * n_st + jnp.einsum('bhl,bhld->bhd', ws, kc)
        return (c_new, n_new, m_new), out

    init = (jnp.zeros((b, h, dk, dv), jnp.float32), jnp.zeros((b, h, dk), jnp.float32),
            jnp.zeros((b, h), jnp.float32))
    xs = (_to_chunks(q), _to_chunks(k), _to_chunks(v), _to_chunks(ig), _to_chunks(lf))
    _, out = lax.scan(step, init, xs)
    return _from_chunks(out)


def hgrn2_chunkwise(q, k, v, lf):
    b, s, h, dk = q.shape
    dv = v.shape[-1]
    causal = jnp.tril(jnp.ones((CHUNK, CHUNK), dtype=bool))

    def step(s_st, xs):
        qc, kc, vc, fc = xs
        gcum = jnp.cumsum(fc, axis=2)
        diff = gcum[:, :, :, None, :] - gcum[:, :, None, :, :]
        decay = jnp.exp(jnp.where(causal[..., None], diff, -jnp.inf))
        att = jnp.einsum('bhld,bhlsd,bhsd->bhls', qc, decay, kc)
        out = (jnp.einsum('bhld,bhdv->bhlv', qc * jnp.exp(gcum), s_st)
               + jnp.einsum('bhls,bhsv->bhlv', att, vc))
        g_end = gcum[:, :, -1]
        kd = kc * jnp.exp(g_end[:, :, None, :] - gcum)
        s_new = jnp.exp(g_end)[..., None] * s_st + jnp.einsum('bhld,bhlv->bhdv', kd, vc)
        return s_new, out

    init = jnp.zeros((b, h, dk, dv), jnp.float32)
    xs = (_to_chunks(q), _to_chunks(k), _to_chunks(v), _to_chunks(lf))
    _, out = lax.scan(step, init, xs)
    return _from_chunks(out)


def mem_cross_attention(qx, mem_n, w_kv):
    b, s, _ = qx.shape
    m = mem_n.shape[1]
    kv = mem_n @ w_kv
    km, vm = jnp.split(kv, 2, axis=-1)
    q = qx.reshape(b, s, XA_HEADS, XA_HEAD_DIM)
    km = km.reshape(b, m, XA_HEADS, XA_HEAD_DIM)
    vm = vm.reshape(b, m, XA_HEADS, XA_HEAD_DIM)
    sc = jnp.einsum('bshd,bmhd->bhsm', q, km).astype(jnp.float32) * (XA_HEAD_DIM ** -0.5)
    p = jax.nn.softmax(sc, axis=-1).astype(vm.dtype)
    return jnp.einsum('bhsm,bmhd->bshd', p, vm).reshape(b, s, XA_WIDTH)


def mlstm_layer_mixer(hn, mem_n, w_in, gate_b, conv_w, conv_b, head_g, w_kv, w_out):
    b, s, _ = hn.shape
    qk_w = A_HEADS * A_QK_DIM
    z = hn @ w_in
    qk, v, o_pre, gates, xq = jnp.split(
        z, [2 * qk_w, 2 * qk_w + MIX_WIDTH, 2 * qk_w + 2 * MIX_WIDTH,
            2 * qk_w + 2 * MIX_WIDTH + 2 * A_HEADS], axis=-1)
    qk = jax.nn.silu(causal_dwconv(qk, conv_w, conv_b))
    q, k = jnp.split(qk, 2, axis=-1)
    gates = gates.astype(jnp.float32) + gate_b.astype(jnp.float32)
    ig = gates[..., :A_HEADS]
    lf = jax.nn.log_sigmoid(gates[..., A_HEADS:])
    q = q.reshape(b, s, A_HEADS, A_QK_DIM).astype(jnp.float32)
    k = k.reshape(b, s, A_HEADS, A_QK_DIM).astype(jnp.float32) * (A_QK_DIM ** -0.5)
    v = v.reshape(b, s, A_HEADS, A_V_DIM).astype(jnp.float32)
    hh = head_rmsnorm(mlstm_chunkwise(q, k, v, ig, lf), head_g)
    y_mix = (jax.nn.sigmoid(o_pre.astype(jnp.float32)) * hh).astype(hn.dtype)
    y_mem = mem_cross_attention(xq, mem_n, w_kv)
    return jnp.concatenate([y_mix, y_mem], axis=-1) @ w_out


def hgrn2_layer_mixer(hn, mem_n, lb, w_in, head_g, w_kv, w_out):
    b, s, _ = hn.shape
    kw = B_HEADS * B_K_DIM
    z = hn @ w_in
    q, f, i, g, xq = jnp.split(z, [kw, 2 * kw, 2 * kw + MIX_WIDTH, 2 * kw + 2 * MIX_WIDTH], axis=-1)
    f = f.astype(jnp.float32)
    lf = jnp.logaddexp(jnp.log(lb), jnp.log1p(-lb) + jax.nn.log_sigmoid(f))
    kk = (1.0 - lb) * jax.nn.sigmoid(-f)
    q = jax.nn.silu(q.astype(jnp.float32)).reshape(b, s, B_HEADS, B_K_DIM)
    kk = kk.reshape(b, s, B_HEADS, B_K_DIM)
    lf = lf.reshape(b, s, B_HEADS, B_K_DIM)
    i = i.astype(jnp.float32).reshape(b, s, B_HEADS, B_V_DIM)
    o = head_rmsnorm(hgrn2_chunkwise(q, kk, i, lf), head_g)
    y_mix = (o * jax.nn.silu(g.astype(jnp.float32))).astype(hn.dtype)
    y_mem = mem_cross_attention(xq, mem_n, w_kv)
    return jnp.concatenate([y_mix, y_mem], axis=-1) @ w_out


def conv_ffn(hn, w_up, conv_w, conv_b, w_down):
    u, g = jnp.split(hn @ w_up, 2, axis=-1)
    g = causal_dwconv(g, conv_w, conv_b)
    return (jax.nn.silu(g) * u) @ w_down


def setup_inputs(seed: int = 0) -> dict:
    key = jax.random.key(seed)
    ks = jax.random.split(key, 24)
    f32 = jnp.float32

    def nrm(k, shape, scale):
        return jax.random.normal(k, shape, f32) * scale

    def gain(k, shape):
        return 1.0 + 0.02 * jax.random.normal(k, shape, f32)

    qk_w = A_HEADS * A_QK_DIM
    return {
        'x': nrm(ks[0], (BATCH, SEQ, D_MODEL), 1.0),
        'mem': nrm(ks[1], (BATCH, MEM_LEN, D_MODEL), 1.0),
        'norm_mix_g': gain(ks[2], (DEPTH, D_MODEL)),
        'norm_mem_g': gain(ks[3], (DEPTH, D_MODEL)),
        'norm_ffn_g': gain(ks[4], (DEPTH, D_MODEL)),
        'norm_out_g': gain(ks[5], (D_MODEL,)),
        'w_mem_kv': nrm(ks[6], (DEPTH, D_MODEL, 2 * XA_WIDTH), D_MODEL ** -0.5),
        'a_w_in': nrm(ks[7], (N_A, D_MODEL, COLS_A), D_MODEL ** -0.5),
        'a_gate_b': jnp.concatenate([nrm(ks[8], (N_A, A_HEADS), 0.1),
                                     3.0 + nrm(ks[9], (N_A, A_HEADS), 0.1)], axis=-1),
        'a_conv_w': nrm(ks[10], (N_A, A_CONV, 2 * qk_w), A_CONV ** -0.5),
        'a_conv_b': nrm(ks[11], (N_A, 2 * qk_w), 0.02),
        'a_head_g': gain(ks[12], (N_A, MIX_WIDTH)),
        'a_w_out': nrm(ks[13], (N_A, D_MODEL, D_MODEL), D_MODEL ** -0.5),
        'b_w_in': nrm(ks[14], (N_B, D_MODEL, COLS_B), D_MODEL ** -0.5),
        'b_lb_logits': nrm(ks[15], (DEPTH, B_HEADS * B_K_DIM), 0.1),
        'b_head_g': gain(ks[16], (N_B, MIX_WIDTH)),
        'b_w_out': nrm(ks[17], (N_B, D_MODEL, D_MODEL), D_MODEL ** -0.5),
        'ffn_w_up': nrm(ks[18], (DEPTH, D_MODEL, 2 * D_FF), D_MODEL ** -0.5),
        'ffn_conv_w': nrm(ks[19], (DEPTH, FFN_CONV, D_FF), FFN_CONV ** -0.5),
        'ffn_conv_b': nrm(ks[20], (DEPTH, D_FF), 0.02),
        'ffn_w_down': nrm(ks[21], (DEPTH, D_FF, D_MODEL), D_FF ** -0.5),
    }


def reference(x, mem, norm_mix_g, norm_mem_g, norm_ffn_g, norm_out_g, w_mem_kv,
              a_w_in, a_gate_b, a_conv_w, a_conv_b, a_head_g, a_w_out,
              b_w_in, b_lb_logits, b_head_g, b_w_out,
              ffn_w_up, ffn_conv_w, ffn_conv_b, ffn_w_down):
    lb_all = jnp.cumsum(jax.nn.softmax(b_lb_logits.astype(jnp.float32), axis=0), axis=0)
    lb_all = lb_all - lb_all[0]
    h = x
    for layer in range(DEPTH):
        hn = rmsnorm(h, norm_mix_g[layer])
        mem_n = rmsnorm(mem, norm_mem_g[layer])
        j = layer // N_MIXERS
        if layer % N_MIXERS == 0:
            y = mlstm_layer_mixer(hn, mem_n, a_w_in[j], a_gate_b[j], a_conv_w[j], a_conv_b[j],
                                  a_head_g[j], w_mem_kv[layer], a_w_out[j])
        else:
            y = hgrn2_layer_mixer(hn, mem_n, lb_all[layer], b_w_in[j], b_head_g[j],
                                  w_mem_kv[layer], b_w_out[j])
        h = h + y
        h = h + conv_ffn(rmsnorm(h, norm_ffn_g[layer]), ffn_w_up[layer], ffn_conv_w[layer],
                         ffn_conv_b[layer], ffn_w_down[layer])
    return rmsnorm(h, norm_out_g)
```

```cpp
#include <hip/hip_runtime.h>
#include <hip/hip_cooperative_groups.h>
#include <cstdio>
#include <cstdint>
namespace cg = cooperative_groups;
#ifndef PG8_KREV
#define PG8_KREV 1
#endif
namespace pg8 {
#define PG8_LAS __attribute__((address_space(3)))
typedef unsigned short bf16_t;
typedef short bf16x8 __attribute__((ext_vector_type(8)));
typedef float f32x4 __attribute__((ext_vector_type(4)));
typedef unsigned u32x4 __attribute__((ext_vector_type(4)));
constexpr int BM = 256, BK = 64, HALF = 128, HTB = HALF * BK * 2  , STAGE_BYTES = 8 * HTB, NXCD = 8, WGM = 8;

__host__ __device__ __forceinline__ int lds_byte(int r, int c) { const int st = (r >> 4) * 2 + (c >> 5), rr = r & 15, cc = c & 31, ob = rr * 64 + cc * 2; return st * 1024 + (ob ^ (((ob >> 9) & 1) << 5)); }
__host__ __device__ __forceinline__ void stage_rc(int b, int& R, int& C) { const int st = b / 1024, sb = b % 1024, swz = sb ^ (((sb >> 9) & 1) << 5); R = (st >> 1) * 16 + swz / 64; C = (st & 1) * 32 + (swz % 64) / 2; }
__host__ __device__ __forceinline__ int perm32(int rho) { const int n = rho >> 4, i = rho & 15; return 8 * (i >> 2) + 4 * n + (i & 3); }

struct Unit { int pm, pn; };
struct Gemm { const bf16_t* A; const bf16_t* Bt; int M, N, K; };

struct StaticOrder {
    int nM, nN, nwg, G, c;
    __host__ __device__ void init(int M, int N, int G_, int c_) { nM = M / BM; nN = N / BM; nwg = nM * nN; G = G_; c = c_; }
    __host__ __device__ bool next(int i, Unit& u) const {
        const long L = (long)i * G + c; if (L >= nwg) return false;
        int wgid = (int)L; { const int q = nwg / NXCD, r = nwg % NXCD, xcd = wgid % NXCD, off = wgid / NXCD; wgid = (xcd < r ? xcd * (q + 1) : r * (q + 1) + (xcd - r) * q) + off; }
        const int nig = WGM * nN, gid = wgid / nig, fm = gid * WGM, gsz = (nM - fm) < WGM ? (nM - fm) : WGM;
        u.pm = fm + ((wgid % nig) % gsz); u.pn = (wgid % nig) / gsz; return true;
    }
    __device__ __forceinline__ void a_ready(const Unit&) const {}
    __device__ __forceinline__ void done(const Unit&) const {}
};

__device__ __forceinline__ unsigned cvt_pk_bf16(float lo, float hi) { unsigned r; asm volatile("v_cvt_pk_bf16_f32 %0, %1, %2" : "=v"(r) : "v"(lo), "v"(hi)); return r; }
typedef unsigned u32x2 __attribute__((ext_vector_type(2)));

__device__ __forceinline__ float row_rstd(const float* ssq, int row, int fq) {
    const f32x4* p = (const f32x4*)(ssq + (size_t)row * 32 + fq * 8);
    const f32x4 a = p[0], b = p[1];
    float s = ((a[0] + a[1]) + (a[2] + a[3])) + ((b[0] + b[1]) + (b[2] + b[3]));
    s += __shfl_xor(s, 16); s += __shfl_xor(s, 32);
    return 1.0f / sqrtf(s * (1.0f / 2048.0f) + 1e-6f);
}

struct EpiScaleBf16 {
    static constexpr bool PERM = true, AFTER_DRAIN = false;
    bf16_t* O; int ldc; const float* ssq;
    __device__ __forceinline__ void operator()(f32x4 (&acc)[2][2][4][2], const Unit& u, int wr, int wc, int fr, int fq) const {
        asm volatile("" : "+v"(fr), "+v"(fq));
        const int row0 = u.pm * BM + wr * 64 + fr, col0 = u.pn * BM + wc * 32 + 8 * fq;
#pragma unroll
        for (int ai = 0; ai < 2; ++ai)
#pragma unroll
            for (int m = 0; m < 4; ++m) { const int row = row0 + ai * HALF + m * 16; const float rs = row_rstd(ssq, row, fq);
                bf16_t* rowp = O + (size_t)row * ldc + col0;
#pragma unroll
                for (int bj = 0; bj < 2; ++bj) { const f32x4 v0 = acc[ai][bj][m][0] * rs, v1 = acc[ai][bj][m][1] * rs;
                    u32x4 w; w.x = cvt_pk_bf16(v0[0], v0[1]); w.y = cvt_pk_bf16(v0[2], v0[3]); w.z = cvt_pk_bf16(v1[0], v1[1]); w.w = cvt_pk_bf16(v1[2], v1[3]);
                    *(u32x4*)(rowp + bj * HALF) = w; } }
    }
};

template <bool BF_BASE, bool W32, bool W16> struct EpiRes {
    static constexpr bool PERM = false, AFTER_DRAIN = false;
    const float* base32; const bf16_t* base16; float* out; bf16_t* hb; float* ssq;
    __device__ __forceinline__ void operator()(f32x4 (&acc)[2][2][4][2], const Unit& u, int wr, int wc, int fr, int fq) const {
        asm volatile("" : "+v"(fr), "+v"(fq));
        const int row0 = u.pm * BM + wr * 64 + fr, col0 = u.pn * BM + wc * 32 + 4 * fq;
#pragma unroll
        for (int ai = 0; ai < 2; ++ai) {
            f32x4 b[4][2][2];
#pragma unroll
            for (int m = 0; m < 4; ++m)
#pragma unroll
                for (int bj = 0; bj < 2; ++bj)
#pragma unroll
                    for (int n = 0; n < 2; ++n) { const size_t o2 = (size_t)(row0 + ai * HALF + m * 16) * 2048 + col0 + bj * HALF + n * 16;
                        if constexpr (BF_BASE) { const u32x2 w = *(const u32x2*)(base16 + o2); b[m][bj][n] = (f32x4){__builtin_bit_cast(float, w.x << 16), __builtin_bit_cast(float, w.x & 0xffff0000u), __builtin_bit_cast(float, w.y << 16), __builtin_bit_cast(float, w.y & 0xffff0000u)}; }
                        else b[m][bj][n] = *(const f32x4*)(base32 + o2); }
#pragma unroll
            for (int m = 0; m < 4; ++m) { const int row = row0 + ai * HALF + m * 16; const size_t off = (size_t)row * 2048 + col0; float ss = 0.f;
#pragma unroll
                for (int bj = 0; bj < 2; ++bj)
#pragma unroll
                    for (int n = 0; n < 2; ++n) { const size_t o2 = off + bj * HALF + n * 16; const f32x4 o = b[m][bj][n] + acc[ai][bj][m][n];
                        ss += (o[0] * o[0] + o[1] * o[1]) + (o[2] * o[2] + o[3] * o[3]);
                        if constexpr (W32) *(f32x4*)(out + o2) = o;
                        if constexpr (W16) { u32x2 w; w.x = cvt_pk_bf16(o[0], o[1]); w.y = cvt_pk_bf16(o[2], o[3]); *(u32x2*)(hb + o2) = w; } }
                ss += __shfl_xor(ss, 16); ss += __shfl_xor(ss, 32);
                if (fq == 0) ssq[(size_t)row * 32 + u.pn * 4 + wc] = ss; }
            asm volatile("" ::: "memory");
        }
    }
};

template <int N> __device__ __forceinline__ float dpp_ror(float v) { return __builtin_bit_cast(float, __builtin_amdgcn_update_dpp(0, __builtin_bit_cast(int, v), 0x120 + N, 0xf, 0xf, false)); }
struct EpiUp {
    static constexpr bool PERM = true, AFTER_DRAIN = false;
    bf16_t* act; bf16_t* side; const float* ssq; const float* cw; const float* cb;
    __device__ __forceinline__ void operator()(f32x4 (&acc)[2][2][4][2], const Unit& u, int wr, int wc, int fr, int fq) const {
        asm volatile("" : "+v"(fr), "+v"(fq));
        const int row0 = u.pm * BM + wr * 64 + fr, f0 = u.pn * HALF + wc * 32 + 8 * fq;
#pragma unroll
        for (int ai = 0; ai < 2; ++ai) {
#pragma unroll
            for (int m = 0; m < 4; ++m) { const float rs = row_rstd(ssq, row0 + ai * HALF + m * 16, fq);
#pragma unroll
                for (int n = 0; n < 2; ++n) { acc[ai][0][m][n] = acc[ai][0][m][n] * rs; acc[ai][1][m][n] = acc[ai][1][m][n] * rs; } }
            const int grp = (u.pm * BM + ai * HALF + wr * 64) >> 6;
            if (fr < 2) { const f32x4 ga = acc[ai][1][0][0], gb = acc[ai][1][0][1], ua = acc[ai][0][0][0], ub = acc[ai][0][0][1];
                u32x4 wg, wu; wg.x = cvt_pk_bf16(ga[0], ga[1]); wg.y = cvt_pk_bf16(ga[2], ga[3]); wg.z = cvt_pk_bf16(gb[0], gb[1]); wg.w = cvt_pk_bf16(gb[2], gb[3]);
                wu.x = cvt_pk_bf16(ua[0], ua[1]); wu.y = cvt_pk_bf16(ua[2], ua[3]); wu.z = cvt_pk_bf16(ub[0], ub[1]); wu.w = cvt_pk_bf16(ub[2], ub[3]);
                *(u32x4*)(side + ((size_t)grp * 6 + fr) * 5632 + f0) = wg; *(u32x4*)(side + ((size_t)grp * 6 + 2 + fr) * 5632 + f0) = wu; }
            if (fr >= 14) { const f32x4 ga = acc[ai][1][3][0], gb = acc[ai][1][3][1];
                u32x4 wg; wg.x = cvt_pk_bf16(ga[0], ga[1]); wg.y = cvt_pk_bf16(ga[2], ga[3]); wg.z = cvt_pk_bf16(gb[0], gb[1]); wg.w = cvt_pk_bf16(gb[2], gb[3]);
                *(u32x4*)(side + ((size_t)grp * 6 + 4 + (fr - 14)) * 5632 + f0) = wg; }
        }
#pragma unroll
        for (int n = 0; n < 2; ++n) {
            const f32x4 w0 = *(const f32x4*)(cw + f0 + 4 * n), w1 = *(const f32x4*)(cw + 5632 + f0 + 4 * n), w2 = *(const f32x4*)(cw + 2 * 5632 + f0 + 4 * n), bb = *(const f32x4*)(cb + f0 + 4 * n);
#pragma unroll
            for (int ai = 0; ai < 2; ++ai)
#pragma unroll
                for (int m = 0; m < 4; ++m)
#pragma unroll
                    for (int e = 0; e < 4; ++e) { const float g0 = acc[ai][1][m][n][e], gp = acc[ai][1][m > 0 ? m - 1 : 0][n][e];
                        const float p1 = dpp_ror<1>(fr == 15 ? gp : g0), p2 = dpp_ror<2>(fr >= 14 ? gp : g0);
                        const float c = bb[e] + w0[e] * p2 + w1[e] * p1 + w2[e] * g0;
                        acc[ai][0][m][n][e] = c * __builtin_amdgcn_rcpf(1.0f + __expf(-c)) * acc[ai][0][m][n][e]; }
        }
#pragma unroll
        for (int ai = 0; ai < 2; ++ai)
#pragma unroll
            for (int m = 0; m < 4; ++m) { const int row = row0 + ai * HALF + m * 16; const f32x4 oa = acc[ai][0][m][0], ob = acc[ai][0][m][1];
                u32x4 w; w.x = cvt_pk_bf16(oa[0], oa[1]); w.y = cvt_pk_bf16(oa[2], oa[3]); w.z = cvt_pk_bf16(ob[0], ob[1]); w.w = cvt_pk_bf16(ob[2], ob[3]);
                *(u32x4*)(act + (size_t)row * 5632 + f0) = w; }
    }
};

template <class Epi, class Sched, bool ALIGN_EPI = false, bool SP2 = false>
__device__ __forceinline__ void gemm_phase(PG8_LAS unsigned char* lds, const Gemm g, const Sched& S, const Epi& E) {
    const int tid = threadIdx.x, wid = __builtin_amdgcn_readfirstlane(tid >> 6), lane = tid & 63, wr = wid >> 2, wc = wid & 3, fr = lane & 15, fq = lane >> 4;
    const int K = g.K, nt = K / BK;
    unsigned voffA[2], voffB[2];
#pragma unroll
    for (int i = 0; i < 2; ++i) { int R, C; stage_rc(tid * 16 + i * 8192, R, C); const int Rb = Epi::PERM ? ((R & ~31) + perm32(R & 31)) : R;
        voffA[i] = (unsigned)(R * K + C) * 2u; voffB[i] = (unsigned)(Rb * K + C) * 2u; }
    const long kstep = (long)(BK * 2);
    const size_t hstep = (size_t)HALF * K * 2;
    const size_t tstep = 2 * hstep;
    const unsigned ldsw = (unsigned)wid * 1024u;
    const int aoff = lds_byte(wr * 64 + fr, fq * 8), boff = lds_byte(wc * 32 + fr, fq * 8);
#define PG8_SA(b, h) (((b) * 2 + (h)) * HTB)
#define PG8_SB(b, h) ((4 + (b) * 2 + (h)) * HTB)
#define PG8_STAGE(bufoff, gbase, voff) do { _Pragma("unroll") for (int _i = 0; _i < 2; ++_i) \
        __builtin_amdgcn_global_load_lds((const unsigned*)((const char*)(gbase) + (voff)[_i]), (PG8_LAS unsigned*)(lds + (bufoff) + ldsw + _i * 8192), 16, 0, 0); } while (0)
#define PG8_LDA(dst, b, h) do { _Pragma("unroll") for (int m = 0; m < 4; ++m) _Pragma("unroll") for (int k = 0; k < 2; ++k) dst[m][k] = *(const PG8_LAS bf16x8*)(lds + PG8_SA(b, h) + aoff + m * 2048 + k * 1024); } while (0)
#define PG8_LDB(dst, b, h) do { _Pragma("unroll") for (int n = 0; n < 2; ++n) _Pragma("unroll") for (int k = 0; k < 2; ++k) dst[n][k] = *(const PG8_LAS bf16x8*)(lds + PG8_SB(b, h) + boff + n * 2048 + k * 1024); } while (0)
#define PG8_MMA(ai, bj, At, Bt) do { __builtin_amdgcn_s_setprio(1); _Pragma("unroll") for (int m = 0; m < 4; ++m) _Pragma("unroll") for (int n = 0; n < 2; ++n) _Pragma("unroll") for (int k = 0; k < 2; ++k) \
        acc[ai][bj][m][n] = __builtin_amdgcn_mfma_f32_16x16x32_bf16(Bt[n][k], At[m][k], acc[ai][bj][m][n], 0, 0, 0); __builtin_amdgcn_s_setprio(0); } while (0)
#define PG8_WAIT_V(n) asm volatile("s_waitcnt vmcnt(" #n ")" ::: "memory")
#define PG8_WAIT_L(n) asm volatile("s_waitcnt lgkmcnt(" #n ")" ::: "memory")
#define PG8_BAR __builtin_amdgcn_s_barrier()
#define PG8_SCHED __builtin_amdgcn_sched_barrier(0)
    Unit cur, nxt; int ui = 0;
    if (!S.next(0, cur)) return;
    f32x4 acc[2][2][4][2];
#pragma unroll
    for (int a = 0; a < 2; ++a)
#pragma unroll
        for (int b = 0; b < 2; ++b)
#pragma unroll
            for (int m = 0; m < 4; ++m)
#pragma unroll
                for (int n = 0; n < 2; ++n) acc[a][b][m][n] = (f32x4){0.f, 0.f, 0.f, 0.f};
    bf16x8 At[4][2], B0[2][2], B1[2][2];
    const char* cA = (const char*)g.A + (size_t)cur.pm * tstep; const char* cB = (const char*)g.Bt + (size_t)cur.pn * tstep;
    long kcur = kstep;
    S.a_ready(cur);
    if constexpr (SP2) {
        PG8_STAGE(PG8_SB(0, 0), cB, voffB); PG8_STAGE(PG8_SB(0, 1), cB + hstep, voffB); PG8_STAGE(PG8_SA(0, 0), cA, voffA); PG8_STAGE(PG8_SA(0, 1), cA + hstep, voffA);
        if (wr == 1) PG8_BAR;
        PG8_WAIT_V(2); PG8_BAR;
        PG8_STAGE(PG8_SB(1, 0), cB + kcur, voffB); PG8_STAGE(PG8_SA(1, 0), cA + kcur, voffA); PG8_STAGE(PG8_SB(1, 1), cB + hstep + kcur, voffB);
        PG8_WAIT_V(6); PG8_BAR;
    } else {
        PG8_STAGE(PG8_SB(0, 0), cB, voffB); PG8_STAGE(PG8_SA(0, 0), cA, voffA); PG8_STAGE(PG8_SB(0, 1), cB + hstep, voffB); PG8_STAGE(PG8_SA(0, 1), cA + hstep, voffA);
        if (wr == 1) PG8_BAR;
        PG8_WAIT_V(4); PG8_BAR;
        PG8_STAGE(PG8_SB(1, 0), cB + kcur, voffB); PG8_STAGE(PG8_SA(1, 0), cA + kcur, voffA); PG8_STAGE(PG8_SB(1, 1), cB + hstep + kcur, voffB);
        PG8_WAIT_V(6); PG8_BAR;
    }
    for (;;) {
        const bool has_next = S.next(ui + 1, nxt);
        const bool nrev = PG8_KREV && has_next && (((ui + 1) & 1) != 0); const long knxt = has_next ? (nrev ? -kstep : kstep) : kcur; const long noff = nrev ? (long)(nt - 1) * kstep : 0;
        const char* nA = has_next ? (const char*)g.A + (size_t)nxt.pm * tstep + noff : cA; const char* nB = has_next ? (const char*)g.Bt + (size_t)nxt.pn * tstep + noff : cB;
        for (int t = 0; t < nt; t += 2) {
            const bool last = (t == nt - 2);
            const char* a1 = cA + (long)(t + 1) * kcur;
            const char* a2 = last ? nA : cA + (long)(t + 2) * kcur; const char* b2 = last ? nB : cB + (long)(t + 2) * kcur;
            const long k3 = last ? knxt : kcur; const char* a3 = a2 + k3; const char* b3 = b2 + k3;
            if (last && has_next) S.a_ready(nxt);
            if constexpr (SP2) {
            PG8_LDB(B0, 0, 0); PG8_LDB(B1, 0, 1); PG8_SCHED; PG8_LDA(At, 0, 0); PG8_STAGE(PG8_SA(1, 1), a1 + hstep, voffA);
            PG8_WAIT_V(8); PG8_WAIT_L(0); PG8_BAR; PG8_MMA(0, 0, At, B0); PG8_MMA(0, 1, At, B1); PG8_BAR; PG8_SCHED;
            PG8_LDA(At, 0, 1); PG8_STAGE(PG8_SB(0, 0), b2, voffB); PG8_STAGE(PG8_SB(0, 1), b2 + hstep, voffB); PG8_STAGE(PG8_SA(0, 0), a2, voffA);
            PG8_WAIT_V(8); PG8_WAIT_L(0); PG8_BAR; PG8_MMA(1, 0, At, B0); PG8_MMA(1, 1, At, B1); PG8_BAR; PG8_SCHED;
            PG8_LDB(B0, 1, 0); PG8_LDB(B1, 1, 1); PG8_SCHED; PG8_LDA(At, 1, 0); PG8_STAGE(PG8_SA(0, 1), a2 + hstep, voffA);
            PG8_WAIT_V(8); PG8_WAIT_L(0); PG8_BAR; PG8_MMA(0, 0, At, B0); PG8_MMA(0, 1, At, B1); PG8_BAR; PG8_SCHED;
            PG8_LDA(At, 1, 1); PG8_STAGE(PG8_SB(1, 0), b3, voffB); PG8_STAGE(PG8_SB(1, 1), b3 + hstep, voffB); PG8_STAGE(PG8_SA(1, 0), a3, voffA);
            PG8_WAIT_V(8); PG8_WAIT_L(0); PG8_BAR; PG8_MMA(1, 0, At, B0); PG8_MMA(1, 1, At, B1); PG8_BAR; PG8_SCHED;
            } else {
            PG8_LDB(B0, 0, 0); PG8_SCHED; PG8_LDA(At, 0, 0); PG8_STAGE(PG8_SA(1, 1), a1 + hstep, voffA);
            PG8_WAIT_L(8); PG8_BAR; PG8_WAIT_L(0); PG8_MMA(0, 0, At, B0); PG8_BAR; PG8_SCHED;
            PG8_LDB(B1, 0, 1); PG8_STAGE(PG8_SB(0, 0), b2, voffB);
            PG8_BAR; PG8_WAIT_L(0); PG8_MMA(0, 1, At, B1); PG8_BAR;
            PG8_LDA(At, 0, 1); PG8_STAGE(PG8_SA(0, 0), a2, voffA);
            PG8_BAR; PG8_WAIT_L(0); PG8_MMA(1, 0, At, B0); PG8_BAR; PG8_SCHED;
            PG8_STAGE(PG8_SB(0, 1), b2 + hstep, voffB);
            PG8_WAIT_V(6); PG8_BAR; PG8_MMA(1, 1, At, B1); PG8_BAR;
            PG8_LDB(B0, 1, 0); PG8_SCHED; PG8_LDA(At, 1, 0); PG8_STAGE(PG8_SA(0, 1), a2 + hstep, voffA);
            PG8_WAIT_L(8); PG8_BAR; PG8_WAIT_L(0); PG8_MMA(0, 0, At, B0); PG8_BAR; PG8_SCHED;
            PG8_LDB(B1, 1, 1); PG8_STAGE(PG8_SB(1, 0), b3, voffB);
            PG8_BAR; PG8_WAIT_L(0); PG8_MMA(0, 1, At, B1); PG8_BAR;
            PG8_LDA(At, 1, 1); PG8_STAGE(PG8_SA(1, 0), a3, voffA);
            PG8_BAR; PG8_WAIT_L(0); PG8_MMA(1, 0, At, B0); PG8_BAR; PG8_SCHED;
            PG8_STAGE(PG8_SB(1, 1), b3 + hstep, voffB);
            PG8_WAIT_V(6); PG8_BAR; PG8_MMA(1, 1, At, B1); PG8_BAR;
            }
        }
        if constexpr (ALIGN_EPI) { if (wr == 0) PG8_BAR; }
        if constexpr (!Epi::AFTER_DRAIN) { E(acc, cur, wr, wc, fr, fq); S.done(cur); }
        if (!has_next) break;
#pragma unroll
        for (int a = 0; a < 2; ++a)
#pragma unroll
            for (int b = 0; b < 2; ++b)
#pragma unroll
                for (int m = 0; m < 4; ++m)
#pragma unroll
                    for (int n = 0; n < 2; ++n) acc[a][b][m][n] = (f32x4){0.f, 0.f, 0.f, 0.f};
        cur = nxt; cA = nA; cB = nB; kcur = knxt; ++ui;
        if constexpr (ALIGN_EPI) { if (wr == 1) PG8_BAR; }
    }
    PG8_WAIT_V(0);
    if constexpr (!ALIGN_EPI) { if (wr == 0) PG8_BAR; }
    PG8_BAR;
    if constexpr (Epi::AFTER_DRAIN) { E.fused(acc, cur, wr, wc, fr, fq, lds, wid, lane); S.done(cur); }
#undef PG8_SA
#undef PG8_SB
#undef PG8_STAGE
#undef PG8_LDA
#undef PG8_LDB
#undef PG8_MMA
#undef PG8_WAIT_V
#undef PG8_WAIT_L
#undef PG8_BAR
#undef PG8_SCHED
}
}

#ifndef PG8_SP2
#define PG8_SP2 true
#endif
#ifndef PG8_ALIGN
#define PG8_ALIGN true
#endif
constexpr int NWAVES = 8, NTHR = 512;
constexpr int BATCH = 8, SEQ = 4096, DM = 2048, T = BATCH * SEQ, MEMLEN = 256, TM = BATCH * MEMLEN;
constexpr int XAW = 512, XAH = 4, XAD = 128, MIXW = 1536;
constexpr int A_H = 4, A_DV = 384, A_DK = 192;
constexpr int B_H = 12, B_DK = 128, B_DV = 128;
constexpr int DFF = 5632;
constexpr int COLS_A = 5128, NA = 5120, NB = 6656;
constexpr int ZA_K = 768, ZA_V = 1536, ZA_O = 3072, ZA_XQ = 4608;
constexpr int ZB_F = 1536, ZB_I = 3072, ZB_G = 4608, ZB_XQ = 6144;
constexpr float EPS = 1e-6f;

constexpr size_t MiB = 1u << 20;
constexpr size_t WS_CTL = 0, WS_GATES = 1 * MiB, WS_SSQ = 2 * MiB, WS_SSQM = 6 * MiB, WS_MEMB = 8 * MiB, WS_KV = 16 * MiB, WS_SIDE = 24 * MiB;
constexpr size_t WS_WIN0 = 58 * MiB, WS_WOUT0 = 78 * MiB, WS_WUP0 = 86 * MiB, WS_WDN0 = 130 * MiB, WS_WIN1 = 152 * MiB, WS_WOUT1 = 178 * MiB, WS_WUP1 = 186 * MiB, WS_WDN1 = 230 * MiB, WS_WKV = 252 * MiB;
constexpr size_t WS_HRAW1 = WS_SIDE;
constexpr size_t WS_HB = 260 * MiB, WS_YCAT = 388 * MiB, WS_Z = 516 * MiB, WS_G5 = 932 * MiB, WS_END = 936 * MiB;
static_assert(WS_SIDE + (size_t)512 * 6 * DFF * 2 <= WS_WIN0 && WS_WIN0 + (size_t)NA * DM * 2 <= WS_WOUT0 && WS_WOUT0 + (size_t)DM * DM * 2 <= WS_WUP0 && WS_WUP0 + (size_t)2 * DFF * DM * 2 <= WS_WDN0 && WS_WDN0 + (size_t)DM * DFF * 2 <= WS_WIN1 &&
              WS_WIN1 + (size_t)NB * DM * 2 <= WS_WOUT1 && WS_WOUT1 + (size_t)DM * DM * 2 <= WS_WUP1 && WS_WUP1 + (size_t)2 * DFF * DM * 2 <= WS_WDN1 && WS_WDN1 + (size_t)DM * DFF * 2 <= WS_WKV && WS_WKV + (size_t)2048 * DM * 2 <= WS_HB &&
              WS_HRAW1 + (size_t)T * MIXW * 2 <= WS_WIN1 && WS_HB + (size_t)T * DM * 2 <= WS_YCAT && WS_YCAT + (size_t)T * DM * 2 <= WS_Z && WS_Z + (size_t)T * NB * 2 <= WS_G5, "d_ws map");
constexpr int LDS_BYTES = 160 * 1024, MISC_OFF = LDS_BYTES - 64;
constexpr size_t CTL_ZERO_BYTES = 65536;
constexpr int CW_BAR = 1024;

#define LAS __attribute__((address_space(3)))
typedef unsigned short bf16;
typedef float f32x4 __attribute__((ext_vector_type(4)));
typedef short bf16x8 __attribute__((ext_vector_type(8)));
typedef unsigned u32x4 __attribute__((ext_vector_type(4)));
typedef unsigned u32x2 __attribute__((ext_vector_type(2)));

typedef __bf16 bf16v2 __attribute__((ext_vector_type(2)));
__device__ __forceinline__ unsigned short f2bf(float f) { const __bf16 b = (__bf16)f; return __builtin_bit_cast(unsigned short, b); }
__device__ __forceinline__ unsigned pk2(float lo, float hi) { bf16v2 v; v[0] = (__bf16)lo; v[1] = (__bf16)hi; return __builtin_bit_cast(unsigned, v); }
__device__ __forceinline__ float bf2f(unsigned short b) { return __builtin_bit_cast(float, (unsigned)b << 16); }
__device__ __forceinline__ float wave_sum(float v) {
#pragma unroll
    for (int o = 1; o < 64; o <<= 1) v += __shfl_xor(v, o);
    return v;
}
__device__ __forceinline__ float sigmoidf_(float x) { return __builtin_amdgcn_rcpf(1.0f + __expf(-x)); }
__device__ __forceinline__ float siluf_(float x) { return x * __builtin_amdgcn_rcpf(1.0f + __expf(-x)); }

template <int KS> struct Frag { bf16x8 v[KS]; };
template <int KS> __device__ __forceinline__ void ldfrag(Frag<KS>& f, const LAS bf16* p, int ld, int fr, int fq) {
    const LAS bf16* q = p + fr * ld + fq * 8;
#pragma unroll
    for (int k = 0; k < KS; ++k) f.v[k] = *(const LAS bf16x8*)(q + 32 * k);
}
typedef short s16x4 __attribute__((ext_vector_type(4)));
template <int KS> __device__ __forceinline__ void ldfrag_tr(Frag<KS>& f, const LAS bf16* X, int ld, int c0, int fr, int fq) {
    const LAS bf16* q = X + (8 * fq + (fr >> 2)) * ld + c0 + 4 * (fr & 3);
#pragma unroll
    for (int k = 0; k < KS; ++k) { const s16x4 lo = __builtin_amdgcn_ds_read_tr16_b64_v4i16((LAS s16x4*)(q + 32 * k * ld)), hi = __builtin_amdgcn_ds_read_tr16_b64_v4i16((LAS s16x4*)(q + (32 * k + 4) * ld));
        f.v[k] = (bf16x8){lo[0], lo[1], lo[2], lo[3], hi[0], hi[1], hi[2], hi[3]}; }
}
template <int KS> __device__ __forceinline__ void ldfrag_trp(Frag<KS>& f, const LAS bf16* X, int ld, int c0, int fr, int fq) {
    const LAS bf16* q = X + (4 * fq + (fr >> 2)) * ld + c0 + 4 * (fr & 3);
#pragma unroll
    for (int k = 0; k < KS; ++k) { const s16x4 lo = __builtin_amdgcn_ds_read_tr16_b64_v4i16((LAS s16x4*)(q + 32 * k * ld)), hi = __builtin_amdgcn_ds_read_tr16_b64_v4i16((LAS s16x4*)(q + (32 * k + 16) * ld));
        f.v[k] = (bf16x8){lo[0], lo[1], lo[2], lo[3], hi[0], hi[1], hi[2], hi[3]}; }
}
template <int KS> __device__ __forceinline__ f32x4 mmaf(const Frag<KS>& a, const Frag<KS>& b, f32x4 acc) {
#pragma unroll
    for (int k = 0; k < KS; ++k) acc = __builtin_amdgcn_mfma_f32_16x16x32_bf16(a.v[k], b.v[k], acc, 0, 0, 0);
    return acc;
}
struct Args { const float* in[21]; float* out; unsigned char* ws; int ph_lo, ph_hi; };
enum { IN_X = 0, IN_MEM, IN_NMIX, IN_NMEM, IN_NFFN, IN_NOUT, IN_WKV, IN_AWIN, IN_AGB, IN_ACW, IN_ACB, IN_AHG, IN_AWOUT, IN_BWIN, IN_BLB, IN_BHG, IN_BWOUT, IN_FUP, IN_FCW, IN_FCB, IN_FDN };

struct WDesc { const float* src; bf16* dst; const float* scale; int K, Nsrc, Ndst, kind; };
__device__ __forceinline__ int src_col(int kind, int n) {
    if (kind == 1) return n < 4608 ? n : n + 8;
    if (kind == 2) { const int pn = n >> 8, r = n & 255; return (r >> 7) * DFF + pn * 128 + (r & 127); }
    return n;
}
__device__ __forceinline__ WDesc get_wdesc(const Args& a, int i) {
    unsigned char* ws = a.ws; WDesc d;
    switch (i) {
    case 0:  d = WDesc{a.in[IN_AWIN], (bf16*)(ws + WS_WIN0), a.in[IN_NMIX], DM, COLS_A, NA, 1}; break;
    case 1:  d = WDesc{a.in[IN_BWIN], (bf16*)(ws + WS_WIN1), a.in[IN_NMIX] + DM, DM, NB, NB, 0}; break;
    case 2:  d = WDesc{a.in[IN_AWOUT], (bf16*)(ws + WS_WOUT0), nullptr, DM, DM, DM, 0}; break;
    case 3:  d = WDesc{a.in[IN_BWOUT], (bf16*)(ws + WS_WOUT1), nullptr, DM, DM, DM, 0}; break;
    case 4:  d = WDesc{a.in[IN_FUP], (bf16*)(ws + WS_WUP0), a.in[IN_NFFN], DM, 2 * DFF, 2 * DFF, 2}; break;
    case 5:  d = WDesc{a.in[IN_FUP] + (size_t)DM * 2 * DFF, (bf16*)(ws + WS_WUP1), a.in[IN_NFFN] + DM, DM, 2 * DFF, 2 * DFF, 2}; break;
    case 6:  d = WDesc{a.in[IN_FDN], (bf16*)(ws + WS_WDN0), nullptr, DFF, DM, DM, 0}; break;
    case 7:  d = WDesc{a.in[IN_FDN] + (size_t)DFF * DM, (bf16*)(ws + WS_WDN1), nullptr, DFF, DM, DM, 0}; break;
    case 8:  d = WDesc{a.in[IN_WKV], (bf16*)(ws + WS_WKV), a.in[IN_NMEM], DM, 1024, 1024, 0}; break;
    default: d = WDesc{a.in[IN_WKV] + (size_t)DM * 1024, (bf16*)(ws + WS_WKV) + (size_t)1024 * DM, a.in[IN_NMEM] + DM, DM, 1024, 1024, 0}; break;
    }
    return d;
}
struct WTile { const float* src; bf16* dst; const float* scale; int K, Nsrc; };
__device__ __forceinline__ bool wtile_get(const Args& a, int it, WTile& t, int lane) {
    int base = 0;
#pragma unroll 1
    for (int wi = 0; wi < 10; ++wi) { const WDesc d = get_wdesc(a, wi); const int nnb = d.Ndst / 256, nit = (d.K / 64) * nnb;
        if (it < base + nit) { const int r = it - base, kb = r / nnb, nb = r - kb * nnb, k0 = 64 * kb, n0 = 256 * nb;
            const int sc = src_col(d.kind, n0 + 128 * (lane >> 5)) + 4 * (lane & 31);
            t.src = d.src + (size_t)k0 * d.Nsrc + sc; t.dst = d.dst + (size_t)n0 * d.K + k0; t.scale = d.scale ? d.scale + k0 : nullptr; t.K = d.K; t.Nsrc = d.Nsrc; return true; }
        base += nit; }
    return false;
}
constexpr int WT_ITEMS = (DM / 64) * (NA / 256) + (DM / 64) * (NB / 256) + 2 * (DM / 64) * (DM / 256) + 2 * (DM / 64) * (2 * DFF / 256) + 2 * (DFF / 64) * (DM / 256) + 2 * (DM / 64) * (1024 / 256);
__device__ __forceinline__ void phase_prologue(const Args& a, LAS unsigned char* lds, int tid, int lane, int wave) {
    unsigned char* ws = a.ws;
    LAS float* wg = (LAS float*)lds;
    { const float* W = a.in[IN_AWIN]; const float* g = a.in[IN_NMIX];
      for (int i = tid; i < DM * 8; i += NTHR) { const int k = i >> 3, j = i & 7; wg[j * DM + k] = W[(size_t)k * COLS_A + 4608 + j] * g[k]; } }
    __syncthreads();
    const int gw = blockIdx.x * NWAVES + wave, NGW = gridDim.x * NWAVES;
    { const float* x = a.in[IN_X]; bf16* hb = (bf16*)(ws + WS_HB); float* ssq = (float*)(ws + WS_SSQ); float* gates = (float*)(ws + WS_GATES); const float* gb = a.in[IN_AGB];
      for (int row = gw; row < T; row += NGW) {
        const f32x4* xr = (const f32x4*)(x + (size_t)row * DM) + lane; f32x4 v[8]; float s = 0.f;
#pragma unroll
        for (int j = 0; j < 8; ++j) { v[j] = xr[64 * j]; s += (v[j][0] * v[j][0] + v[j][1] * v[j][1]) + (v[j][2] * v[j][2] + v[j][3] * v[j][3]); }
        s = wave_sum(s);
        u32x2* o8 = (u32x2*)(hb + (size_t)row * DM) + lane;
#pragma unroll
        for (int j = 0; j < 8; ++j) { u32x2 w; w.x = pk2(v[j][0], v[j][1]); w.y = pk2(v[j][2], v[j][3]); o8[64 * j] = w; }
        float mine = 0.f;
#pragma unroll 1
        for (int q = 0; q < 8; ++q) { float t = 0.f;
#pragma unroll
            for (int j = 0; j < 8; ++j) { const f32x4 w = *(const LAS f32x4*)(wg + q * DM + 256 * j + 4 * lane); t += (v[j][0] * w[0] + v[j][1] * w[1]) + (v[j][2] * w[2] + v[j][3] * w[3]); }
            t = wave_sum(t); mine = (lane == q) ? t : mine; }
        const float rstd = 1.0f / sqrtf(s * (1.0f / DM) + EPS);
        if (lane < 32) ssq[(size_t)row * 32 + lane] = lane == 0 ? s : 0.f;
        if (lane < 8) { float pre = mine * rstd + gb[lane]; if (lane >= 4) pre = fminf(pre, 0.f) - log1pf(__expf(-fabsf(pre))); gates[(size_t)row * 8 + lane] = pre; }
      } }
    { const float* x = a.in[IN_MEM]; bf16* mb = (bf16*)(ws + WS_MEMB); float* ssq = (float*)(ws + WS_SSQM);
      for (int row = gw; row < TM; row += NGW) {
        const f32x4* xr = (const f32x4*)(x + (size_t)row * DM) + lane; f32x4 v[8]; float s = 0.f;
#pragma unroll
        for (int j = 0; j < 8; ++j) { v[j] = xr[64 * j]; s += (v[j][0] * v[j][0] + v[j][1] * v[j][1]) + (v[j][2] * v[j][2] + v[j][3] * v[j][3]); }
        s = wave_sum(s);
        u32x2* o8 = (u32x2*)(mb + (size_t)row * DM) + lane;
#pragma unroll
        for (int j = 0; j < 8; ++j) { u32x2 w; w.x = pk2(v[j][0], v[j][1]); w.y = pk2(v[j][2], v[j][3]); o8[64 * j] = w; }
        if (lane < 32) ssq[(size_t)row * 32 + lane] = lane == 0 ? s : 0.f;
      } }
    __syncthreads();
    {   LAS float* tile0 = (LAS float*)lds;
        f32x4 pf[8]; WTile cur, nxt; int it = blockIdx.x; bool have = wtile_get(a, it, cur, lane);
        if (have) {
#pragma unroll
            for (int i = 0; i < 8; ++i) pf[i] = *(const f32x4*)(cur.src + (size_t)(8 * wave + i) * cur.Nsrc); }
        int buf = 0;
        while (have) {
            LAS float* tl = tile0 + buf * (64 * 260);
#pragma unroll
            for (int i = 0; i < 8; ++i) { f32x4 v = pf[i]; if (cur.scale) v = v * cur.scale[8 * wave + i]; *(LAS f32x4*)(tl + (8 * wave + i) * 260 + 4 * lane) = v; }
            const bool have_n = wtile_get(a, it + (int)gridDim.x, nxt, lane);
            if (have_n) {
#pragma unroll
                for (int i = 0; i < 8; ++i) pf[i] = *(const f32x4*)(nxt.src + (size_t)(8 * wave + i) * nxt.Nsrc); }
            __syncthreads();
#pragma unroll
            for (int j = 0; j < 4; ++j) { const int n = lane + 64 * j; const LAS float* sp = tl + (8 * wave) * 260 + n;
                u32x4 o; o.x = pk2(sp[0], sp[260]); o.y = pk2(sp[2 * 260], sp[3 * 260]); o.z = pk2(sp[4 * 260], sp[5 * 260]); o.w = pk2(sp[6 * 260], sp[7 * 260]);
                *(u32x4*)(cur.dst + (size_t)n * cur.K + 8 * wave) = o; }
            cur = nxt; have = have_n; it += gridDim.x; buf ^= 1;
        }
    }
}

#ifndef HGRN_DUP
#define HGRN_DUP 0
#endif
#ifndef MLSTM_DUP
#define MLSTM_DUP 0
#endif
__device__ __forceinline__ void mlstm_gate_scan(const Args& a, int bh, int lane) {
    const float* gates = (const float*)(a.ws + WS_GATES); float* g5 = (float*)(a.ws + WS_G5);
    const int b = bh >> 2, h = bh & 3; float m_st = 0.f;
    const float* gp = gates + ((size_t)b * SEQ + lane) * 8 + h;
    float pig[8], plf[8];
#pragma unroll
    for (int j = 0; j < 8; ++j) { pig[j] = gp[(size_t)64 * j * 8]; plf[j] = gp[(size_t)64 * j * 8 + 4]; }
    for (int c0 = 0; c0 < SEQ / 64; c0 += 8) {
#pragma unroll
        for (int j = 0; j < 8; ++j) {
            const int c = c0 + j; const size_t t = (size_t)b * SEQ + 64 * c + lane;
            const float ig = pig[j], lf = plf[j];
            if (c + 8 < SEQ / 64) { pig[j] = gp[(size_t)64 * (c + 8) * 8]; plf[j] = gp[(size_t)64 * (c + 8) * 8 + 4]; }
            float g = lf;
#pragma unroll
            for (int o = 1; o < 64; o <<= 1) { const float x = __shfl_up(g, o); if (lane >= o) g += x; }
            const float u = ig - g; float pm = u;
#pragma unroll
            for (int o = 1; o < 64; o <<= 1) { const float x = __shfl_up(pm, o); if (lane >= o) pm = fmaxf(pm, x); }
            const float M = fmaxf(m_st, pm), M63 = __shfl(M, 63), g63 = __shfl(g, 63);
            f32x4 o0, o1; o0[0] = u; o0[1] = M; o0[2] = __expf(m_st - M); o0[3] = __expf(u - M63); o1[0] = __expf(-(g + M)); o1[1] = __expf(m_st - M63); o1[2] = 0.f; o1[3] = 0.f;
            f32x4* dst = (f32x4*)(g5 + (t * 4 + h) * 8); dst[0] = o0; dst[1] = o1;
            m_st = g63 + M63;
        }
    }
}
__device__ __forceinline__ void phase_mlstm_conv(const Args& a, int tid, int first, int stride) {
    const bf16* Z = (const bf16*)(a.ws + WS_Z); bf16* QK = (bf16*)(a.ws + WS_YCAT);
    if (tid >= 384) return;
    const int cg = tid % 192, rg2 = tid / 192, c0 = cg * 8; const float osc = cg >= 96 ? 0.07216878364870322f : 1.0f;
    float w[4][8], bias[8];
    { const float* cw = a.in[IN_ACW]; const float* cb = a.in[IN_ACB];
#pragma unroll
      for (int k = 0; k < 4; ++k) { const f32x4 x0 = *(const f32x4*)(cw + k * 1536 + c0), x1 = *(const f32x4*)(cw + k * 1536 + c0 + 4);
#pragma unroll
          for (int e = 0; e < 4; ++e) { w[k][e] = x0[e]; w[k][4 + e] = x1[e]; } }
      const f32x4 b0 = *(const f32x4*)(cb + c0), b1 = *(const f32x4*)(cb + c0 + 4);
#pragma unroll
      for (int e = 0; e < 4; ++e) { bias[e] = b0[e]; bias[4 + e] = b1[e]; } }
    for (int it = first; it < T / 16; it += stride) {
        const int t0 = it * 16 + rg2 * 8; const bool start = (t0 % SEQ) == 0;
        float x[11][8];
#pragma unroll
        for (int r = 0; r < 11; ++r) { u32x4 v = (u32x4){0u, 0u, 0u, 0u}; if (r >= 3 || !start) v = *(const u32x4*)(Z + (size_t)(t0 - 3 + r) * NA + c0);
            const unsigned vv[4] = {v.x, v.y, v.z, v.w};
#pragma unroll
            for (int e = 0; e < 4; ++e) { x[r][2 * e] = bf2f((bf16)(vv[e] & 0xffffu)); x[r][2 * e + 1] = bf2f((bf16)(vv[e] >> 16)); } }
#pragma unroll
        for (int r = 0; r < 8; ++r) { float y[8];
#pragma unroll
            for (int e = 0; e < 8; ++e) { const float c = bias[e] + w[0][e] * x[r][e] + w[1][e] * x[r + 1][e] + w[2][e] * x[r + 2][e] + w[3][e] * x[r + 3][e]; y[e] = siluf_(c) * osc; }
            u32x4 o; o.x = pk2(y[0], y[1]); o.y = pk2(y[2], y[3]); o.z = pk2(y[4], y[5]); o.w = pk2(y[6], y[7]);
            *(u32x4*)(QK + (size_t)(t0 + r) * MIXW + c0) = o; }
    }
}
__device__ __forceinline__ void phase_mlstm(const Args& a, LAS unsigned char* lds, int tid, int lane, int wave) {
    unsigned char* ws = a.ws;
    const bf16* Z = (const bf16*)(ws + WS_Z); const bf16* QK = (const bf16*)(ws + WS_YCAT); const float* g5 = (const float*)(ws + WS_G5); bf16* hraw = (bf16*)(ws + WS_HB);
    LAS bf16* Qs = (LAS bf16*)lds;
    LAS bf16* Ks = (LAS bf16*)(lds + 25600);
    LAS bf16* Vs = (LAS bf16*)(lds + 51200);
    LAS bf16* VWs = (LAS bf16*)(lds + 60416);
    LAS bf16* Ps = (LAS bf16*)(lds + 69632);
    LAS bf16* CT0 = (LAS bf16*)(lds + 78848);
    LAS float* fu = (LAS float*)(lds + 130048);
    LAS float* fM = fu + 64; LAS float* fwi = fu + 128; LAS float* fem = fu + 192; LAS float* fdec = fu + 256;
    const int fr = lane & 15, fq = lane >> 4;
    for (int item = blockIdx.x; item < BATCH * A_H * 8; item += gridDim.x) {
        const int bh = (item & 7) * 4 + (item >> 6), js = (item >> 3) & 7, b = bh >> 2, h = bh & 3;
        __syncthreads();
        for (int i = tid; i < 2 * 64 * 200 / 2; i += NTHR) ((LAS unsigned*)CT0)[i] = 0u;
        for (int i = tid; i < 64 * 72 / 2; i += NTHR) ((LAS unsigned*)VWs)[i] = 0u;
        for (int i = tid; i < 64 * 72; i += NTHR) Vs[i] = (i % 72 == 48) ? (bf16)0x3f80 : (bf16)0;
        f32x4 cacc[6];
#pragma unroll
        for (int i = 0; i < 6; ++i) cacc[i] = (f32x4){0.f, 0.f, 0.f, 0.f};
        __syncthreads();
        const int vrow = tid / 6, vcc = tid - vrow * 6;
        const int grow = tid >> 1, ghalf = tid & 1;
        const bf16* qkbase = QK + (size_t)b * SEQ * MIXW + h * A_DK;
        const bf16* vbase = Z + (size_t)b * SEQ * NA + ZA_V + h * A_DV + js * 48 + vcc * 8;
        const float* gbase = g5 + ((size_t)b * SEQ * 4 + h) * 8;
        u32x4 pq[3], pk[3], pv; f32x4 pg; float pws;
#define MLSTM_PREFETCH(c_) do { const size_t tt = (size_t)64 * (c_); int tp_ = tid; asm volatile("" : "+v"(tp_)); \
            _Pragma("unroll") for (int j = 0; j < 3; ++j) { const int i = tp_ + NTHR * j, row = i / 24, cc = i - row * 24; pq[j] = *(const u32x4*)(qkbase + (tt + row) * MIXW + cc * 8); pk[j] = *(const u32x4*)(qkbase + (tt + row) * MIXW + 768 + cc * 8); } \
            if (tid < 384) { pv = *(const u32x4*)(vbase + (tt + vrow) * NA); pws = gbase[(tt + vrow) * 32 + 3]; } \
            if (tid < 128) pg = *(const f32x4*)(gbase + (tt + grow) * 32 + 4 * ghalf); } while (0)
        MLSTM_PREFETCH(0);
        for (int c = 0; c < SEQ / 64; ++c) {
            const size_t t0 = (size_t)b * SEQ + 64 * c; const int cur = c & 1;
            LAS bf16* CTc = CT0 + cur * 64 * 200; LAS bf16* CTn = CT0 + (cur ^ 1) * 64 * 200;
            {
            int ts_ = tid; asm volatile("" : "+v"(ts_));
#pragma unroll
            for (int j = 0; j < 3; ++j) { const int i = ts_ + NTHR * j, row = i / 24, cc = i - row * 24;
                *(LAS u32x4*)(Qs + row * 200 + cc * 8) = pq[j]; *(LAS u32x4*)(Ks + row * 200 + cc * 8) = pk[j]; }
            if (tid < 384) { *(LAS u32x4*)(Vs + vrow * 72 + vcc * 8) = pv; const unsigned vv[4] = {pv.x, pv.y, pv.z, pv.w}; unsigned ww[4];
#pragma unroll
                for (int e = 0; e < 4; ++e) ww[e] = pk2(bf2f((bf16)(vv[e] & 0xffffu)) * pws, bf2f((bf16)(vv[e] >> 16)) * pws);
                *(LAS u32x4*)(VWs + vrow * 72 + vcc * 8) = (u32x4){ww[0], ww[1], ww[2], ww[3]}; }
            if (tid < 128) { if (ghalf == 0) { fu[grow] = pg[0]; fM[grow] = pg[1]; fwi[grow] = pg[2]; VWs[grow * 72 + 48] = f2bf(pg[3]); } else { fem[grow] = pg[0]; if (grow == 0) fdec[0] = pg[1]; } }
            }
            __syncthreads();
            if (c + 1 < SEQ / 64) MLSTM_PREFETCH(c + 1);
            {
                const int li = wave >> 1, half = wave & 1, l = 16 * li + fr; const float wil = fwi[l], Ml = fM[l];
                Frag<6> fqq; ldfrag(fqq, Qs + 16 * li * 200, 200, fr, fq);
                unsigned pb[4][2];
#pragma unroll
                for (int si = 0; si < 4; ++si) { pb[si][0] = 0u; pb[si][1] = 0u;
                    if (si <= li) { Frag<6> fk; ldfrag(fk, Ks + 16 * si * 200, 200, fr, fq); const f32x4 sacc = mmaf<6>(fk, fqq, (f32x4){0.f, 0.f, 0.f, 0.f}); float p[4];
#pragma unroll
                        for (int r = 0; r < 4; ++r) { const int sx = 16 * si + 4 * fq + r; p[r] = (sx <= l) ? sacc[r] * __expf(fu[sx] - Ml) : 0.f; }
                        pb[si][0] = pk2(p[0], p[1]); pb[si][1] = pk2(p[2], p[3]); } }
                Frag<2> fp;
#pragma unroll
                for (int k = 0; k < 2; ++k) { const u32x4 w = (u32x4){pb[2 * k][0], pb[2 * k][1], pb[2 * k + 1][0], pb[2 * k + 1][1]}; fp.v[k] = __builtin_bit_cast(bf16x8, w); }
                const int vfa = half ? 2 : 0;
                Frag<6> ca, cd; Frag<2> va, vd; ldfrag(ca, CTc + 16 * vfa * 200, 200, fr, fq); ldfrag(cd, CTc + 16 * 3 * 200, 200, fr, fq); ldfrag_trp(va, Vs, 72, 16 * vfa, fr, fq); ldfrag_trp(vd, Vs, 72, 48, fr, fq);
                f32x4 oa = (f32x4){0.f, 0.f, 0.f, 0.f}, od = oa, ob = oa;
#pragma unroll
                for (int k = 0; k < 6; ++k) { oa = __builtin_amdgcn_mfma_f32_16x16x32_bf16(ca.v[k], fqq.v[k], oa, 0, 0, 0); od = __builtin_amdgcn_mfma_f32_16x16x32_bf16(cd.v[k], fqq.v[k], od, 0, 0, 0); }
                oa = oa * wil; od = od * wil;
#pragma unroll
                for (int k = 0; k < 2; ++k) { oa = __builtin_amdgcn_mfma_f32_16x16x32_bf16(va.v[k], fp.v[k], oa, 0, 0, 0); od = __builtin_amdgcn_mfma_f32_16x16x32_bf16(vd.v[k], fp.v[k], od, 0, 0, 0); }
                if (!half) { Frag<6> cb; Frag<2> vb; ldfrag(cb, CTc + 16 * 200, 200, fr, fq); ldfrag_trp(vb, Vs, 72, 16, fr, fq);
                    ob = mmaf<6>(cb, fqq, ob); ob = ob * wil; ob = mmaf<2>(vb, fp, ob); }
                const float den = __shfl(od[0], fr), dinv = __builtin_amdgcn_rcpf(fmaxf(fabsf(den), fem[l]));
                bf16* orow = hraw + (t0 + l) * MIXW + h * A_DV + js * 48 + 4 * fq;
                { u32x2 w2; w2.x = pk2(oa[0] * dinv, oa[1] * dinv); w2.y = pk2(oa[2] * dinv, oa[3] * dinv); *(u32x2*)(orow + 16 * vfa) = w2; }
                if (!half) { u32x2 w2; w2.x = pk2(ob[0] * dinv, ob[1] * dinv); w2.y = pk2(ob[2] * dinv, ob[3] * dinv); *(u32x2*)(orow + 16) = w2; }
            }
            {
                const float decay = fdec[0];
                Frag<2> fv[4];
#pragma unroll
                for (int vf = 0; vf < 4; ++vf) ldfrag_tr(fv[vf], VWs, 72, 16 * vf, fr, fq);
                const int dk0 = (6 * wave) >> 2;
                Frag<2> fka, fkb; ldfrag_tr(fka, Ks, 200, 16 * dk0, fr, fq); ldfrag_tr(fkb, Ks, 200, 16 * (dk0 + 1), fr, fq);
#pragma unroll
                for (int i = 0; i < 6; ++i) cacc[i] = cacc[i] * decay;
                if (wave & 1) {
                    cacc[0] = mmaf<2>(fka, fv[2], cacc[0]); cacc[1] = mmaf<2>(fka, fv[3], cacc[1]); cacc[2] = mmaf<2>(fkb, fv[0], cacc[2]); cacc[3] = mmaf<2>(fkb, fv[1], cacc[3]); cacc[4] = mmaf<2>(fkb, fv[2], cacc[4]); cacc[5] = mmaf<2>(fkb, fv[3], cacc[5]);
                } else {
                    cacc[0] = mmaf<2>(fka, fv[0], cacc[0]); cacc[1] = mmaf<2>(fka, fv[1], cacc[1]); cacc[2] = mmaf<2>(fka, fv[2], cacc[2]); cacc[3] = mmaf<2>(fka, fv[3], cacc[3]); cacc[4] = mmaf<2>(fkb, fv[0], cacc[4]); cacc[5] = mmaf<2>(fkb, fv[1], cacc[5]);
                }
#pragma unroll
                for (int i = 0; i < 6; ++i) { const int f = 6 * wave + i, dkf = f >> 2, vf = f & 3;
                    u32x2 w2; w2.x = pk2(cacc[i][0], cacc[i][1]); w2.y = pk2(cacc[i][2], cacc[i][3]);
                    *(LAS u32x2*)(CTn + (16 * vf + fr) * 200 + 16 * dkf + 4 * fq) = w2; }
            }
            __syncthreads();
        }
#undef MLSTM_PREFETCH
    }
}

__device__ __forceinline__ void phase_hgrn(const Args& a, LAS unsigned char* lds, int tid, int lane, int wave) {
    unsigned char* ws = a.ws;
    const bf16* Z = (const bf16*)(ws + WS_Z); bf16* hraw = (bf16*)(ws + WS_HRAW1);
    LAS bf16* Qg0 = (LAS bf16*)lds;
    LAS bf16* Kg0 = (LAS bf16*)(lds + 34816);
    LAS bf16* VT0 = (LAS bf16*)(lds + 69632);
    LAS bf16* ST0 = (LAS bf16*)(lds + 88064);
    LAS float* eg0 = (LAS float*)(lds + 122880);
    const int fr = lane & 15, fq = lane >> 4;
    const int rg = lane >> 2, ch0 = 16 * wave + 4 * (lane & 3);
    const int vrow = tid >> 3, vcc = tid & 7;
    for (int item = blockIdx.x; item < BATCH * B_H * 2; item += gridDim.x) {
        const int bh = item >> 1, js = item & 1, b = bh / B_H, h = bh - b * B_H;
        __syncthreads();
        for (int i = tid; i < 2 * 64 * 136 / 2; i += NTHR) ((LAS unsigned*)ST0)[i] = 0u;
        f32x4 sacc[4];
#pragma unroll
        for (int i = 0; i < 4; ++i) sacc[i] = (f32x4){0.f, 0.f, 0.f, 0.f};
        float lb[4];
        { const float* lbl = a.in[IN_BLB];
#pragma unroll
          for (int e = 0; e < 4; ++e) lb[e] = 1.0f / (1.0f + __expf(lbl[h * B_DK + ch0 + e] - lbl[MIXW + h * B_DK + ch0 + e])); }
        const bf16* qbase = Z + ((size_t)b * SEQ + 4 * rg) * NB + h * B_DK + ch0;
        const bf16* vbase = Z + ((size_t)b * SEQ + vrow) * NB + ZB_I + h * B_DV + js * 64 + vcc * 8;
        u32x2 pqv[4], pfv[4]; u32x4 pv;
#define HGRN_PREFETCH(c_) do { const size_t tt = (size_t)64 * (c_) * NB; \
            _Pragma("unroll") for (int i = 0; i < 4; ++i) { pqv[i] = *(const u32x2*)(qbase + tt + (size_t)i * NB); pfv[i] = *(const u32x2*)(qbase + tt + (size_t)i * NB + ZB_F); } \
            pv = *(const u32x4*)(vbase + tt); } while (0)
#define HGRN_ELEMENTWISE(bi_) do { LAS bf16* Qg_ = Qg0 + (bi_) * 64 * 136; LAS bf16* Kg_ = Kg0 + (bi_) * 64 * 136; \
            float qs[4][4], kk[4][4], cs[4][4]; float run[4] = {1.f, 1.f, 1.f, 1.f}; \
            _Pragma("unroll") for (int i = 0; i < 4; ++i) { const unsigned qv[2] = {pqv[i].x, pqv[i].y}, fv[2] = {pfv[i].x, pfv[i].y}; \
                _Pragma("unroll") for (int e = 0; e < 4; ++e) { const float q = bf2f((bf16)((qv[e >> 1] >> (16 * (e & 1))) & 0xffffu)), f = bf2f((bf16)((fv[e >> 1] >> (16 * (e & 1))) & 0xffffu)); \
                    const float fg = lb[e] + (1.0f - lb[e]) * sigmoidf_(f); run[e] *= fg; qs[i][e] = siluf_(q); kk[i][e] = 1.0f - fg; cs[i][e] = run[e]; } } \
            float excl[4], gend[4]; \
            _Pragma("unroll") for (int e = 0; e < 4; ++e) { float x = run[e]; \
                _Pragma("unroll") for (int o = 4; o < 64; o <<= 1) { const float y = __shfl_up(x, o); if (lane >= o) x *= y; } \
                const float y = __shfl_up(x, 4); excl[e] = lane >= 4 ? y : 1.0f; gend[e] = __shfl(x, 60 + (lane & 3)); } \
            _Pragma("unroll") for (int i = 0; i < 4; ++i) { float qg[4], kg[4]; \
                _Pragma("unroll") for (int e = 0; e < 4; ++e) { const float cp = cs[i][e] * excl[e]; qg[e] = qs[i][e] * cp; kg[e] = kk[i][e] * __builtin_amdgcn_rcpf(fmaxf(cp, 1e-30f)); } \
                const int l = 4 * rg + i; u32x2 w; w.x = pk2(qg[0], qg[1]); w.y = pk2(qg[2], qg[3]); *(LAS u32x2*)(Qg_ + l * 136 + ch0) = w; \
                w.x = pk2(kg[0], kg[1]); w.y = pk2(kg[2], kg[3]); *(LAS u32x2*)(Kg_ + l * 136 + ch0) = w; } \
            if (rg == 15) { _Pragma("unroll") for (int e = 0; e < 4; ++e) eg0[(bi_) * 128 + ch0 + e] = gend[e]; } \
            *(LAS u32x4*)(VT0 + (bi_) * 64 * 72 + vrow * 72 + vcc * 8) = pv; } while (0)
        HGRN_PREFETCH(0);
        HGRN_ELEMENTWISE(0);
        HGRN_PREFETCH(1);
        __syncthreads();
        for (int c = 0; c < SEQ / 64; ++c) {
            const size_t t0 = (size_t)b * SEQ + 64 * c; const int cur = c & 1;
            const LAS bf16* Qg = Qg0 + cur * 64 * 136; const LAS bf16* Kg = Kg0 + cur * 64 * 136; const LAS bf16* VT = VT0 + cur * 64 * 72;
            const LAS bf16* STc = ST0 + cur * 64 * 136; LAS bf16* STn = ST0 + (cur ^ 1) * 64 * 136; const LAS float* eg = eg0 + cur * 128;
            if (c + 1 < SEQ / 64) { HGRN_ELEMENTWISE(cur ^ 1); if (c + 2 < SEQ / 64) HGRN_PREFETCH(c + 2); }
            {
                const int li = wave >> 1, l = 16 * li + fr, vf0 = 2 * (wave & 1);
                Frag<4> fqq; ldfrag(fqq, Qg + 16 * li * 136, 136, fr, fq);
                unsigned pb[4][2];
#pragma unroll
                for (int si = 0; si < 4; ++si) { pb[si][0] = 0u; pb[si][1] = 0u;
                    if (si <= li) { Frag<4> fk; ldfrag(fk, Kg + 16 * si * 136, 136, fr, fq); const f32x4 sa = mmaf<4>(fk, fqq, (f32x4){0.f, 0.f, 0.f, 0.f}); float p[4];
#pragma unroll
                        for (int r = 0; r < 4; ++r) { const int sx = 16 * si + 4 * fq + r; p[r] = (sx <= l) ? sa[r] : 0.f; }
                        pb[si][0] = pk2(p[0], p[1]); pb[si][1] = pk2(p[2], p[3]); } }
                Frag<2> fp;
#pragma unroll
                for (int k = 0; k < 2; ++k) { const u32x4 w = (u32x4){pb[2 * k][0], pb[2 * k][1], pb[2 * k + 1][0], pb[2 * k + 1][1]}; fp.v[k] = __builtin_bit_cast(bf16x8, w); }
                Frag<4> sa, sb; Frag<2> va, vb;
                ldfrag(sa, STc + 16 * vf0 * 136, 136, fr, fq); ldfrag(sb, STc + 16 * (vf0 + 1) * 136, 136, fr, fq);
                ldfrag_trp(va, VT, 72, 16 * vf0, fr, fq); ldfrag_trp(vb, VT, 72, 16 * (vf0 + 1), fr, fq);
                f32x4 oa = (f32x4){0.f, 0.f, 0.f, 0.f}, ob = oa;
#pragma unroll
                for (int k = 0; k < 4; ++k) { oa = __builtin_amdgcn_mfma_f32_16x16x32_bf16(sa.v[k], fqq.v[k], oa, 0, 0, 0); ob = __builtin_amdgcn_mfma_f32_16x16x32_bf16(sb.v[k], fqq.v[k], ob, 0, 0, 0); }
#pragma unroll
                for (int k = 0; k < 2; ++k) { oa = __builtin_amdgcn_mfma_f32_16x16x32_bf16(va.v[k], fp.v[k], oa, 0, 0, 0); ob = __builtin_amdgcn_mfma_f32_16x16x32_bf16(vb.v[k], fp.v[k], ob, 0, 0, 0); }
                bf16* orow = hraw + (t0 + l) * MIXW + h * B_DV + js * 64 + 4 * fq;
                u32x2 w2; w2.x = pk2(oa[0], oa[1]); w2.y = pk2(oa[2], oa[3]); *(u32x2*)(orow + 16 * vf0) = w2;
                w2.x = pk2(ob[0], ob[1]); w2.y = pk2(ob[2], ob[3]); *(u32x2*)(orow + 16 * vf0 + 16) = w2;
            }
            {
                Frag<2> fke, fv[4]; ldfrag_tr(fke, Kg, 136, 16 * wave, fr, fq);
#pragma unroll
                for (int vf = 0; vf < 4; ++vf) ldfrag_tr(fv[vf], VT, 72, 16 * vf, fr, fq);
                float egr[4];
#pragma unroll
                for (int r = 0; r < 4; ++r) egr[r] = eg[16 * wave + 4 * fq + r];
#pragma unroll
                for (int i = 0; i < 4; ++i) {
                    sacc[i] = mmaf<2>(fke, fv[i], sacc[i]);
#pragma unroll
                    for (int r = 0; r < 4; ++r) sacc[i][r] *= egr[r];
                    u32x2 w; w.x = pk2(sacc[i][0], sacc[i][1]); w.y = pk2(sacc[i][2], sacc[i][3]);
                    *(LAS u32x2*)(STn + (16 * i + fr) * 136 + 16 * wave + 4 * fq) = w; }
            }
            __syncthreads();
        }
#undef HGRN_PREFETCH
#undef HGRN_ELEMENTWISE
    }
}

template <int LAYER>
__device__ __forceinline__ void phase_attn(const Args& a, LAS unsigned char* lds, int tid, int lane, int wave, int item0, int istride) {
    unsigned char* ws = a.ws;
    constexpr int NZ = LAYER == 0 ? NA : NB, XQ = LAYER == 0 ? ZA_XQ : ZB_XQ;
    const bf16* Z = (const bf16*)(ws + WS_Z); const bf16* KV = (const bf16*)(ws + WS_KV); bf16* ycat = (bf16*)(ws + WS_YCAT); const bf16* hraw = (const bf16*)(ws + (LAYER == 0 ? WS_HB : WS_HRAW1));
    LAS bf16* Ks = (LAS bf16*)lds;
    LAS bf16* Vt = (LAS bf16*)(lds + 69632);
    LAS bf16* Pw = (LAS bf16*)(lds + 137216 + wave * 2304);
    const int fr = lane & 15, fq = lane >> 4;
    for (int item = item0; item < BATCH * XAH * 8; item += istride) {
        const int bh = item >> 3, part = item & 7, b = bh >> 2, h = bh & 3;
        __syncthreads();
        { const bf16* kp = KV + (size_t)b * MEMLEN * 2048 + LAYER * 1024 + h * XAD;
          for (int i = tid; i < 256 * 16; i += NTHR) { const int key = i >> 4, c8 = i & 15;
              *(LAS u32x4*)(Ks + key * 136 + c8 * 8) = *(const u32x4*)(kp + (size_t)key * 2048 + c8 * 8);
              const u32x4 v = *(const u32x4*)(kp + (size_t)key * 2048 + 512 + c8 * 8); const unsigned vv[4] = {v.x, v.y, v.z, v.w};
#pragma unroll
              for (int j = 0; j < 4; ++j) { Vt[(c8 * 8 + 2 * j) * 264 + key] = (bf16)(vv[j] & 0xffffu); Vt[(c8 * 8 + 2 * j + 1) * 264 + key] = (bf16)(vv[j] >> 16); } } }
        __syncthreads();
        for (int tile = 0; tile < 4; ++tile) {
            const size_t tq0 = (size_t)b * SEQ + part * 512 + tile * 128 + 16 * wave;
            bf16x8 aq[4];
#pragma unroll
            for (int ks = 0; ks < 4; ++ks) aq[ks] = *(const bf16x8*)(Z + (tq0 + fr) * NZ + XQ + h * XAD + 32 * ks + 8 * fq);
            f32x4 s[16];
#pragma unroll
            for (int nf = 0; nf < 16; ++nf) { f32x4 acc = (f32x4){0.f, 0.f, 0.f, 0.f};
#pragma unroll
                for (int ks = 0; ks < 4; ++ks) { const bf16x8 bk = *(const LAS bf16x8*)(Ks + (16 * nf + fr) * 136 + 32 * ks + 8 * fq); acc = __builtin_amdgcn_mfma_f32_16x16x32_bf16(aq[ks], bk, acc, 0, 0, 0); }
                s[nf] = acc; }
            float mx[4], sm[4];
#pragma unroll
            for (int r = 0; r < 4; ++r) { float m = s[0][r];
#pragma unroll
                for (int nf = 1; nf < 16; ++nf) m = fmaxf(m, s[nf][r]);
                m = fmaxf(m, __shfl_xor(m, 1)); m = fmaxf(m, __shfl_xor(m, 2)); m = fmaxf(m, __shfl_xor(m, 4)); m = fmaxf(m, __shfl_xor(m, 8)); mx[r] = m; sm[r] = 0.f; }
            constexpr float SC = 0.08838834764831845f * 1.4426950408889634f;
#pragma unroll
            for (int nf = 0; nf < 16; ++nf)
#pragma unroll
                for (int r = 0; r < 4; ++r) { const float p = __builtin_amdgcn_exp2f((s[nf][r] - mx[r]) * SC); s[nf][r] = p; sm[r] += p; }
#pragma unroll
            for (int r = 0; r < 4; ++r) { float t = sm[r]; t += __shfl_xor(t, 1); t += __shfl_xor(t, 2); t += __shfl_xor(t, 4); t += __shfl_xor(t, 8); sm[r] = 1.0f / t; }
            f32x4 o[8];
#pragma unroll
            for (int df = 0; df < 8; ++df) o[df] = (f32x4){0.f, 0.f, 0.f, 0.f};
#pragma unroll
            for (int qd = 0; qd < 4; ++qd) {
#pragma unroll
                for (int n4 = 0; n4 < 4; ++n4)
#pragma unroll
                    for (int r = 0; r < 4; ++r) Pw[(4 * fq + r) * 72 + 16 * n4 + fr] = f2bf(s[4 * qd + n4][r]);
                asm volatile("s_waitcnt lgkmcnt(0)" ::: "memory");
#pragma unroll
                for (int ks = 0; ks < 2; ++ks) { const bf16x8 ap = *(const LAS bf16x8*)(Pw + fr * 72 + 32 * ks + 8 * fq);
#pragma unroll
                    for (int df = 0; df < 8; ++df) { const bf16x8 bv = *(const LAS bf16x8*)(Vt + (16 * df + fr) * 264 + 64 * qd + 32 * ks + 8 * fq); o[df] = __builtin_amdgcn_mfma_f32_16x16x32_bf16(ap, bv, o[df], 0, 0, 0); } }
                asm volatile("s_waitcnt lgkmcnt(0)" ::: "memory");
            }
#pragma unroll
            for (int df = 0; df < 8; ++df)
#pragma unroll
                for (int r = 0; r < 4; ++r) ycat[(tq0 + 4 * fq + r) * DM + MIXW + h * XAD + 16 * df + fr] = f2bf(o[df][r] * sm[r]);
        }
    }
}
template <int LAYER>
__device__ __forceinline__ void phase_norm(const Args& a, int lane, int wave) {
    unsigned char* ws = a.ws;
    const bf16* Z = (const bf16*)(ws + WS_Z); bf16* ycat = (bf16*)(ws + WS_YCAT); const bf16* hraw = (const bf16*)(ws + (LAYER == 0 ? WS_HB : WS_HRAW1));
    const int gw = blockIdx.x * NWAVES + wave, NGW = gridDim.x * NWAVES;
    if (LAYER == 0) {
        const float* hg = a.in[IN_AHG];
        for (int t = gw; t < T; t += NGW) {
            const bf16* hp = hraw + (size_t)t * MIXW + 24 * lane; const bf16* op = Z + (size_t)t * NA + ZA_O + 24 * lane;
            float v[24], og[24]; float ss = 0.f;
#pragma unroll
            for (int j = 0; j < 3; ++j) { const u32x4 w = *(const u32x4*)(hp + 8 * j), wo = *(const u32x4*)(op + 8 * j); const unsigned ww[4] = {w.x, w.y, w.z, w.w}, wwo[4] = {wo.x, wo.y, wo.z, wo.w};
#pragma unroll
                for (int e = 0; e < 4; ++e) { v[8 * j + 2 * e] = bf2f((bf16)(ww[e] & 0xffffu)); v[8 * j + 2 * e + 1] = bf2f((bf16)(ww[e] >> 16)); og[8 * j + 2 * e] = bf2f((bf16)(wwo[e] & 0xffffu)); og[8 * j + 2 * e + 1] = bf2f((bf16)(wwo[e] >> 16)); } }
#pragma unroll
            for (int i = 0; i < 24; ++i) ss += v[i] * v[i];
            ss += __shfl_xor(ss, 1); ss += __shfl_xor(ss, 2); ss += __shfl_xor(ss, 4); ss += __shfl_xor(ss, 8);
            const float rstd = 1.0f / sqrtf(ss * (1.0f / A_DV) + EPS);
            bf16* yp = ycat + (size_t)t * DM + 24 * lane;
#pragma unroll
            for (int j = 0; j < 3; ++j) { float y[8];
#pragma unroll
                for (int e = 0; e < 8; ++e) { const int i = 8 * j + e; y[e] = sigmoidf_(og[i]) * v[i] * rstd * hg[24 * lane + i]; }
                u32x4 w; w.x = pk2(y[0], y[1]); w.y = pk2(y[2], y[3]); w.z = pk2(y[4], y[5]); w.w = pk2(y[6], y[7]); *(u32x4*)(yp + 8 * j) = w; }
        }
    } else {
        const float* hg = a.in[IN_BHG];
        for (int t = gw; t < T; t += NGW) {
#pragma unroll
            for (int j = 0; j < 3; ++j) { const int c0 = 8 * lane + 512 * j;
                const u32x4 w = *(const u32x4*)(hraw + (size_t)t * MIXW + c0), wo = *(const u32x4*)(Z + (size_t)t * NB + ZB_G + c0); const unsigned ww[4] = {w.x, w.y, w.z, w.w}, wwo[4] = {wo.x, wo.y, wo.z, wo.w};
                float v[8], og[8]; float ss = 0.f;
#pragma unroll
                for (int e = 0; e < 4; ++e) { v[2 * e] = bf2f((bf16)(ww[e] & 0xffffu)); v[2 * e + 1] = bf2f((bf16)(ww[e] >> 16)); og[2 * e] = bf2f((bf16)(wwo[e] & 0xffffu)); og[2 * e + 1] = bf2f((bf16)(wwo[e] >> 16)); }
#pragma unroll
                for (int e = 0; e < 8; ++e) ss += v[e] * v[e];
                ss += __shfl_xor(ss, 1); ss += __shfl_xor(ss, 2); ss += __shfl_xor(ss, 4); ss += __shfl_xor(ss, 8);
                const float rstd = 1.0f / sqrtf(ss * (1.0f / B_DV) + EPS);
                float y[8];
#pragma unroll
                for (int e = 0; e < 8; ++e) y[e] = v[e] * rstd * hg[c0 + e] * siluf_(og[e]);
                u32x4 wy; wy.x = pk2(y[0], y[1]); wy.y = pk2(y[2], y[3]); wy.z = pk2(y[4], y[5]); wy.w = pk2(y[6], y[7]); *(u32x4*)(ycat + (size_t)t * DM + c0) = wy; }
        }
    }
}

__device__ __forceinline__ void phase_ffn_fixup(const Args& a, int layer, int tid) {
    unsigned char* ws = a.ws; const bf16* side = (const bf16*)(ws + WS_SIDE); bf16* act = (bf16*)(ws + WS_Z);
    const float* cw = a.in[IN_FCW] + (size_t)layer * 3 * DFF; const float* cb = a.in[IN_FCB] + (size_t)layer * DFF;
    const int total = 512 * 2 * DFF;
    for (int i = blockIdx.x * NTHR + tid; i < total; i += gridDim.x * NTHR) {
        const int f = i % DFF, gr = i / DFF, grp = gr >> 1, r = gr & 1; const int t = grp * 64 + r; const bool start = (grp & 63) == 0;
        const bf16* sg = side + (size_t)grp * 6 * DFF; const bf16* sp = sg - (size_t)6 * DFF;
        const float g0 = bf2f(sg[(size_t)r * DFF + f]), u0 = bf2f(sg[(size_t)(2 + r) * DFF + f]);
        float g1, g2;
        if (r == 0) { g1 = start ? 0.f : bf2f(sp[(size_t)5 * DFF + f]); g2 = start ? 0.f : bf2f(sp[(size_t)4 * DFF + f]); }
        else { g1 = bf2f(sg[f]); g2 = start ? 0.f : bf2f(sp[(size_t)5 * DFF + f]); }
        const float c = cb[f] + cw[f] * g2 + cw[DFF + f] * g1 + cw[2 * DFF + f] * g0;
        act[(size_t)t * DFF + f] = f2bf(siluf_(c) * u0);
    }
}
__device__ __forceinline__ void phase_final_norm(const Args& a, int lane, int wave) {
    const float* ssq = (const float*)(a.ws + WS_SSQ); const float* g = a.in[IN_NOUT]; float* out = a.out; const bf16* hb = (const bf16*)(a.ws + WS_HB);
    const int gw = blockIdx.x * NWAVES + wave, NGW = gridDim.x * NWAVES;
    for (int row = gw; row < T; row += NGW) {
        float s = lane < 32 ? ssq[(size_t)row * 32 + lane] : 0.f; s = wave_sum(s);
        const float rstd = 1.0f / sqrtf(s * (1.0f / DM) + EPS);
        const u32x4* hr = (const u32x4*)(hb + (size_t)row * DM) + lane; f32x4* xr = (f32x4*)(out + (size_t)row * DM);
#pragma unroll
        for (int j = 0; j < 4; ++j) { const u32x4 w = hr[64 * j]; const int c8 = 8 * (lane + 64 * j); const f32x4 g0 = *(const f32x4*)(g + c8), g1 = *(const f32x4*)(g + c8 + 4);
            f32x4 v0 = (f32x4){__builtin_bit_cast(float, w.x << 16), __builtin_bit_cast(float, w.x & 0xffff0000u), __builtin_bit_cast(float, w.y << 16), __builtin_bit_cast(float, w.y & 0xffff0000u)};
            f32x4 v1 = (f32x4){__builtin_bit_cast(float, w.z << 16), __builtin_bit_cast(float, w.z & 0xffff0000u), __builtin_bit_cast(float, w.w << 16), __builtin_bit_cast(float, w.w & 0xffff0000u)};
            xr[c8 / 4] = v0 * rstd * g0; xr[c8 / 4 + 1] = v1 * rstd * g1; }
    }
}

#define XB_TMO      128
#define XB_XCNT(j)  (256  + 64 * (j))
#define XB_XSUB(j)  (1280 + 64 * (j))
#define XB_XGEN(j)  (2304 + 64 * (j))
#define XB_TOP      3328
#define XB_TOPGEN   3392
#define XCD_BAR_WORDS 3456
#define XB_SPIN_CAP (1u << 18)

__device__ __forceinline__ unsigned xb_ld(unsigned* p)              { return __hip_atomic_load(p, __ATOMIC_RELAXED, __HIP_MEMORY_SCOPE_AGENT); }
__device__ __forceinline__ unsigned xb_add(unsigned* p, unsigned v) { return __hip_atomic_fetch_add(p, v, __ATOMIC_RELAXED, __HIP_MEMORY_SCOPE_AGENT); }
__device__ __forceinline__ unsigned xb_xcc_id() { return (unsigned)__builtin_amdgcn_s_getreg((3 << 11) | 20) & 0xFu; }
#define XB_SPIN(cond, bar) do { unsigned _sp = 0; while (cond) { __builtin_amdgcn_s_sleep(1); \
    if ((++_sp & 255u) == 0u) { if (xb_ld(&(bar)[XB_TMO])) break; if (_sp > XB_SPIN_CAP) { atomicAdd(&(bar)[XB_TMO], 1u); break; } } } } while (0)

struct XcdBarrier {
    unsigned* bar; unsigned x;
    volatile LAS unsigned* st;
};

__device__ __forceinline__ XcdBarrier xcd_barrier_post(unsigned* bar, volatile LAS unsigned* st) {
    XcdBarrier b; b.bar = bar; b.x = xb_xcc_id(); b.st = st;
    if (threadIdx.x == 0) (void)xb_add(&bar[XB_XCNT(b.x)], 1u);
    return b;
}
__device__ __forceinline__ void xcd_barrier_complete(unsigned* bar, unsigned x, unsigned& nloc, unsigned& nx) {
    const unsigned G = gridDim.x * gridDim.y * gridDim.z;
    unsigned sum, cnt, mine, sp = 0u;
    for (;;) {
        sum = 0u; cnt = 0u; mine = 0u;
#pragma unroll
        for (unsigned j = 0; j < 16; ++j) { const unsigned c = xb_ld(&bar[XB_XCNT(j)]); sum += c; cnt += (c > 0u) ? 1u : 0u; mine = (j == x) ? c : mine; }
        if (sum == G) break;
        __builtin_amdgcn_s_sleep(1);
        if ((++sp & 255u) == 0u) { if (xb_ld(&bar[XB_TMO])) break; if (sp > XB_SPIN_CAP) { atomicAdd(&bar[XB_TMO], 1u); break; } }
    }
    nloc = mine > 0u ? mine : 1u; nx = cnt > 0u ? cnt : 1u;
}

__device__ __forceinline__ void xcd_barrier(const XcdBarrier& b) {
    asm volatile("s_waitcnt vmcnt(0)" ::: "memory");
    __syncthreads();
    if (threadIdx.x == 0) {
        unsigned* bar = b.bar;
        __builtin_amdgcn_s_waitcnt(0);
        unsigned nloc = b.st[0], nx = b.st[1];
        if (nloc == 0u) { xcd_barrier_complete(bar, b.x, nloc, nx); b.st[0] = nloc; b.st[1] = nx; }
        const unsigned old = xb_add(&bar[XB_XSUB(b.x)], 1u);
        const unsigned gen = old / nloc;
        if (old + 1u == (gen + 1u) * nloc) {
            __builtin_amdgcn_fence(__ATOMIC_RELEASE, "agent");
            asm volatile("s_waitcnt vmcnt(0)" ::: "memory");
            const unsigned og = xb_add(&bar[XB_TOP], 1u);
            const unsigned tg = og / nx;
            if (og + 1u == (tg + 1u) * nx) xb_add(&bar[XB_TOPGEN], 1u);
            else XB_SPIN(xb_ld(&bar[XB_TOPGEN]) == tg, bar);
            __builtin_amdgcn_fence(__ATOMIC_ACQUIRE, "agent");
            xb_add(&bar[XB_XGEN(b.x)], 1u);
            asm volatile("s_waitcnt vmcnt(0)" ::: "memory");
        } else {
            XB_SPIN(xb_ld(&bar[XB_XGEN(b.x)]) == gen, bar);
            __builtin_amdgcn_fence(__ATOMIC_ACQUIRE, "agent");
            asm volatile("s_waitcnt vmcnt(0)" ::: "memory");
        }
    }
    __syncthreads();
}

constexpr int NPHASES = 19;
typedef const Args __attribute__((address_space(4))) CArgs;
__device__ __forceinline__ void load_args(Args& a, CArgs* p) {
#pragma unroll
    for (int i = 0; i < 21; ++i) a.in[i] = p->in[i];
    a.out = p->out; a.ws = p->ws; a.ph_lo = p->ph_lo; a.ph_hi = p->ph_hi; }
__device__ __forceinline__ bool in_range(int k) { CArgs* p = (CArgs*)__builtin_amdgcn_kernarg_segment_ptr(); asm volatile("" : "+s"(p)); return p->ph_lo <= k && k < p->ph_hi; }
#define PHASE_BEGIN() CArgs* ap_ = (CArgs*)__builtin_amdgcn_kernarg_segment_ptr(); asm volatile("" : "+s"(ap_)); Args a; load_args(a, ap_); \
    int tid = threadIdx.x; asm volatile("" : "+v"(tid)); const int lane = tid & 63, wave = __builtin_amdgcn_readfirstlane(tid >> 6); unsigned char* ws = a.ws; const int G = gridDim.x; (void)lane; (void)wave; (void)ws; (void)G;
#ifdef ONLY_PH
#define IN(k) (((k) == ONLY_PH || ((k) >= 2 && (k) - 8 == ONLY_PH)) && in_range(k))
#else
#define IN(k) in_range(k)
#endif
#ifndef REPEAT_PH
#define REPEAT_PH -1
#endif
#define REP(k) for (int rep_ = 0; rep_ < 1 + (REPEAT_PH == (k) ? 1 : 0); ++rep_)
#define SEAM(k) do { if (IN(k) && IN((k) + 1)) { if (hi > 1000) cg::this_grid().sync(); CArgs* apb_ = (CArgs*)__builtin_amdgcn_kernarg_segment_ptr(); asm volatile("" : "+s"(apb_)); \
        XcdBarrier b_; b_.bar = (unsigned*)(apb_->ws + WS_CTL) + CW_BAR; b_.x = xb_xcc_id(); b_.st = (volatile LAS unsigned*)(lds + MISC_OFF); xcd_barrier(b_); } } while (0)
template <int layer> __device__ __forceinline__ void layer_phases(LAS unsigned char* lds, const int hi) {
        const int pb = 2 + 8 * layer;
        if (IN(pb)) REP(pb) { __syncthreads();
            PHASE_BEGIN();
            const int N = layer ? NB : NA;
            pg8::Gemm g{(const bf16*)(ws + WS_HB), (const bf16*)(ws + (layer ? WS_WIN1 : WS_WIN0)), T, N, DM}; pg8::StaticOrder S; S.init(T, N, G, (int)blockIdx.x);
            pg8::EpiScaleBf16 E{(bf16*)(ws + WS_Z), N, (const float*)(ws + WS_SSQ)};
            pg8::gemm_phase<pg8::EpiScaleBf16, pg8::StaticOrder, PG8_ALIGN, PG8_SP2>(lds, g, S, E);
        }
        SEAM(pb);
        if (layer == 0) {
            if (IN(pb + 1)) REP(pb + 1) { __syncthreads(); PHASE_BEGIN();
                const int nkv = (TM / 256) * (2048 / 256), ngs = BATCH * A_H;
                if (G >= 2 * nkv + 2 * ngs) {
                    const int bid = (int)blockIdx.x;
                    if (bid >= G - ngs) { if (wave == 0) mlstm_gate_scan(a, G - 1 - bid, lane); }
                    else if (bid >= nkv) phase_mlstm_conv(a, tid, bid - nkv, G - nkv - ngs);
                } else {
                    if (wave == 0) for (int bh = G - 1 - (int)blockIdx.x; bh < ngs; bh += G) mlstm_gate_scan(a, bh, lane);
                    phase_mlstm_conv(a, tid, (int)blockIdx.x, G);
                }
                __syncthreads();
                pg8::Gemm g{(const bf16*)(ws + WS_MEMB), (const bf16*)(ws + WS_WKV), TM, 2048, DM}; pg8::StaticOrder S; S.init(TM, 2048, G, (int)blockIdx.x);
                pg8::EpiScaleBf16 E{(bf16*)(ws + WS_KV), 2048, (const float*)(ws + WS_SSQM)};
                pg8::gemm_phase<pg8::EpiScaleBf16, pg8::StaticOrder, PG8_ALIGN, PG8_SP2>(lds, g, S, E);
            }
            SEAM(pb + 1);
        }
        if (IN(pb + 2)) REP(pb + 2) { __syncthreads(); PHASE_BEGIN();
            if (layer == 0) phase_mlstm(a, lds, tid, lane, wave);
            else {
                phase_hgrn(a, lds, tid, lane, wave);
                const int nscan = BATCH * B_H * 2;
                if (G > nscan) { if ((int)blockIdx.x >= nscan) phase_attn<1>(a, lds, tid, lane, wave, (int)blockIdx.x - nscan, G - nscan); }
                else phase_attn<1>(a, lds, tid, lane, wave, (int)blockIdx.x, G);
            } }
        SEAM(pb + 2);
        if (IN(pb + 3)) REP(pb + 3) { __syncthreads(); PHASE_BEGIN(); if (layer == 0) { phase_attn<0>(a, lds, tid, lane, wave, (int)blockIdx.x, G); phase_norm<0>(a, lane, wave); } else phase_norm<1>(a, lane, wave); }
        SEAM(pb + 3);
        if (IN(pb + 4)) REP(pb + 4) { __syncthreads();
            PHASE_BEGIN();
            pg8::Gemm g{(const bf16*)(ws + WS_YCAT), (const bf16*)(ws + (layer ? WS_WOUT1 : WS_WOUT0)), T, DM, DM}; pg8::StaticOrder S; S.init(T, DM, G, (int)blockIdx.x);
            if constexpr (layer == 0) { typedef pg8::EpiRes<false, false, true> EpiR; EpiR E{a.in[IN_X], nullptr, nullptr, (bf16*)(ws + WS_HB), (float*)(ws + WS_SSQ)};
                pg8::gemm_phase<EpiR, pg8::StaticOrder, PG8_ALIGN, PG8_SP2>(lds, g, S, E); }
            else { typedef pg8::EpiRes<true, false, true> EpiR; EpiR E{nullptr, (const bf16*)(ws + WS_HB), nullptr, (bf16*)(ws + WS_HB), (float*)(ws + WS_SSQ)};
                pg8::gemm_phase<EpiR, pg8::StaticOrder, PG8_ALIGN, PG8_SP2>(lds, g, S, E); }
        }
        SEAM(pb + 4);
        if (IN(pb + 5)) REP(pb + 5) { __syncthreads();
            PHASE_BEGIN();
            pg8::Gemm g{(const bf16*)(ws + WS_HB), (const bf16*)(ws + (layer ? WS_WUP1 : WS_WUP0)), T, 2 * DFF, DM}; pg8::StaticOrder S; S.init(T, 2 * DFF, G, (int)blockIdx.x);
            pg8::EpiUp E{(bf16*)(ws + WS_Z), (bf16*)(ws + WS_SIDE), (const float*)(ws + WS_SSQ), a.in[IN_FCW] + (size_t)layer * 3 * DFF, a.in[IN_FCB] + (size_t)layer * DFF};
            pg8::gemm_phase<pg8::EpiUp, pg8::StaticOrder, PG8_ALIGN, PG8_SP2>(lds, g, S, E);
        }
        SEAM(pb + 5);
        if (IN(pb + 6)) REP(pb + 6) { __syncthreads(); PHASE_BEGIN(); phase_ffn_fixup(a, layer, tid); }
        SEAM(pb + 6);
        if (IN(pb + 7)) REP(pb + 7) { __syncthreads();
            PHASE_BEGIN();
            pg8::Gemm g{(const bf16*)(ws + WS_Z), (const bf16*)(ws + (layer ? WS_WDN1 : WS_WDN0)), T, DM, DFF}; pg8::StaticOrder S; S.init(T, DM, G, (int)blockIdx.x);
            if constexpr (layer == 0) { typedef pg8::EpiRes<true, false, true> EpiR; EpiR E{nullptr, (const bf16*)(ws + WS_HB), nullptr, (bf16*)(ws + WS_HB), (float*)(ws + WS_SSQ)};
                pg8::gemm_phase<EpiR, pg8::StaticOrder, PG8_ALIGN, PG8_SP2>(lds, g, S, E); }
            else { typedef pg8::EpiRes<true, false, true> EpiR; EpiR E{nullptr, (const bf16*)(ws + WS_HB), nullptr, (bf16*)(ws + WS_HB), (float*)(ws + WS_SSQ)};
                pg8::gemm_phase<EpiR, pg8::StaticOrder, PG8_ALIGN, PG8_SP2>(lds, g, S, E); }
        }
        SEAM(pb + 7);
    }
__global__ void __launch_bounds__(NTHR, 2) mk_fwd(Args a_unused) {
    extern __shared__ __attribute__((aligned(16))) unsigned char lds_raw[];
    LAS unsigned char* lds = (LAS unsigned char*)lds_raw;
    int lo, hi; unsigned* barw; { CArgs* ap0 = (CArgs*)__builtin_amdgcn_kernarg_segment_ptr(); lo = ap0->ph_lo; hi = ap0->ph_hi; barw = (unsigned*)(ap0->ws + WS_CTL) + CW_BAR; }
    volatile LAS unsigned* misc = (volatile LAS unsigned*)(lds + MISC_OFF);
    if (threadIdx.x < 16) misc[threadIdx.x] = 0u;
    __syncthreads();
    if (hi - lo > 1) (void)xcd_barrier_post(barw, misc);
    if (IN(0)) REP(0) { __syncthreads(); PHASE_BEGIN(); phase_prologue(a, lds, tid, lane, wave); }
    SEAM(0);
    layer_phases<0>(lds, hi);
    layer_phases<1>(lds, hi);
    if (IN(18)) REP(18) { __syncthreads(); PHASE_BEGIN(); phase_final_norm(a, lane, wave); }
#undef IN
#undef SEAM
}

#ifndef MK_N_LAUNCHES
#define MK_N_LAUNCHES 1
#endif
extern "C" void kernel_launch(void* const* d_in, const int* in_sizes, int n_in, void* d_out, int out_size, void* d_ws, size_t ws_size, hipStream_t stream) {
    static int grid = 0;
    if (grid == 0) {
        if (n_in != 21 || in_sizes[0] != T * DM || out_size != T * DM || ws_size < WS_END) { fprintf(stderr, "kernel_launch: unexpected sizes n_in %d in0 %d out %d ws %zu (need %zu)\n", n_in, n_in > 0 ? in_sizes[0] : -1, out_size, ws_size, (size_t)WS_END); grid = -1; return; }
        int dev = 0, cus = 0, per_cu = 0;
        if (hipGetDevice(&dev) != hipSuccess || hipDeviceGetAttribute(&cus, hipDeviceAttributeMultiprocessorCount, dev) != hipSuccess) { grid = -1; return; }
        if (hipFuncSetAttribute((const void*)mk_fwd, hipFuncAttributeMaxDynamicSharedMemorySize, LDS_BYTES) != hipSuccess) { fprintf(stderr, "kernel_launch: hipFuncSetAttribute failed\n"); grid = -1; return; }
        if (hipOccupancyMaxActiveBlocksPerMultiprocessor(&per_cu, (const void*)mk_fwd, NTHR, LDS_BYTES) != hipSuccess || per_cu < 1) { fprintf(stderr, "kernel_launch: occupancy query says %d blocks per CU\n", per_cu); (void)hipGetLastError(); grid = -1; return; }
        grid = cus;
    }
    if (grid < 0) return;
    Args a{};
    for (int i = 0; i < 21; ++i) a.in[i] = (const float*)d_in[i];
    a.out = (float*)d_out; a.ws = (unsigned char*)d_ws;
#if MK_N_LAUNCHES == 1
    if (hipMemsetAsync((char*)d_ws + WS_CTL, 0, CTL_ZERO_BYTES, stream) != hipSuccess) { fprintf(stderr, "kernel_launch: memset failed\n"); return; }
    a.ph_lo = 0; a.ph_hi = NPHASES;
    void* args[] = {&a};
    hipError_t e = hipLaunchCooperativeKernel((const void*)mk_fwd, dim3(grid), dim3(NTHR), args, LDS_BYTES, stream);
    if (e != hipSuccess) fprintf(stderr, "kernel_launch: cooperative launch failed: %s (grid %d)\n", hipGetErrorString(e), grid);
#else
    for (int p = 0; p < NPHASES; ++p) { a.ph_lo = p; a.ph_hi = p + 1; hipLaunchKernelGGL(mk_fwd, dim3(grid), dim3(NTHR), LDS_BYTES, stream, a); }
#endif
}
```

```cpp
#include <hip/hip_runtime.h>
#include <hip/hip_cooperative_groups.h>
#include <cstdio>
#include <cstdint>
namespace cg = cooperative_groups;
namespace pg8 {
#define PG8_LAS __attribute__((address_space(3)))
typedef unsigned short bf16_t;
typedef short bf16x8 __attribute__((ext_vector_type(8)));
typedef float f32x4 __attribute__((ext_vector_type(4)));
typedef unsigned u32x4 __attribute__((ext_vector_type(4)));
constexpr int BM = 256, BK = 64, HALF = 128, HTB = HALF * BK * 2  , STAGE_BYTES = 8 * HTB, NXCD = 8, WGM = 8;

__host__ __device__ __forceinline__ int lds_byte(int r, int c) { const int st = (r >> 4) * 2 + (c >> 5), rr = r & 15, cc = c & 31, ob = rr * 64 + cc * 2; return st * 1024 + (ob ^ (((ob >> 9) & 1) << 5)); }
__host__ __device__ __forceinline__ void stage_rc(int b, int& R, int& C) { const int st = b / 1024, sb = b % 1024, swz = sb ^ (((sb >> 9) & 1) << 5); R = (st >> 1) * 16 + swz / 64; C = (st & 1) * 32 + (swz % 64) / 2; }
__host__ __device__ __forceinline__ int perm32(int rho) { const int n = rho >> 4, i = rho & 15; return 8 * (i >> 2) + 4 * n + (i & 3); }

struct Unit { int pm, pn; };
struct Gemm { const bf16_t* A; const bf16_t* Bt; int M, N, K; };

struct StaticOrder {
    int nM, nN, nwg, G, c;
    __host__ __device__ void init(int M, int N, int G_, int c_) { nM = M / BM; nN = N / BM; nwg = nM * nN; G = G_; c = c_; }
    __host__ __device__ bool next(int i, Unit& u) const {
        const long L = (long)i * G + c; if (L >= nwg) return false;
        int wgid = (int)L; { const int q = nwg / NXCD, r = nwg % NXCD, xcd = wgid % NXCD, off = wgid / NXCD; wgid = (xcd < r ? xcd * (q + 1) : r * (q + 1) + (xcd - r) * q) + off; }
        const int nig = WGM * nN, gid = wgid / nig, fm = gid * WGM, gsz = (nM - fm) < WGM ? (nM - fm) : WGM;
        u.pm = fm + ((wgid % nig) % gsz); u.pn = (wgid % nig) / gsz; return true;
    }
    __device__ __forceinline__ void a_ready(const Unit&) const {}
    __device__ __forceinline__ void done(const Unit&) const {}
};

__device__ __forceinline__ unsigned cvt_pk_bf16(float lo, float hi) { unsigned r; asm volatile("v_cvt_pk_bf16_f32 %0, %1, %2" : "=v"(r) : "v"(lo), "v"(hi)); return r; }
typedef unsigned u32x2 __attribute__((ext_vector_type(2)));

__device__ __forceinline__ float row_rstd(const float* ssq, int row, int fq) {
    const f32x4* p = (const f32x4*)(ssq + (size_t)row * 32 + fq * 8);
    const f32x4 a = p[0], b = p[1];
    float s = ((a[0] + a[1]) + (a[2] + a[3])) + ((b[0] + b[1]) + (b[2] + b[3]));
    s += __shfl_xor(s, 16); s += __shfl_xor(s, 32);
    return 1.0f / sqrtf(s * (1.0f / 2048.0f) + 1e-6f);
}

struct EpiScaleBf16 {
    static constexpr bool PERM = true, AFTER_DRAIN = false;
    bf16_t* O; int ldc; const float* ssq;
    __device__ __forceinline__ void operator()(f32x4 (&acc)[2][2][4][2], const Unit& u, int wr, int wc, int fr, int fq) const {
        asm volatile("" : "+v"(fr), "+v"(fq));
        const int row0 = u.pm * BM + wr * 64 + fr, col0 = u.pn * BM + wc * 32 + 8 * fq;
#pragma unroll
        for (int ai = 0; ai < 2; ++ai)
#pragma unroll
            for (int m = 0; m < 4; ++m) { const int row = row0 + ai * HALF + m * 16; const float rs = row_rstd(ssq, row, fq);
                bf16_t* rowp = O + (size_t)row * ldc + col0;
#pragma unroll
                for (int bj = 0; bj < 2; ++bj) { const f32x4 v0 = acc[ai][bj][m][0] * rs, v1 = acc[ai][bj][m][1] * rs;
                    u32x4 w; w.x = cvt_pk_bf16(v0[0], v0[1]); w.y = cvt_pk_bf16(v0[2], v0[3]); w.z = cvt_pk_bf16(v1[0], v1[1]); w.w = cvt_pk_bf16(v1[2], v1[3]);
                    *(u32x4*)(rowp + bj * HALF) = w; } }
    }
};

template <int N> __device__ __forceinline__ float dpp_shr(float v, float fill) { return __builtin_bit_cast(float, __builtin_amdgcn_update_dpp(__builtin_bit_cast(int, fill), __builtin_bit_cast(int, v), 0x110 + N, 0xf, 0xf, false)); }
struct EpiZ1 {
    static constexpr bool PERM = true, AFTER_DRAIN = false;
    bf16_t* O; int ldc; const float* ssq; const float* lbl; float* eg;
    __device__ __forceinline__ void operator()(f32x4 (&acc)[2][2][4][2], const Unit& u, int wr, int wc, int fr, int fq) const {
        asm volatile("" : "+v"(fr), "+v"(fq));
        const int row0 = u.pm * BM + wr * 64 + fr, col0 = u.pn * BM + wc * 32 + 8 * fq;
        if (u.pn < 12) {
            const int ch0 = u.pn * 128 + wc * 32 + 8 * fq;
            const int lane15 = (fq * 16) | 15;
            float lb[8];
            { const f32x4 l0 = *(const f32x4*)(lbl + ch0), l1 = *(const f32x4*)(lbl + ch0 + 4), l2 = *(const f32x4*)(lbl + 1536 + ch0), l3 = *(const f32x4*)(lbl + 1536 + ch0 + 4);
#pragma unroll
              for (int e = 0; e < 4; ++e) { lb[e] = __builtin_amdgcn_rcpf(1.0f + __expf(l0[e] - l2[e])); lb[4 + e] = __builtin_amdgcn_rcpf(1.0f + __expf(l1[e] - l3[e])); } }
#pragma unroll
            for (int ai = 0; ai < 2; ++ai) {
                float carry[8];
#pragma unroll
                for (int c = 0; c < 8; ++c) carry[c] = 1.0f;
#pragma unroll
                for (int m = 0; m < 4; ++m) { const int row = row0 + ai * HALF + m * 16; const float rs = row_rstd(ssq, row, fq);
#pragma unroll
                    for (int n = 0; n < 2; ++n)
#pragma unroll
                        for (int e = 0; e < 4; ++e) { const int c = 4 * n + e; const float qv = acc[ai][0][m][n][e] * rs, fv = acc[ai][1][m][n][e] * rs;
                            const float fg = lb[c] + (1.0f - lb[c]) * __builtin_amdgcn_rcpf(1.0f + __expf(-fv));
                            float x = fg; x *= dpp_shr<1>(x, 1.0f); x *= dpp_shr<2>(x, 1.0f); x *= dpp_shr<4>(x, 1.0f); x *= dpp_shr<8>(x, 1.0f);
                            const float tot = __shfl(x, lane15), cp = x * carry[c]; carry[c] *= tot;
                            acc[ai][0][m][n][e] = qv * __builtin_amdgcn_rcpf(1.0f + __expf(-qv)) * cp;
                            acc[ai][1][m][n][e] = (1.0f - fg) * __builtin_amdgcn_rcpf(fmaxf(cp, 1e-30f)); }
                    bf16_t* rowp = O + (size_t)row * ldc + col0;
#pragma unroll
                    for (int bj = 0; bj < 2; ++bj) { const f32x4 v0 = acc[ai][bj][m][0], v1 = acc[ai][bj][m][1];
                        u32x4 w; w.x = cvt_pk_bf16(v0[0], v0[1]); w.y = cvt_pk_bf16(v0[2], v0[3]); w.z = cvt_pk_bf16(v1[0], v1[1]); w.w = cvt_pk_bf16(v1[2], v1[3]);
                        *(u32x4*)(rowp + bj * HALF) = w; }
                    __builtin_amdgcn_sched_barrier(0); }
                if (fr == 0) { float* ep = eg + (size_t)((u.pm * BM + ai * HALF + wr * 64) >> 6) * 1536 + ch0;
                    *(f32x4*)ep = (f32x4){carry[0], carry[1], carry[2], carry[3]}; *(f32x4*)(ep + 4) = (f32x4){carry[4], carry[5], carry[6], carry[7]}; }
            }
        } else {
#pragma unroll
            for (int ai = 0; ai < 2; ++ai)
#pragma unroll
                for (int m = 0; m < 4; ++m) { const int row = row0 + ai * HALF + m * 16; const float rs = row_rstd(ssq, row, fq);
                    bf16_t* rowp = O + (size_t)row * ldc + col0;
#pragma unroll
                    for (int bj = 0; bj < 2; ++bj) { const f32x4 v0 = acc[ai][bj][m][0] * rs, v1 = acc[ai][bj][m][1] * rs;
                        u32x4 w; w.x = cvt_pk_bf16(v0[0], v0[1]); w.y = cvt_pk_bf16(v0[2], v0[3]); w.z = cvt_pk_bf16(v1[0], v1[1]); w.w = cvt_pk_bf16(v1[2], v1[3]);
                        *(u32x4*)(rowp + bj * HALF) = w; } }
        }
    }
};

template <bool BF_BASE, bool W32, bool W16> struct EpiRes {
    static constexpr bool PERM = false, AFTER_DRAIN = false;
    const float* base32; const bf16_t* base16; float* out; bf16_t* hb; float* ssq;
    __device__ __forceinline__ void operator()(f32x4 (&acc)[2][2][4][2], const Unit& u, int wr, int wc, int fr, int fq) const {
        asm volatile("" : "+v"(fr), "+v"(fq));
        const int row0 = u.pm * BM + wr * 64 + fr, col0 = u.pn * BM + wc * 32 + 4 * fq;
#pragma unroll
        for (int ai = 0; ai < 2; ++ai) {
            f32x4 b[4][2][2];
#pragma unroll
            for (int m = 0; m < 4; ++m)
#pragma unroll
                for (int bj = 0; bj < 2; ++bj)
#pragma unroll
                    for (int n = 0; n < 2; ++n) { const size_t o2 = (size_t)(row0 + ai * HALF + m * 16) * 2048 + col0 + bj * HALF + n * 16;
                        if constexpr (BF_BASE) { const u32x2 w = *(const u32x2*)(base16 + o2); b[m][bj][n] = (f32x4){__builtin_bit_cast(float, w.x << 16), __builtin_bit_cast(float, w.x & 0xffff0000u), __builtin_bit_cast(float, w.y << 16), __builtin_bit_cast(float, w.y & 0xffff0000u)}; }
                        else b[m][bj][n] = *(const f32x4*)(base32 + o2); }
#pragma unroll
            for (int m = 0; m < 4; ++m) { const int row = row0 + ai * HALF + m * 16; const size_t off = (size_t)row * 2048 + col0; float ss = 0.f;
#pragma unroll
                for (int bj = 0; bj < 2; ++bj)
#pragma unroll
                    for (int n = 0; n < 2; ++n) { const size_t o2 = off + bj * HALF + n * 16; const f32x4 o = b[m][bj][n] + acc[ai][bj][m][n];
                        ss += (o[0] * o[0] + o[1] * o[1]) + (o[2] * o[2] + o[3] * o[3]);
                        if constexpr (W32) *(f32x4*)(out + o2) = o;
                        if constexpr (W16) { u32x2 w; w.x = cvt_pk_bf16(o[0], o[1]); w.y = cvt_pk_bf16(o[2], o[3]); *(u32x2*)(hb + o2) = w; } }
                ss += __shfl_xor(ss, 16); ss += __shfl_xor(ss, 32);
                if (fq == 0) ssq[(size_t)row * 32 + u.pn * 4 + wc] = ss; }
            asm volatile("" ::: "memory");
        }
    }
};

template <int N> __device__ __forceinline__ float dpp_ror(float v) { return __builtin_bit_cast(float, __builtin_amdgcn_update_dpp(0, __builtin_bit_cast(int, v), 0x120 + N, 0xf, 0xf, false)); }
struct EpiUp {
    static constexpr bool PERM = true, AFTER_DRAIN = false;
    bf16_t* act; bf16_t* side; const float* ssq; const float* cw; const float* cb;
    __device__ __forceinline__ void operator()(f32x4 (&acc)[2][2][4][2], const Unit& u, int wr, int wc, int fr, int fq) const {
        asm volatile("" : "+v"(fr), "+v"(fq));
        const int row0 = u.pm * BM + wr * 64 + fr, f0 = u.pn * HALF + wc * 32 + 8 * fq;
#pragma unroll
        for (int ai = 0; ai < 2; ++ai) {
#pragma unroll
            for (int m = 0; m < 4; ++m) { const float rs = row_rstd(ssq, row0 + ai * HALF + m * 16, fq);
#pragma unroll
                for (int n = 0; n < 2; ++n) { acc[ai][0][m][n] = acc[ai][0][m][n] * rs; acc[ai][1][m][n] = acc[ai][1][m][n] * rs; } }
            const int grp = (u.pm * BM + ai * HALF + wr * 64) >> 6;
            if (fr < 2) { const f32x4 ga = acc[ai][1][0][0], gb = acc[ai][1][0][1], ua = acc[ai][0][0][0], ub = acc[ai][0][0][1];
                u32x4 wg, wu; wg.x = cvt_pk_bf16(ga[0], ga[1]); wg.y = cvt_pk_bf16(ga[2], ga[3]); wg.z = cvt_pk_bf16(gb[0], gb[1]); wg.w = cvt_pk_bf16(gb[2], gb[3]);
                wu.x = cvt_pk_bf16(ua[0], ua[1]); wu.y = cvt_pk_bf16(ua[2], ua[3]); wu.z = cvt_pk_bf16(ub[0], ub[1]); wu.w = cvt_pk_bf16(ub[2], ub[3]);
                *(u32x4*)(side + ((size_t)grp * 6 + fr) * 5632 + f0) = wg; *(u32x4*)(side + ((size_t)grp * 6 + 2 + fr) * 5632 + f0) = wu; }
            if (fr >= 14) { const f32x4 ga = acc[ai][1][3][0], gb = acc[ai][1][3][1];
                u32x4 wg; wg.x = cvt_pk_bf16(ga[0], ga[1]); wg.y = cvt_pk_bf16(ga[2], ga[3]); wg.z = cvt_pk_bf16(gb[0], gb[1]); wg.w = cvt_pk_bf16(gb[2], gb[3]);
                *(u32x4*)(side + ((size_t)grp * 6 + 4 + (fr - 14)) * 5632 + f0) = wg; }
        }
#pragma unroll
        for (int n = 0; n < 2; ++n) {
            const f32x4 w0 = *(const f32x4*)(cw + f0 + 4 * n), w1 = *(const f32x4*)(cw + 5632 + f0 + 4 * n), w2 = *(const f32x4*)(cw + 2 * 5632 + f0 + 4 * n), bb = *(const f32x4*)(cb + f0 + 4 * n);
#pragma unroll
            for (int ai = 0; ai < 2; ++ai)
#pragma unroll
                for (int m = 0; m < 4; ++m)
#pragma unroll
                    for (int e = 0; e < 4; ++e) { const float g0 = acc[ai][1][m][n][e], gp = acc[ai][1][m > 0 ? m - 1 : 0][n][e];
                        const float p1 = dpp_ror<1>(fr == 15 ? gp : g0), p2 = dpp_ror<2>(fr >= 14 ? gp : g0);
                        const float c = bb[e] + w0[e] * p2 + w1[e] * p1 + w2[e] * g0;
                        acc[ai][0][m][n][e] = c * __builtin_amdgcn_rcpf(1.0f + __expf(-c)) * acc[ai][0][m][n][e]; }
        }
#pragma unroll
        for (int ai = 0; ai < 2; ++ai)
#pragma unroll
            for (int m = 0; m < 4; ++m) { const int row = row0 + ai * HALF + m * 16; const f32x4 oa = acc[ai][0][m][0], ob = acc[ai][0][m][1];
                u32x4 w; w.x = cvt_pk_bf16(oa[0], oa[1]); w.y = cvt_pk_bf16(oa[2], oa[3]); w.z = cvt_pk_bf16(ob[0], ob[1]); w.w = cvt_pk_bf16(ob[2], ob[3]);
                *(u32x4*)(act + (size_t)row * 5632 + f0) = w; }
    }
};

template <class Epi, class Sched, bool ALIGN_EPI = false, bool SP2 = false>
__device__ __forceinline__ void gemm_phase(PG8_LAS unsigned char* lds, const Gemm g, const Sched& S, const Epi& E) {
    const int tid = threadIdx.x, wid = __builtin_amdgcn_readfirstlane(tid >> 6), lane = tid & 63, wr = wid >> 2, wc = wid & 3, fr = lane & 15, fq = lane >> 4;
    const int K = g.K, nt = K / BK;
    unsigned voffA[2], voffB[2];
#pragma unroll
    for (int i = 0; i < 2; ++i) { int R, C; stage_rc(tid * 16 + i * 8192, R, C); const int Rb = Epi::PERM ? ((R & ~31) + perm32(R & 31)) : R;
        voffA[i] = (unsigned)(R * K + C) * 2u; voffB[i] = (unsigned)(Rb * K + C) * 2u; }
    const size_t kstep = (size_t)(BK * 2);
    const size_t hstep = (size_t)HALF * K * 2;
    const size_t tstep = 2 * hstep;
    const unsigned ldsw = (unsigned)wid * 1024u;
    const int aoff = lds_byte(wr * 64 + fr, fq * 8), boff = lds_byte(wc * 32 + fr, fq * 8);
#define PG8_SA(b, h) (((b) * 2 + (h)) * HTB)
#define PG8_SB(b, h) ((4 + (b) * 2 + (h)) * HTB)
#define PG8_STAGE(bufoff, gbase, voff) do { _Pragma("unroll") for (int _i = 0; _i < 2; ++_i) \
        __builtin_amdgcn_global_load_lds((const unsigned*)((const char*)(gbase) + (voff)[_i]), (PG8_LAS unsigned*)(lds + (bufoff) + ldsw + _i * 8192), 16, 0, 0); } while (0)
#define PG8_LDA(dst, b, h) do { _Pragma("unroll") for (int m = 0; m < 4; ++m) _Pragma("unroll") for (int k = 0; k < 2; ++k) dst[m][k] = *(const PG8_LAS bf16x8*)(lds + PG8_SA(b, h) + aoff + m * 2048 + k * 1024); } while (0)
#define PG8_LDB(dst, b, h) do { _Pragma("unroll") for (int n = 0; n < 2; ++n) _Pragma("unroll") for (int k = 0; k < 2; ++k) dst[n][k] = *(const PG8_LAS bf16x8*)(lds + PG8_SB(b, h) + boff + n * 2048 + k * 1024); } while (0)
#define PG8_MMA(ai, bj, At, Bt) do { __builtin_amdgcn_s_setprio(1); _Pragma("unroll") for (int m = 0; m < 4; ++m) _Pragma("unroll") for (int n = 0; n < 2; ++n) _Pragma("unroll") for (int k = 0; k < 2; ++k) \
        acc[ai][bj][m][n] = __builtin_amdgcn_mfma_f32_16x16x32_bf16(Bt[n][k], At[m][k], acc[ai][bj][m][n], 0, 0, 0); __builtin_amdgcn_s_setprio(0); } while (0)
#define PG8_WAIT_V(n) asm volatile("s_waitcnt vmcnt(" #n ")" ::: "memory")
#define PG8_WAIT_L(n) asm volatile("s_waitcnt lgkmcnt(" #n ")" ::: "memory")
#define PG8_BAR __builtin_amdgcn_s_barrier()
#define PG8_SCHED __builtin_amdgcn_sched_barrier(0)
    Unit cur, nxt; int ui = 0;
    if (!S.next(0, cur)) return;
    f32x4 acc[2][2][4][2];
#pragma unroll
    for (int a = 0; a < 2; ++a)
#pragma unroll
        for (int b = 0; b < 2; ++b)
#pragma unroll
            for (int m = 0; m < 4; ++m)
#pragma unroll
                for (int n = 0; n < 2; ++n) acc[a][b][m][n] = (f32x4){0.f, 0.f, 0.f, 0.f};
    bf16x8 At[4][2], B0[2][2], B1[2][2];
    const char* cA = (const char*)g.A + (size_t)cur.pm * tstep; const char* cB = (const char*)g.Bt + (size_t)cur.pn * tstep;
    S.a_ready(cur);
    if constexpr (SP2) {
        PG8_STAGE(PG8_SB(0, 0), cB, voffB); PG8_STAGE(PG8_SB(0, 1), cB + hstep, voffB); PG8_STAGE(PG8_SA(0, 0), cA, voffA); PG8_STAGE(PG8_SA(0, 1), cA + hstep, voffA);
        if (wr == 1) PG8_BAR;
        PG8_WAIT_V(2); PG8_BAR;
        PG8_STAGE(PG8_SB(1, 0), cB + kstep, voffB); PG8_STAGE(PG8_SA(1, 0), cA + kstep, voffA); PG8_STAGE(PG8_SB(1, 1), cB + hstep + kstep, voffB);
        PG8_WAIT_V(6); PG8_BAR;
    } else {
        PG8_STAGE(PG8_SB(0, 0), cB, voffB); PG8_STAGE(PG8_SA(0, 0), cA, voffA); PG8_STAGE(PG8_SB(0, 1), cB + hstep, voffB); PG8_STAGE(PG8_SA(0, 1), cA + hstep, voffA);
        if (wr == 1) PG8_BAR;
        PG8_WAIT_V(4); PG8_BAR;
        PG8_STAGE(PG8_SB(1, 0), cB + kstep, voffB); PG8_STAGE(PG8_SA(1, 0), cA + kstep, voffA); PG8_STAGE(PG8_SB(1, 1), cB + hstep + kstep, voffB);
        PG8_WAIT_V(6); PG8_BAR;
    }
    for (;;) {
        const bool has_next = S.next(ui + 1, nxt);
        const char* nA = has_next ? (const char*)g.A + (size_t)nxt.pm * tstep : cA; const char* nB = has_next ? (const char*)g.Bt + (size_t)nxt.pn * tstep : cB;
        for (int t = 0; t < nt; t += 2) {
            const bool last = (t == nt - 2);
            const char* a1 = cA + (size_t)(t + 1) * kstep;
            const char* a2 = last ? nA : cA + (size_t)(t + 2) * kstep; const char* b2 = last ? nB : cB + (size_t)(t + 2) * kstep;
            const char* a3 = a2 + kstep; const char* b3 = b2 + kstep;
            if (last && has_next) S.a_ready(nxt);
            if constexpr (SP2) {
            PG8_LDB(B0, 0, 0); PG8_LDB(B1, 0, 1); PG8_SCHED; PG8_LDA(At, 0, 0); PG8_STAGE(PG8_SA(1, 1), a1 + hstep, voffA);
            PG8_WAIT_V(8); PG8_WAIT_L(0); PG8_BAR; PG8_MMA(0, 0, At, B0); PG8_MMA(0, 1, At, B1); PG8_BAR; PG8_SCHED;
            PG8_LDA(At, 0, 1); PG8_STAGE(PG8_SB(0, 0), b2, voffB); PG8_STAGE(PG8_SB(0, 1), b2 + hstep, voffB); PG8_STAGE(PG8_SA(0, 0), a2, voffA);
            PG8_WAIT_V(8); PG8_WAIT_L(0); PG8_BAR; PG8_MMA(1, 0, At, B0); PG8_MMA(1, 1, At, B1); PG8_BAR; PG8_SCHED;
            PG8_LDB(B0, 1, 0); PG8_LDB(B1, 1, 1); PG8_SCHED; PG8_LDA(At, 1, 0); PG8_STAGE(PG8_SA(0, 1), a2 + hstep, voffA);
            PG8_WAIT_V(8); PG8_WAIT_L(0); PG8_BAR; PG8_MMA(0, 0, At, B0); PG8_MMA(0, 1, At, B1); PG8_BAR; PG8_SCHED;
            PG8_LDA(At, 1, 1); PG8_STAGE(PG8_SB(1, 0), b3, voffB); PG8_STAGE(PG8_SB(1, 1), b3 + hstep, voffB); PG8_STAGE(PG8_SA(1, 0), a3, voffA);
            PG8_WAIT_V(8); PG8_WAIT_L(0); PG8_BAR; PG8_MMA(1, 0, At, B0); PG8_MMA(1, 1, At, B1); PG8_BAR; PG8_SCHED;
            } else {
            PG8_LDB(B0, 0, 0); PG8_SCHED; PG8_LDA(At, 0, 0); PG8_STAGE(PG8_SA(1, 1), a1 + hstep, voffA);
            PG8_WAIT_L(8); PG8_BAR; PG8_WAIT_L(0); PG8_MMA(0, 0, At, B0); PG8_BAR; PG8_SCHED;
            PG8_LDB(B1, 0, 1); PG8_STAGE(PG8_SB(0, 0), b2, voffB);
            PG8_BAR; PG8_WAIT_L(0); PG8_MMA(0, 1, At, B1); PG8_BAR;
            PG8_LDA(At, 0, 1); PG8_STAGE(PG8_SA(0, 0), a2, voffA);
            PG8_BAR; PG8_WAIT_L(0); PG8_MMA(1, 0, At, B0); PG8_BAR; PG8_SCHED;
            PG8_STAGE(PG8_SB(0, 1), b2 + hstep, voffB);
            PG8_WAIT_V(6); PG8_BAR; PG8_MMA(1, 1, At, B1); PG8_BAR;
            PG8_LDB(B0, 1, 0); PG8_SCHED; PG8_LDA(At, 1, 0); PG8_STAGE(PG8_SA(0, 1), a2 + hstep, voffA);
            PG8_WAIT_L(8); PG8_BAR; PG8_WAIT_L(0); PG8_MMA(0, 0, At, B0); PG8_BAR; PG8_SCHED;
            PG8_LDB(B1, 1, 1); PG8_STAGE(PG8_SB(1, 0), b3, voffB);
            PG8_BAR; PG8_WAIT_L(0); PG8_MMA(0, 1, At, B1); PG8_BAR;
            PG8_LDA(At, 1, 1); PG8_STAGE(PG8_SA(1, 0), a3, voffA);
            PG8_BAR; PG8_WAIT_L(0); PG8_MMA(1, 0, At, B0); PG8_BAR; PG8_SCHED;
            PG8_STAGE(PG8_SB(1, 1), b3 + hstep, voffB);
            PG8_WAIT_V(6); PG8_BAR; PG8_MMA(1, 1, At, B1); PG8_BAR;
            }
        }
        if constexpr (ALIGN_EPI) { if (wr == 0) PG8_BAR; }
        if constexpr (!Epi::AFTER_DRAIN) { E(acc, cur, wr, wc, fr, fq); S.done(cur); }
        if (!has_next) break;
#pragma unroll
        for (int a = 0; a < 2; ++a)
#pragma unroll
            for (int b = 0; b < 2; ++b)
#pragma unroll
                for (int m = 0; m < 4; ++m)
#pragma unroll
                    for (int n = 0; n < 2; ++n) acc[a][b][m][n] = (f32x4){0.f, 0.f, 0.f, 0.f};
        cur = nxt; cA = nA; cB = nB; ++ui;
        if constexpr (ALIGN_EPI) { if (wr == 1) PG8_BAR; }
    }
    PG8_WAIT_V(0);
    if constexpr (!ALIGN_EPI) { if (wr == 0) PG8_BAR; }
    PG8_BAR;
    if constexpr (Epi::AFTER_DRAIN) { E.fused(acc, cur, wr, wc, fr, fq, lds, wid, lane); S.done(cur); }
#undef PG8_SA
#undef PG8_SB
#undef PG8_STAGE
#undef PG8_LDA
#undef PG8_LDB
#undef PG8_MMA
#undef PG8_WAIT_V
#undef PG8_WAIT_L
#undef PG8_BAR
#undef PG8_SCHED
}
}

#ifndef PG8_SP2
#define PG8_SP2 true
#endif
#ifndef PG8_ALIGN
#define PG8_ALIGN true
#endif
constexpr int NWAVES = 8, NTHR = 512;
constexpr int BATCH = 8, SEQ = 4096, DM = 2048, T = BATCH * SEQ, MEMLEN = 256, TM = BATCH * MEMLEN;
constexpr int XAW = 512, XAH = 4, XAD = 128, MIXW = 1536;
constexpr int A_H = 4, A_DV = 384, A_DK = 192;
constexpr int B_H = 12, B_DK = 128, B_DV = 128;
constexpr int DFF = 5632;
constexpr int COLS_A = 5128, NA = 5120, NB = 6656;
constexpr int ZA_K = 768, ZA_V = 1536, ZA_O = 3072, ZA_XQ = 4608;
constexpr int ZB_F = 1536, ZB_I = 3072, ZB_G = 4608, ZB_XQ = 6144;
constexpr float EPS = 1e-6f;

constexpr size_t MiB = 1u << 20;
constexpr size_t WS_CTL = 0, WS_GATES = 1 * MiB, WS_SSQ = 2 * MiB, WS_SSQM = 6 * MiB, WS_MEMB = 8 * MiB, WS_KV = 16 * MiB, WS_SIDE = 24 * MiB;
constexpr size_t WS_WIN0 = 58 * MiB, WS_WOUT0 = 78 * MiB, WS_WUP0 = 86 * MiB, WS_WDN0 = 130 * MiB, WS_WIN1 = 152 * MiB, WS_WOUT1 = 178 * MiB, WS_WUP1 = 186 * MiB, WS_WDN1 = 230 * MiB, WS_WKV = 252 * MiB;
constexpr size_t WS_HRAW1 = WS_SIDE;
constexpr size_t WS_HB = 260 * MiB, WS_YCAT = 388 * MiB, WS_Z = 516 * MiB, WS_G5 = 932 * MiB, WS_END = 936 * MiB;
static_assert(WS_SIDE + (size_t)512 * 6 * DFF * 2 <= WS_WIN0 && WS_WIN0 + (size_t)NA * DM * 2 <= WS_WOUT0 && WS_WOUT0 + (size_t)DM * DM * 2 <= WS_WUP0 && WS_WUP0 + (size_t)2 * DFF * DM * 2 <= WS_WDN0 && WS_WDN0 + (size_t)DM * DFF * 2 <= WS_WIN1 &&
              WS_WIN1 + (size_t)NB * DM * 2 <= WS_WOUT1 && WS_WOUT1 + (size_t)DM * DM * 2 <= WS_WUP1 && WS_WUP1 + (size_t)2 * DFF * DM * 2 <= WS_WDN1 && WS_WDN1 + (size_t)DM * DFF * 2 <= WS_WKV && WS_WKV + (size_t)2048 * DM * 2 <= WS_HB &&
              WS_HRAW1 + (size_t)T * MIXW * 2 <= WS_WIN1 && WS_HB + (size_t)T * DM * 2 <= WS_YCAT && WS_YCAT + (size_t)T * DM * 2 <= WS_Z && WS_Z + (size_t)T * NB * 2 <= WS_G5, "d_ws map");
constexpr int LDS_BYTES = 160 * 1024, MISC_OFF = LDS_BYTES - 64;
constexpr size_t CTL_ZERO_BYTES = 65536;
constexpr int CW_BAR = 1024;

#define LAS __attribute__((address_space(3)))
typedef unsigned short bf16;
typedef float f32x4 __attribute__((ext_vector_type(4)));
typedef short bf16x8 __attribute__((ext_vector_type(8)));
typedef unsigned u32x4 __attribute__((ext_vector_type(4)));
typedef unsigned u32x2 __attribute__((ext_vector_type(2)));

typedef __bf16 bf16v2 __attribute__((ext_vector_type(2)));
__device__ __forceinline__ unsigned short f2bf(float f) { const __bf16 b = (__bf16)f; return __builtin_bit_cast(unsigned short, b); }
__device__ __forceinline__ unsigned pk2(float lo, float hi) { bf16v2 v; v[0] = (__bf16)lo; v[1] = (__bf16)hi; return __builtin_bit_cast(unsigned, v); }
__device__ __forceinline__ float bf2f(unsigned short b) { return __builtin_bit_cast(float, (unsigned)b << 16); }
__device__ __forceinline__ float wave_sum(float v) {
#pragma unroll
    for (int o = 1; o < 64; o <<= 1) v += __shfl_xor(v, o);
    return v;
}
__device__ __forceinline__ float sigmoidf_(float x) { return __builtin_amdgcn_rcpf(1.0f + __expf(-x)); }
__device__ __forceinline__ float siluf_(float x) { return x * __builtin_amdgcn_rcpf(1.0f + __expf(-x)); }

template <int KS> struct Frag { bf16x8 v[KS]; };
template <int KS> __device__ __forceinline__ void ldfrag(Frag<KS>& f, const LAS bf16* p, int ld, int fr, int fq) {
    const LAS bf16* q = p + fr * ld + fq * 8;
#pragma unroll
    for (int k = 0; k < KS; ++k) f.v[k] = *(const LAS bf16x8*)(q + 32 * k);
}
typedef short s16x4 __attribute__((ext_vector_type(4)));
template <int KS> __device__ __forceinline__ void ldfrag_tr(Frag<KS>& f, const LAS bf16* X, int ld, int c0, int fr, int fq) {
    const LAS bf16* q = X + (8 * fq + (fr >> 2)) * ld + c0 + 4 * (fr & 3);
#pragma unroll
    for (int k = 0; k < KS; ++k) { const s16x4 lo = __builtin_amdgcn_ds_read_tr16_b64_v4i16((LAS s16x4*)(q + 32 * k * ld)), hi = __builtin_amdgcn_ds_read_tr16_b64_v4i16((LAS s16x4*)(q + (32 * k + 4) * ld));
        f.v[k] = (bf16x8){lo[0], lo[1], lo[2], lo[3], hi[0], hi[1], hi[2], hi[3]}; }
}
template <int KS> __device__ __forceinline__ void ldfrag_trp(Frag<KS>& f, const LAS bf16* X, int ld, int c0, int fr, int fq) {
    const LAS bf16* q = X + (4 * fq + (fr >> 2)) * ld + c0 + 4 * (fr & 3);
#pragma unroll
    for (int k = 0; k < KS; ++k) { const s16x4 lo = __builtin_amdgcn_ds_read_tr16_b64_v4i16((LAS s16x4*)(q + 32 * k * ld)), hi = __builtin_amdgcn_ds_read_tr16_b64_v4i16((LAS s16x4*)(q + (32 * k + 16) * ld));
        f.v[k] = (bf16x8){lo[0], lo[1], lo[2], lo[3], hi[0], hi[1], hi[2], hi[3]}; }
}
template <int KS> __device__ __forceinline__ f32x4 mmaf(const Frag<KS>& a, const Frag<KS>& b, f32x4 acc) {
#pragma unroll
    for (int k = 0; k < KS; ++k) acc = __builtin_amdgcn_mfma_f32_16x16x32_bf16(a.v[k], b.v[k], acc, 0, 0, 0);
    return acc;
}
struct Args { const float* in[21]; float* out; unsigned char* ws; int ph_lo, ph_hi; };
enum { IN_X = 0, IN_MEM, IN_NMIX, IN_NMEM, IN_NFFN, IN_NOUT, IN_WKV, IN_AWIN, IN_AGB, IN_ACW, IN_ACB, IN_AHG, IN_AWOUT, IN_BWIN, IN_BLB, IN_BHG, IN_BWOUT, IN_FUP, IN_FCW, IN_FCB, IN_FDN };

struct WDesc { const float* src; bf16* dst; const float* scale; int K, Nsrc, Ndst, kind; };
__device__ __forceinline__ int src_col(int kind, int n) {
    if (kind == 1) return n < 4608 ? n : n + 8;
    if (kind == 2) { const int pn = n >> 8, r = n & 255; return (r >> 7) * DFF + pn * 128 + (r & 127); }
    if (kind == 3) { if (n >= 2 * MIXW) return n; const int hh = n >> 8, r = n & 255; return (r >> 7) * MIXW + hh * 128 + (r & 127); }
    return n;
}
__device__ __forceinline__ WDesc get_wdesc(const Args& a, int i) {
    unsigned char* ws = a.ws; WDesc d;
    switch (i) {
    case 0:  d = WDesc{a.in[IN_AWIN], (bf16*)(ws + WS_WIN0), a.in[IN_NMIX], DM, COLS_A, NA, 1}; break;
    case 1:  d = WDesc{a.in[IN_BWIN], (bf16*)(ws + WS_WIN1), a.in[IN_NMIX] + DM, DM, NB, NB, 3}; break;
    case 2:  d = WDesc{a.in[IN_AWOUT], (bf16*)(ws + WS_WOUT0), nullptr, DM, DM, DM, 0}; break;
    case 3:  d = WDesc{a.in[IN_BWOUT], (bf16*)(ws + WS_WOUT1), nullptr, DM, DM, DM, 0}; break;
    case 4:  d = WDesc{a.in[IN_FUP], (bf16*)(ws + WS_WUP0), a.in[IN_NFFN], DM, 2 * DFF, 2 * DFF, 2}; break;
    case 5:  d = WDesc{a.in[IN_FUP] + (size_t)DM * 2 * DFF, (bf16*)(ws + WS_WUP1), a.in[IN_NFFN] + DM, DM, 2 * DFF, 2 * DFF, 2}; break;
    case 6:  d = WDesc{a.in[IN_FDN], (bf16*)(ws + WS_WDN0), nullptr, DFF, DM, DM, 0}; break;
    case 7:  d = WDesc{a.in[IN_FDN] + (size_t)DFF * DM, (bf16*)(ws + WS_WDN1), nullptr, DFF, DM, DM, 0}; break;
    case 8:  d = WDesc{a.in[IN_WKV], (bf16*)(ws + WS_WKV), a.in[IN_NMEM], DM, 1024, 1024, 0}; break;
    default: d = WDesc{a.in[IN_WKV] + (size_t)DM * 1024, (bf16*)(ws + WS_WKV) + (size_t)1024 * DM, a.in[IN_NMEM] + DM, DM, 1024, 1024, 0}; break;
    }
    return d;
}
struct WTile { const float* src; bf16* dst; const float* scale; int K, Nsrc; };
__device__ __forceinline__ bool wtile_get(const Args& a, int it, WTile& t, int lane) {
    int base = 0;
#pragma unroll 1
    for (int wi = 0; wi < 10; ++wi) { const WDesc d = get_wdesc(a, wi); const int nnb = d.Ndst / 256, nit = (d.K / 64) * nnb;
        if (it < base + nit) { const int r = it - base, kb = r / nnb, nb = r - kb * nnb, k0 = 64 * kb, n0 = 256 * nb;
            const int sc = src_col(d.kind, n0 + 128 * (lane >> 5)) + 4 * (lane & 31);
            t.src = d.src + (size_t)k0 * d.Nsrc + sc; t.dst = d.dst + (size_t)n0 * d.K + k0; t.scale = d.scale ? d.scale + k0 : nullptr; t.K = d.K; t.Nsrc = d.Nsrc; return true; }
        base += nit; }
    return false;
}
constexpr int WT_ITEMS = (DM / 64) * (NA / 256) + (DM / 64) * (NB / 256) + 2 * (DM / 64) * (DM / 256) + 2 * (DM / 64) * (2 * DFF / 256) + 2 * (DFF / 64) * (DM / 256) + 2 * (DM / 64) * (1024 / 256);
__device__ __forceinline__ void phase_prologue(const Args& a, LAS unsigned char* lds, int tid, int lane, int wave) {
    unsigned char* ws = a.ws;
    LAS float* wg = (LAS float*)lds;
    { const float* W = a.in[IN_AWIN]; const float* g = a.in[IN_NMIX];
      for (int i = tid; i < DM * 8; i += NTHR) { const int k = i >> 3, j = i & 7; wg[j * DM + k] = W[(size_t)k * COLS_A + 4608 + j] * g[k]; } }
    __syncthreads();
    const int gw = blockIdx.x * NWAVES + wave, NGW = gridDim.x * NWAVES;
    { const float* x = a.in[IN_X]; bf16* hb = (bf16*)(ws + WS_HB); float* ssq = (float*)(ws + WS_SSQ); float* gates = (float*)(ws + WS_GATES); const float* gb = a.in[IN_AGB];
      for (int row = gw; row < T; row += NGW) {
        const f32x4* xr = (const f32x4*)(x + (size_t)row * DM) + lane; f32x4 v[8]; float s = 0.f;
#pragma unroll
        for (int j = 0; j < 8; ++j) { v[j] = xr[64 * j]; s += (v[j][0] * v[j][0] + v[j][1] * v[j][1]) + (v[j][2] * v[j][2] + v[j][3] * v[j][3]); }
        s = wave_sum(s);
        u32x2* o8 = (u32x2*)(hb + (size_t)row * DM) + lane;
#pragma unroll
        for (int j = 0; j < 8; ++j) { u32x2 w; w.x = pk2(v[j][0], v[j][1]); w.y = pk2(v[j][2], v[j][3]); o8[64 * j] = w; }
        float mine = 0.f;
#pragma unroll 1
        for (int q = 0; q < 8; ++q) { float t = 0.f;
#pragma unroll
            for (int j = 0; j < 8; ++j) { const f32x4 w = *(const LAS f32x4*)(wg + q * DM + 256 * j + 4 * lane); t += (v[j][0] * w[0] + v[j][1] * w[1]) + (v[j][2] * w[2] + v[j][3] * w[3]); }
            t = wave_sum(t); mine = (lane == q) ? t : mine; }
        const float rstd = 1.0f / sqrtf(s * (1.0f / DM) + EPS);
        if (lane < 32) ssq[(size_t)row * 32 + lane] = lane == 0 ? s : 0.f;
        if (lane < 8) { float pre = mine * rstd + gb[lane]; if (lane >= 4) pre = fminf(pre, 0.f) - log1pf(__expf(-fabsf(pre))); gates[(size_t)row * 8 + lane] = pre; }
      } }
    { const float* x = a.in[IN_MEM]; bf16* mb = (bf16*)(ws + WS_MEMB); float* ssq = (float*)(ws + WS_SSQM);
      for (int row = gw; row < TM; row += NGW) {
        const f32x4* xr = (const f32x4*)(x + (size_t)row * DM) + lane; f32x4 v[8]; float s = 0.f;
#pragma unroll
        for (int j = 0; j < 8; ++j) { v[j] = xr[64 * j]; s += (v[j][0] * v[j][0] + v[j][1] * v[j][1]) + (v[j][2] * v[j][2] + v[j][3] * v[j][3]); }
        s = wave_sum(s);
        u32x2* o8 = (u32x2*)(mb + (size_t)row * DM) + lane;
#pragma unroll
        for (int j = 0; j < 8; ++j) { u32x2 w; w.x = pk2(v[j][0], v[j][1]); w.y = pk2(v[j][2], v[j][3]); o8[64 * j] = w; }
        if (lane < 32) ssq[(size_t)row * 32 + lane] = lane == 0 ? s : 0.f;
      } }
    __syncthreads();
    {   LAS float* tile0 = (LAS float*)lds;
        f32x4 pf[8]; WTile cur, nxt; int it = blockIdx.x; bool have = wtile_get(a, it, cur, lane);
        if (have) {
#pragma unroll
            for (int i = 0; i < 8; ++i) pf[i] = *(const f32x4*)(cur.src + (size_t)(8 * wave + i) * cur.Nsrc); }
        int buf = 0;
        while (have) {
            LAS float* tl = tile0 + buf * (64 * 260);
#pragma unroll
            for (int i = 0; i < 8; ++i) { f32x4 v = pf[i]; if (cur.scale) v = v * cur.scale[8 * wave + i]; *(LAS f32x4*)(tl + (8 * wave + i) * 260 + 4 * lane) = v; }
            const bool have_n = wtile_get(a, it + (int)gridDim.x, nxt, lane);
            if (have_n) {
#pragma unroll
                for (int i = 0; i < 8; ++i) pf[i] = *(const f32x4*)(nxt.src + (size_t)(8 * wave + i) * nxt.Nsrc); }
            __syncthreads();
#pragma unroll
            for (int j = 0; j < 4; ++j) { const int n = lane + 64 * j; const LAS float* sp = tl + (8 * wave) * 260 + n;
                u32x4 o; o.x = pk2(sp[0], sp[260]); o.y = pk2(sp[2 * 260], sp[3 * 260]); o.z = pk2(sp[4 * 260], sp[5 * 260]); o.w = pk2(sp[6 * 260], sp[7 * 260]);
                *(u32x4*)(cur.dst + (size_t)n * cur.K + 8 * wave) = o; }
            cur = nxt; have = have_n; it += gridDim.x; buf ^= 1;
        }
    }
}

#ifndef HGRN_DUP
#define HGRN_DUP 0
#endif
#ifndef MLSTM_DUP
#define MLSTM_DUP 0
#endif
__device__ __forceinline__ void mlstm_gate_scan(const Args& a, int bh, int lane) {
    const float* gates = (const float*)(a.ws + WS_GATES); float* g5 = (float*)(a.ws + WS_G5);
    const int b = bh >> 2, h = bh & 3; float m_st = 0.f;
    const float* gp = gates + ((size_t)b * SEQ + lane) * 8 + h;
    float pig[8], plf[8];
#pragma unroll
    for (int j = 0; j < 8; ++j) { pig[j] = gp[(size_t)64 * j * 8]; plf[j] = gp[(size_t)64 * j * 8 + 4]; }
    for (int c0 = 0; c0 < SEQ / 64; c0 += 8) {
#pragma unroll
        for (int j = 0; j < 8; ++j) {
            const int c = c0 + j; const size_t t = (size_t)b * SEQ + 64 * c + lane;
            const float ig = pig[j], lf = plf[j];
            if (c + 8 < SEQ / 64) { pig[j] = gp[(size_t)64 * (c + 8) * 8]; plf[j] = gp[(size_t)64 * (c + 8) * 8 + 4]; }
            float g = lf;
#pragma unroll
            for (int o = 1; o < 64; o <<= 1) { const float x = __shfl_up(g, o); if (lane >= o) g += x; }
            const float u = ig - g; float pm = u;
#pragma unroll
            for (int o = 1; o < 64; o <<= 1) { const float x = __shfl_up(pm, o); if (lane >= o) pm = fmaxf(pm, x); }
            const float M = fmaxf(m_st, pm), M63 = __shfl(M, 63), g63 = __shfl(g, 63);
            f32x4 o0, o1; o0[0] = u; o0[1] = M; o0[2] = __expf(m_st - M); o0[3] = __expf(u - M63); o1[0] = __expf(-(g + M)); o1[1] = __expf(m_st - M63); o1[2] = 0.f; o1[3] = 0.f;
            f32x4* dst = (f32x4*)(g5 + (t * 4 + h) * 8); dst[0] = o0; dst[1] = o1;
            m_st = g63 + M63;
        }
    }
}
__device__ __forceinline__ void phase_mlstm_conv(const Args& a, int tid, int first, int stride) {
    const bf16* Z = (const bf16*)(a.ws + WS_Z); bf16* QK = (bf16*)(a.ws + WS_YCAT);
    if (tid >= 384) return;
    const int cg = tid % 192, rg2 = tid / 192, c0 = cg * 8; const float osc = cg >= 96 ? 0.07216878364870322f : 1.0f;
    float w[4][8], bias[8];
    { const float* cw = a.in[IN_ACW]; const float* cb = a.in[IN_ACB];
#pragma unroll
      for (int k = 0; k < 4; ++k) { const f32x4 x0 = *(const f32x4*)(cw + k * 1536 + c0), x1 = *(const f32x4*)(cw + k * 1536 + c0 + 4);
#pragma unroll
          for (int e = 0; e < 4; ++e) { w[k][e] = x0[e]; w[k][4 + e] = x1[e]; } }
      const f32x4 b0 = *(const f32x4*)(cb + c0), b1 = *(const f32x4*)(cb + c0 + 4);
#pragma unroll
      for (int e = 0; e < 4; ++e) { bias[e] = b0[e]; bias[4 + e] = b1[e]; } }
    for (int it = first; it < T / 16; it += stride) {
        const int t0 = it * 16 + rg2 * 8; const bool start = (t0 % SEQ) == 0;
        float x[11][8];
#pragma unroll
        for (int r = 0; r < 11; ++r) { u32x4 v = (u32x4){0u, 0u, 0u, 0u}; if (r >= 3 || !start) v = *(const u32x4*)(Z + (size_t)(t0 - 3 + r) * NA + c0);
            const unsigned vv[4] = {v.x, v.y, v.z, v.w};
#pragma unroll
            for (int e = 0; e < 4; ++e) { x[r][2 * e] = bf2f((bf16)(vv[e] & 0xffffu)); x[r][2 * e + 1] = bf2f((bf16)(vv[e] >> 16)); } }
#pragma unroll
        for (int r = 0; r < 8; ++r) { float y[8];
#pragma unroll
            for (int e = 0; e < 8; ++e) { const float c = bias[e] + w[0][e] * x[r][e] + w[1][e] * x[r + 1][e] + w[2][e] * x[r + 2][e] + w[3][e] * x[r + 3][e]; y[e] = siluf_(c) * osc; }
            u32x4 o; o.x = pk2(y[0], y[1]); o.y = pk2(y[2], y[3]); o.z = pk2(y[4], y[5]); o.w = pk2(y[6], y[7]);
            *(u32x4*)(QK + (size_t)(t0 + r) * MIXW + c0) = o; }
    }
}
__device__ __forceinline__ void phase_mlstm(const Args& a, LAS unsigned char* lds, int tid, int lane, int wave) {
    unsigned char* ws = a.ws;
    const bf16* Z = (const bf16*)(ws + WS_Z); const bf16* QK = (const bf16*)(ws + WS_YCAT); const float* g5 = (const float*)(ws + WS_G5); bf16* hraw = (bf16*)(ws + WS_HB);
    LAS bf16* Qs = (LAS bf16*)lds;
    LAS bf16* Ks = (LAS bf16*)(lds + 25600);
    LAS bf16* Vs = (LAS bf16*)(lds + 51200);
    LAS bf16* VWs = (LAS bf16*)(lds + 60416);
    LAS bf16* Ps = (LAS bf16*)(lds + 69632);
    LAS bf16* CT0 = (LAS bf16*)(lds + 78848);
    LAS float* fu = (LAS float*)(lds + 130048);
    LAS float* fM = fu + 64; LAS float* fwi = fu + 128; LAS float* fem = fu + 192; LAS float* fdec = fu + 256;
    const int fr = lane & 15, fq = lane >> 4;
    for (int item = blockIdx.x; item < BATCH * A_H * 8; item += gridDim.x) {
        const int bh = (item & 7) * 4 + (item >> 6), js = (item >> 3) & 7, b = bh >> 2, h = bh & 3;
        __syncthreads();
        for (int i = tid; i < 2 * 64 * 200 / 2; i += NTHR) ((LAS unsigned*)CT0)[i] = 0u;
        for (int i = tid; i < 64 * 72 / 2; i += NTHR) ((LAS unsigned*)VWs)[i] = 0u;
        for (int i = tid; i < 64 * 72; i += NTHR) Vs[i] = (i % 72 == 48) ? (bf16)0x3f80 : (bf16)0;
        f32x4 cacc[6];
#pragma unroll
        for (int i = 0; i < 6; ++i) cacc[i] = (f32x4){0.f, 0.f, 0.f, 0.f};
        __syncthreads();
        const int vrow = tid / 6, vcc = tid - vrow * 6;
        const int grow = tid >> 1, ghalf = tid & 1;
        const bf16* qkbase = QK + (size_t)b * SEQ * MIXW + h * A_DK;
        const bf16* vbase = Z + (size_t)b * SEQ * NA + ZA_V + h * A_DV + js * 48 + vcc * 8;
        const float* gbase = g5 + ((size_t)b * SEQ * 4 + h) * 8;
        u32x4 pq[3], pk[3], pv; f32x4 pg; float pws;
#define MLSTM_PREFETCH(c_) do { const size_t tt = (size_t)64 * (c_); int tp_ = tid; asm volatile("" : "+v"(tp_)); \
            _Pragma("unroll") for (int j = 0; j < 3; ++j) { const int i = tp_ + NTHR * j, row = i / 24, cc = i - row * 24; pq[j] = *(const u32x4*)(qkbase + (tt + row) * MIXW + cc * 8); pk[j] = *(const u32x4*)(qkbase + (tt + row) * MIXW + 768 + cc * 8); } \
            if (tid < 384) { pv = *(const u32x4*)(vbase + (tt + vrow) * NA); pws = gbase[(tt + vrow) * 32 + 3]; } \
            if (tid < 128) pg = *(const f32x4*)(gbase + (tt + grow) * 32 + 4 * ghalf); } while (0)
        MLSTM_PREFETCH(0);
        for (int c = 0; c < SEQ / 64; ++c) {
            const size_t t0 = (size_t)b * SEQ + 64 * c; const int cur = c & 1;
            LAS bf16* CTc = CT0 + cur * 64 * 200; LAS bf16* CTn = CT0 + (cur ^ 1) * 64 * 200;
            {
            int ts_ = tid; asm volatile("" : "+v"(ts_));
#pragma unroll
            for (int j = 0; j < 3; ++j) { const int i = ts_ + NTHR * j, row = i / 24, cc = i - row * 24;
                *(LAS u32x4*)(Qs + row * 200 + cc * 8) = pq[j]; *(LAS u32x4*)(Ks + row * 200 + cc * 8) = pk[j]; }
            if (tid < 384) { *(LAS u32x4*)(Vs + vrow * 72 + vcc * 8) = pv; const unsigned vv[4] = {pv.x, pv.y, pv.z, pv.w}; unsigned ww[4];
#pragma unroll
                for (int e = 0; e < 4; ++e) ww[e] = pk2(bf2f((bf16)(vv[e] & 0xffffu)) * pws, bf2f((bf16)(vv[e] >> 16)) * pws);
                *(LAS u32x4*)(VWs + vrow * 72 + vcc * 8) = (u32x4){ww[0], ww[1], ww[2], ww[3]}; }
            if (tid < 128) { if (ghalf == 0) { fu[grow] = pg[0]; fM[grow] = pg[1]; fwi[grow] = pg[2]; VWs[grow * 72 + 48] = f2bf(pg[3]); } else { fem[grow] = pg[0]; if (grow == 0) fdec[0] = pg[1]; } }
            }
            __syncthreads();
            if (c + 1 < SEQ / 64) MLSTM_PREFETCH(c + 1);
            {
                const int li = wave >> 1, half = wave & 1, l = 16 * li + fr; const float wil = fwi[l], Ml = fM[l];
                Frag<6> fqq; ldfrag(fqq, Qs + 16 * li * 200, 200, fr, fq);
                unsigned pb[4][2];
#pragma unroll
                for (int si = 0; si < 4; ++si) { pb[si][0] = 0u; pb[si][1] = 0u;
                    if (si <= li) { Frag<6> fk; ldfrag(fk, Ks + 16 * si * 200, 200, fr, fq); const f32x4 sacc = mmaf<6>(fk, fqq, (f32x4){0.f, 0.f, 0.f, 0.f}); float p[4];
#pragma unroll
                        for (int r = 0; r < 4; ++r) { const int sx = 16 * si + 4 * fq + r; p[r] = (sx <= l) ? sacc[r] * __expf(fu[sx] - Ml) : 0.f; }
                        pb[si][0] = pk2(p[0], p[1]); pb[si][1] = pk2(p[2], p[3]); } }
                Frag<2> fp;
#pragma unroll
                for (int k = 0; k < 2; ++k) { const u32x4 w = (u32x4){pb[2 * k][0], pb[2 * k][1], pb[2 * k + 1][0], pb[2 * k + 1][1]}; fp.v[k] = __builtin_bit_cast(bf16x8, w); }
                const int vfa = half ? 2 : 0;
                Frag<6> ca, cd; Frag<2> va, vd; ldfrag(ca, CTc + 16 * vfa * 200, 200, fr, fq); ldfrag(cd, CTc + 16 * 3 * 200, 200, fr, fq); ldfrag_trp(va, Vs, 72, 16 * vfa, fr, fq); ldfrag_trp(vd, Vs, 72, 48, fr, fq);
                f32x4 oa = (f32x4){0.f, 0.f, 0.f, 0.f}, od = oa, ob = oa;
#pragma unroll
                for (int k = 0; k < 6; ++k) { oa = __builtin_amdgcn_mfma_f32_16x16x32_bf16(ca.v[k], fqq.v[k], oa, 0, 0, 0); od = __builtin_amdgcn_mfma_f32_16x16x32_bf16(cd.v[k], fqq.v[k], od, 0, 0, 0); }
                oa = oa * wil; od = od * wil;
#pragma unroll
                for (int k = 0; k < 2; ++k) { oa = __builtin_amdgcn_mfma_f32_16x16x32_bf16(va.v[k], fp.v[k], oa, 0, 0, 0); od = __builtin_amdgcn_mfma_f32_16x16x32_bf16(vd.v[k], fp.v[k], od, 0, 0, 0); }
                if (!half) { Frag<6> cb; Frag<2> vb; ldfrag(cb, CTc + 16 * 200, 200, fr, fq); ldfrag_trp(vb, Vs, 72, 16, fr, fq);
                    ob = mmaf<6>(cb, fqq, ob); ob = ob * wil; ob = mmaf<2>(vb, fp, ob); }
                const float den = __shfl(od[0], fr), dinv = __builtin_amdgcn_rcpf(fmaxf(fabsf(den), fem[l]));
                bf16* orow = hraw + (t0 + l) * MIXW + h * A_DV + js * 48 + 4 * fq;
                { u32x2 w2; w2.x = pk2(oa[0] * dinv, oa[1] * dinv); w2.y = pk2(oa[2] * dinv, oa[3] * dinv); *(u32x2*)(orow + 16 * vfa) = w2; }
                if (!half) { u32x2 w2; w2.x = pk2(ob[0] * dinv, ob[1] * dinv); w2.y = pk2(ob[2] * dinv, ob[3] * dinv); *(u32x2*)(orow + 16) = w2; }
            }
            {
                const float decay = fdec[0];
                Frag<2> fv[4];
#pragma unroll
                for (int vf = 0; vf < 4; ++vf) ldfrag_tr(fv[vf], VWs, 72, 16 * vf, fr, fq);
                const int dk0 = (6 * wave) >> 2;
                Frag<2> fka, fkb; ldfrag_tr(fka, Ks, 200, 16 * dk0, fr, fq); ldfrag_tr(fkb, Ks, 200, 16 * (dk0 + 1), fr, fq);
#pragma unroll
                for (int i = 0; i < 6; ++i) cacc[i] = cacc[i] * decay;
                if (wave & 1) {
                    cacc[0] = mmaf<2>(fka, fv[2], cacc[0]); cacc[1] = mmaf<2>(fka, fv[3], cacc[1]); cacc[2] = mmaf<2>(fkb, fv[0], cacc[2]); cacc[3] = mmaf<2>(fkb, fv[1], cacc[3]); cacc[4] = mmaf<2>(fkb, fv[2], cacc[4]); cacc[5] = mmaf<2>(fkb, fv[3], cacc[5]);
                } else {
                    cacc[0] = mmaf<2>(fka, fv[0], cacc[0]); cacc[1] = mmaf<2>(fka, fv[1], cacc[1]); cacc[2] = mmaf<2>(fka, fv[2], cacc[2]); cacc[3] = mmaf<2>(fka, fv[3], cacc[3]); cacc[4] = mmaf<2>(fkb, fv[0], cacc[4]); cacc[5] = mmaf<2>(fkb, fv[1], cacc[5]);
                }
#pragma unroll
                for (int i = 0; i < 6; ++i) { const int f = 6 * wave + i, dkf = f >> 2, vf = f & 3;
                    u32x2 w2; w2.x = pk2(cacc[i][0], cacc[i][1]); w2.y = pk2(cacc[i][2], cacc[i][3]);
                    *(LAS u32x2*)(CTn + (16 * vf + fr) * 200 + 16 * dkf + 4 * fq) = w2; }
            }
            __syncthreads();
        }
#undef MLSTM_PREFETCH
    }
}

__device__ __forceinline__ void phase_hgrn(const Args& a, LAS unsigned char* lds, int tid, int lane, int wave) {
    unsigned char* ws = a.ws;
    const bf16* Z = (const bf16*)(ws + WS_Z); bf16* hraw = (bf16*)(ws + WS_HRAW1);
    LAS bf16* Qg0 = (LAS bf16*)lds;
    LAS bf16* Kg0 = (LAS bf16*)(lds + 34816);
    LAS bf16* VT0 = (LAS bf16*)(lds + 69632);
    LAS bf16* ST0 = (LAS bf16*)(lds + 88064);
    LAS float* eg0 = (LAS float*)(lds + 122880);
    const int fr = lane & 15, fq = lane >> 4;
    const int vrow = tid >> 3, vcc = tid & 7;
    for (int item = blockIdx.x; item < BATCH * B_H * 2; item += gridDim.x) {
        const int bh = item >> 1, js = item & 1, b = bh / B_H, h = bh - b * B_H;
        __syncthreads();
        for (int i = tid; i < 2 * 64 * 136 / 2; i += NTHR) ((LAS unsigned*)ST0)[i] = 0u;
        f32x4 sacc[4];
#pragma unroll
        for (int i = 0; i < 4; ++i) sacc[i] = (f32x4){0.f, 0.f, 0.f, 0.f};
        const bf16* qbase = Z + (size_t)b * SEQ * NB + 256 * h;
        const bf16* vbase = Z + ((size_t)b * SEQ + vrow) * NB + ZB_I + h * B_DV + js * 64 + vcc * 8;
        const float* egbase = (const float*)(ws + WS_G5) + (size_t)b * (SEQ / 64) * 1536 + h * B_DK;
        u32x4 pq[2], pk[2], pv; float peg = 0.f;
#define HGRN_PREFETCH(c_) do { const size_t tt = (size_t)64 * (c_); \
            _Pragma("unroll") for (int j = 0; j < 2; ++j) { const int i = tid + NTHR * j, row = i >> 4, cc = i & 15; pq[j] = *(const u32x4*)(qbase + (tt + row) * NB + cc * 8); pk[j] = *(const u32x4*)(qbase + (tt + row) * NB + 128 + cc * 8); } \
            pv = *(const u32x4*)(vbase + tt * NB); if (tid < 128) peg = egbase[(size_t)(c_) * 1536 + tid]; } while (0)
#define HGRN_ELEMENTWISE(bi_) do { LAS bf16* Qg_ = Qg0 + (bi_) * 64 * 136; LAS bf16* Kg_ = Kg0 + (bi_) * 64 * 136; \
            _Pragma("unroll") for (int j = 0; j < 2; ++j) { const int i = tid + NTHR * j, row = i >> 4, cc = i & 15; *(LAS u32x4*)(Qg_ + row * 136 + cc * 8) = pq[j]; *(LAS u32x4*)(Kg_ + row * 136 + cc * 8) = pk[j]; } \
            if (tid < 128) eg0[(bi_) * 128 + tid] = peg; \
            *(LAS u32x4*)(VT0 + (bi_) * 64 * 72 + vrow * 72 + vcc * 8) = pv; } while (0)
        HGRN_PREFETCH(0);
        HGRN_ELEMENTWISE(0);
        HGRN_PREFETCH(1);
        __syncthreads();
        for (int c = 0; c < SEQ / 64; ++c) {
            const size_t t0 = (size_t)b * SEQ + 64 * c; const int cur = c & 1;
            const LAS bf16* Qg = Qg0 + cur * 64 * 136; const LAS bf16* Kg = Kg0 + cur * 64 * 136; const LAS bf16* VT = VT0 + cur * 64 * 72;
            const LAS bf16* STc = ST0 + cur * 64 * 136; LAS bf16* STn = ST0 + (cur ^ 1) * 64 * 136; const LAS float* eg = eg0 + cur * 128;
            if (c + 1 < SEQ / 64) { HGRN_ELEMENTWISE(cur ^ 1); if (c + 2 < SEQ / 64) HGRN_PREFETCH(c + 2); }
            {
                const int li = wave >> 1, l = 16 * li + fr, vf0 = 2 * (wave & 1);
                Frag<4> fqq; ldfrag(fqq, Qg + 16 * li * 136, 136, fr, fq);
                unsigned pb[4][2];
#pragma unroll
                for (int si = 0; si < 4; ++si) { pb[si][0] = 0u; pb[si][1] = 0u;
                    if (si <= li) { Frag<4> fk; ldfrag(fk, Kg + 16 * si * 136, 136, fr, fq); const f32x4 sa = mmaf<4>(fk, fqq, (f32x4){0.f, 0.f, 0.f, 0.f}); float p[4];
#pragma unroll
                        for (int r = 0; r < 4; ++r) { const int sx = 16 * si + 4 * fq + r; p[r] = (sx <= l) ? sa[r] : 0.f; }
                        pb[si][0] = pk2(p[0], p[1]); pb[si][1] = pk2(p[2], p[3]); } }
                Frag<2> fp;
#pragma unroll
                for (int k = 0; k < 2; ++k) { const u32x4 w = (u32x4){pb[2 * k][0], pb[2 * k][1], pb[2 * k + 1][0], pb[2 * k + 1][1]}; fp.v[k] = __builtin_bit_cast(bf16x8, w); }
                Frag<4> sa, sb; Frag<2> va, vb;
                ldfrag(sa, STc + 16 * vf0 * 136, 136, fr, fq); ldfrag(sb, STc + 16 * (vf0 + 1) * 136, 136, fr, fq);
                ldfrag_trp(va, VT, 72, 16 * vf0, fr, fq); ldfrag_trp(vb, VT, 72, 16 * (vf0 + 1), fr, fq);
                f32x4 oa = (f32x4){0.f, 0.f, 0.f, 0.f}, ob = oa;
#pragma unroll
                for (int k = 0; k < 4; ++k) { oa = __builtin_amdgcn_mfma_f32_16x16x32_bf16(sa.v[k], fqq.v[k], oa, 0, 0, 0); ob = __builtin_amdgcn_mfma_f32_16x16x32_bf16(sb.v[k], fqq.v[k], ob, 0, 0, 0); }
#pragma unroll
                for (int k = 0; k < 2; ++k) { oa = __builtin_amdgcn_mfma_f32_16x16x32_bf16(va.v[k], fp.v[k], oa, 0, 0, 0); ob = __builtin_amdgcn_mfma_f32_16x16x32_bf16(vb.v[k], fp.v[k], ob, 0, 0, 0); }
                bf16* orow = hraw + (t0 + l) * MIXW + h * B_DV + js * 64 + 4 * fq;
                u32x2 w2; w2.x = pk2(oa[0], oa[1]); w2.y = pk2(oa[2], oa[3]); *(u32x2*)(orow + 16 * vf0) = w2;
                w2.x = pk2(ob[0], ob[1]); w2.y = pk2(ob[2], ob[3]); *(u32x2*)(orow + 16 * vf0 + 16) = w2;
            }
            {
                Frag<2> fke, fv[4]; ldfrag_tr(fke, Kg, 136, 16 * wave, fr, fq);
#pragma unroll
                for (int vf = 0; vf < 4; ++vf) ldfrag_tr(fv[vf], VT, 72, 16 * vf, fr, fq);
                float egr[4];
#pragma unroll
                for (int r = 0; r < 4; ++r) egr[r] = eg[16 * wave + 4 * fq + r];
#pragma unroll
                for (int i = 0; i < 4; ++i) {
                    sacc[i] = mmaf<2>(fke, fv[i], sacc[i]);
#pragma unroll
                    for (int r = 0; r < 4; ++r) sacc[i][r] *= egr[r];
                    u32x2 w; w.x = pk2(sacc[i][0], sacc[i][1]); w.y = pk2(sacc[i][2], sacc[i][3]);
                    *(LAS u32x2*)(STn + (16 * i + fr) * 136 + 16 * wave + 4 * fq) = w; }
            }
            __syncthreads();
        }
#undef HGRN_PREFETCH
#undef HGRN_ELEMENTWISE
    }
}

template <int LAYER>
__device__ __forceinline__ void phase_attn(const Args& a, LAS unsigned char* lds, int tid, int lane, int wave, int item0, int istride) {
    unsigned char* ws = a.ws;
    constexpr int NZ = LAYER == 0 ? NA : NB, XQ = LAYER == 0 ? ZA_XQ : ZB_XQ;
    const bf16* Z = (const bf16*)(ws + WS_Z); const bf16* KV = (const bf16*)(ws + WS_KV); bf16* ycat = (bf16*)(ws + WS_YCAT); const bf16* hraw = (const bf16*)(ws + (LAYER == 0 ? WS_HB : WS_HRAW1));
    LAS bf16* Ks = (LAS bf16*)lds;
    LAS bf16* Vt = (LAS bf16*)(lds + 69632);
    LAS bf16* Pw = (LAS bf16*)(lds + 137216 + wave * 2304);
    const int fr = lane & 15, fq = lane >> 4;
    for (int item = item0; item < BATCH * XAH * 8; item += istride) {
        const int bh = item >> 3, part = item & 7, b = bh >> 2, h = bh & 3;
        __syncthreads();
        { const bf16* kp = KV + (size_t)b * MEMLEN * 2048 + LAYER * 1024 + h * XAD;
          for (int i = tid; i < 256 * 16; i += NTHR) { const int key = i >> 4, c8 = i & 15;
              *(LAS u32x4*)(Ks + key * 136 + c8 * 8) = *(const u32x4*)(kp + (size_t)key * 2048 + c8 * 8);
              const u32x4 v = *(const u32x4*)(kp + (size_t)key * 2048 + 512 + c8 * 8); const unsigned vv[4] = {v.x, v.y, v.z, v.w};
#pragma unroll
              for (int j = 0; j < 4; ++j) { Vt[(c8 * 8 + 2 * j) * 264 + key] = (bf16)(vv[j] & 0xffffu); Vt[(c8 * 8 + 2 * j + 1) * 264 + key] = (bf16)(vv[j] >> 16); } } }
        __syncthreads();
        for (int tile = 0; tile < 4; ++tile) {
            const size_t tq0 = (size_t)b * SEQ + part * 512 + tile * 128 + 16 * wave;
            bf16x8 aq[4];
#pragma unroll
            for (int ks = 0; ks < 4; ++ks) aq[ks] = *(const bf16x8*)(Z + (tq0 + fr) * NZ + XQ + h * XAD + 32 * ks + 8 * fq);
            f32x4 s[16];
#pragma unroll
            for (int nf = 0; nf < 16; ++nf) { f32x4 acc = (f32x4){0.f, 0.f, 0.f, 0.f};
#pragma unroll
                for (int ks = 0; ks < 4; ++ks) { const bf16x8 bk = *(const LAS bf16x8*)(Ks + (16 * nf + fr) * 136 + 32 * ks + 8 * fq); acc = __builtin_amdgcn_mfma_f32_16x16x32_bf16(aq[ks], bk, acc, 0, 0, 0); }
                s[nf] = acc; }
            float mx[4], sm[4];
#pragma unroll
            for (int r = 0; r < 4; ++r) { float m = s[0][r];
#pragma unroll
                for (int nf = 1; nf < 16; ++nf) m = fmaxf(m, s[nf][r]);
                m = fmaxf(m, __shfl_xor(m, 1)); m = fmaxf(m, __shfl_xor(m, 2)); m = fmaxf(m, __shfl_xor(m, 4)); m = fmaxf(m, __shfl_xor(m, 8)); mx[r] = m; sm[r] = 0.f; }
            constexpr float SC = 0.08838834764831845f * 1.4426950408889634f;
#pragma unroll
            for (int nf = 0; nf < 16; ++nf)
#pragma unroll
                for (int r = 0; r < 4; ++r) { const float p = __builtin_amdgcn_exp2f((s[nf][r] - mx[r]) * SC); s[nf][r] = p; sm[r] += p; }
#pragma unroll
            for (int r = 0; r < 4; ++r) { float t = sm[r]; t += __shfl_xor(t, 1); t += __shfl_xor(t, 2); t += __shfl_xor(t, 4); t += __shfl_xor(t, 8); sm[r] = 1.0f / t; }
            f32x4 o[8];
#pragma unroll
            for (int df = 0; df < 8; ++df) o[df] = (f32x4){0.f, 0.f, 0.f, 0.f};
#pragma unroll
            for (int qd = 0; qd < 4; ++qd) {
#pragma unroll
                for (int n4 = 0; n4 < 4; ++n4)
#pragma unroll
                    for (int r = 0; r < 4; ++r) Pw[(4 * fq + r) * 72 + 16 * n4 + fr] = f2bf(s[4 * qd + n4][r]);
                asm volatile("s_waitcnt lgkmcnt(0)" ::: "memory");
#pragma unroll
                for (int ks = 0; ks < 2; ++ks) { const bf16x8 ap = *(const LAS bf16x8*)(Pw + fr * 72 + 32 * ks + 8 * fq);
#pragma unroll
                    for (int df = 0; df < 8; ++df) { const bf16x8 bv = *(const LAS bf16x8*)(Vt + (16 * df + fr) * 264 + 64 * qd + 32 * ks + 8 * fq); o[df] = __builtin_amdgcn_mfma_f32_16x16x32_bf16(ap, bv, o[df], 0, 0, 0); } }
                asm volatile("s_waitcnt lgkmcnt(0)" ::: "memory");
            }
#pragma unroll
            for (int df = 0; df < 8; ++df)
#pragma unroll
                for (int r = 0; r < 4; ++r) ycat[(tq0 + 4 * fq + r) * DM + MIXW + h * XAD + 16 * df + fr] = f2bf(o[df][r] * sm[r]);
        }
    }
}
template <int LAYER>
__device__ __forceinline__ void phase_norm(const Args& a, int lane, int wave) {
    unsigned char* ws = a.ws;
    const bf16* Z = (const bf16*)(ws + WS_Z); bf16* ycat = (bf16*)(ws + WS_YCAT); const bf16* hraw = (const bf16*)(ws + (LAYER == 0 ? WS_HB : WS_HRAW1));
    const int gw = blockIdx.x * NWAVES + wave, NGW = gridDim.x * NWAVES;
    if (LAYER == 0) {
        const float* hg = a.in[IN_AHG];
        for (int t = gw; t < T; t += NGW) {
            const bf16* hp = hraw + (size_t)t * MIXW + 24 * lane; const bf16* op = Z + (size_t)t * NA + ZA_O + 24 * lane;
            float v[24], og[24]; float ss = 0.f;
#pragma unroll
            for (int j = 0; j < 3; ++j) { const u32x4 w = *(const u32x4*)(hp + 8 * j), wo = *(const u32x4*)(op + 8 * j); const unsigned ww[4] = {w.x, w.y, w.z, w.w}, wwo[4] = {wo.x, wo.y, wo.z, wo.w};
#pragma unroll
                for (int e = 0; e < 4; ++e) { v[8 * j + 2 * e] = bf2f((bf16)(ww[e] & 0xffffu)); v[8 * j + 2 * e + 1] = bf2f((bf16)(ww[e] >> 16)); og[8 * j + 2 * e] = bf2f((bf16)(wwo[e] & 0xffffu)); og[8 * j + 2 * e + 1] = bf2f((bf16)(wwo[e] >> 16)); } }
#pragma unroll
            for (int i = 0; i < 24; ++i) ss += v[i] * v[i];
            ss += __shfl_xor(ss, 1); ss += __shfl_xor(ss, 2); ss += __shfl_xor(ss, 4); ss += __shfl_xor(ss, 8);
            const float rstd = 1.0f / sqrtf(ss * (1.0f / A_DV) + EPS);
            bf16* yp = ycat + (size_t)t * DM + 24 * lane;
#pragma unroll
            for (int j = 0; j < 3; ++j) { float y[8];
#pragma unroll
                for (int e = 0; e < 8; ++e) { const int i = 8 * j + e; y[e] = sigmoidf_(og[i]) * v[i] * rstd * hg[24 * lane + i]; }
                u32x4 w; w.x = pk2(y[0], y[1]); w.y = pk2(y[2], y[3]); w.z = pk2(y[4], y[5]); w.w = pk2(y[6], y[7]); *(u32x4*)(yp + 8 * j) = w; }
        }
    } else {
        const float* hg = a.in[IN_BHG];
        for (int t = gw; t < T; t += NGW) {
#pragma unroll
            for (int j = 0; j < 3; ++j) { const int c0 = 8 * lane + 512 * j;
                const u32x4 w = *(const u32x4*)(hraw + (size_t)t * MIXW + c0), wo = *(const u32x4*)(Z + (size_t)t * NB + ZB_G + c0); const unsigned ww[4] = {w.x, w.y, w.z, w.w}, wwo[4] = {wo.x, wo.y, wo.z, wo.w};
                float v[8], og[8]; float ss = 0.f;
#pragma unroll
                for (int e = 0; e < 4; ++e) { v[2 * e] = bf2f((bf16)(ww[e] & 0xffffu)); v[2 * e + 1] = bf2f((bf16)(ww[e] >> 16)); og[2 * e] = bf2f((bf16)(wwo[e] & 0xffffu)); og[2 * e + 1] = bf2f((bf16)(wwo[e] >> 16)); }
#pragma unroll
                for (int e = 0; e < 8; ++e) ss += v[e] * v[e];
                ss += __shfl_xor(ss, 1); ss += __shfl_xor(ss, 2); ss += __shfl_xor(ss, 4); ss += __shfl_xor(ss, 8);
                const float rstd = 1.0f / sqrtf(ss * (1.0f / B_DV) + EPS);
                float y[8];
#pragma unroll
                for (int e = 0; e < 8; ++e) y[e] = v[e] * rstd * hg[c0 + e] * siluf_(og[e]);
                u32x4 wy; wy.x = pk2(y[0], y[1]); wy.y = pk2(y[2], y[3]); wy.z = pk2(y[4], y[5]); wy.w = pk2(y[6], y[7]); *(u32x4*)(ycat + (size_t)t * DM + c0) = wy; }
        }
    }
}

__device__ __forceinline__ void phase_ffn_fixup(const Args& a, int layer, int tid) {
    unsigned char* ws = a.ws; const bf16* side = (const bf16*)(ws + WS_SIDE); bf16* act = (bf16*)(ws + WS_Z);
    const float* cw = a.in[IN_FCW] + (size_t)layer * 3 * DFF; const float* cb = a.in[IN_FCB] + (size_t)layer * DFF;
    const int total = 512 * 2 * DFF;
    for (int i = blockIdx.x * NTHR + tid; i < total; i += gridDim.x * NTHR) {
        const int f = i % DFF, gr = i / DFF, grp = gr >> 1, r = gr & 1; const int t = grp * 64 + r; const bool start = (grp & 63) == 0;
        const bf16* sg = side + (size_t)grp * 6 * DFF; const bf16* sp = sg - (size_t)6 * DFF;
        const float g0 = bf2f(sg[(size_t)r * DFF + f]), u0 = bf2f(sg[(size_t)(2 + r) * DFF + f]);
        float g1, g2;
        if (r == 0) { g1 = start ? 0.f : bf2f(sp[(size_t)5 * DFF + f]); g2 = start ? 0.f : bf2f(sp[(size_t)4 * DFF + f]); }
        else { g1 = bf2f(sg[f]); g2 = start ? 0.f : bf2f(sp[(size_t)5 * DFF + f]); }
        const float c = cb[f] + cw[f] * g2 + cw[DFF + f] * g1 + cw[2 * DFF + f] * g0;
        act[(size_t)t * DFF + f] = f2bf(siluf_(c) * u0);
    }
}
__device__ __forceinline__ void phase_final_norm(const Args& a, int lane, int wave) {
    const float* ssq = (const float*)(a.ws + WS_SSQ); const float* g = a.in[IN_NOUT]; float* out = a.out; const bf16* hb = (const bf16*)(a.ws + WS_HB);
    const int gw = blockIdx.x * NWAVES + wave, NGW = gridDim.x * NWAVES;
    for (int row = gw; row < T; row += NGW) {
        float s = lane < 32 ? ssq[(size_t)row * 32 + lane] : 0.f; s = wave_sum(s);
        const float rstd = 1.0f / sqrtf(s * (1.0f / DM) + EPS);
        const u32x4* hr = (const u32x4*)(hb + (size_t)row * DM) + lane; f32x4* xr = (f32x4*)(out + (size_t)row * DM);
#pragma unroll
        for (int j = 0; j < 4; ++j) { const u32x4 w = hr[64 * j]; const int c8 = 8 * (lane + 64 * j); const f32x4 g0 = *(const f32x4*)(g + c8), g1 = *(const f32x4*)(g + c8 + 4);
            f32x4 v0 = (f32x4){__builtin_bit_cast(float, w.x << 16), __builtin_bit_cast(float, w.x & 0xffff0000u), __builtin_bit_cast(float, w.y << 16), __builtin_bit_cast(float, w.y & 0xffff0000u)};
            f32x4 v1 = (f32x4){__builtin_bit_cast(float, w.z << 16), __builtin_bit_cast(float, w.z & 0xffff0000u), __builtin_bit_cast(float, w.w << 16), __builtin_bit_cast(float, w.w & 0xffff0000u)};
            xr[c8 / 4] = v0 * rstd * g0; xr[c8 / 4 + 1] = v1 * rstd * g1; }
    }
}

#define XB_TMO      128
#define XB_XCNT(j)  (256  + 64 * (j))
#define XB_XSUB(j)  (1280 + 64 * (j))
#define XB_XGEN(j)  (2304 + 64 * (j))
#define XB_TOP      3328
#define XB_TOPGEN   3392
#define XCD_BAR_WORDS 3456
#define XB_SPIN_CAP (1u << 18)

__device__ __forceinline__ unsigned xb_ld(unsigned* p)              { return __hip_atomic_load(p, __ATOMIC_RELAXED, __HIP_MEMORY_SCOPE_AGENT); }
__device__ __forceinline__ unsigned xb_add(unsigned* p, unsigned v) { return __hip_atomic_fetch_add(p, v, __ATOMIC_RELAXED, __HIP_MEMORY_SCOPE_AGENT); }
__device__ __forceinline__ unsigned xb_xcc_id() { return (unsigned)__builtin_amdgcn_s_getreg((3 << 11) | 20) & 0xFu; }
#define XB_SPIN(cond, bar) do { unsigned _sp = 0; while (cond) { __builtin_amdgcn_s_sleep(1); \
    if ((++_sp & 255u) == 0u) { if (xb_ld(&(bar)[XB_TMO])) break; if (_sp > XB_SPIN_CAP) { atomicAdd(&(bar)[XB_TMO], 1u); break; } } } } while (0)

struct XcdBarrier {
    unsigned* bar; unsigned x;
    volatile LAS unsigned* st;
};

__device__ __forceinline__ XcdBarrier xcd_barrier_post(unsigned* bar, volatile LAS unsigned* st) {
    XcdBarrier b; b.bar = bar; b.x = xb_xcc_id(); b.st = st;
    if (threadIdx.x == 0) (void)xb_add(&bar[XB_XCNT(b.x)], 1u);
    return b;
}
__device__ __forceinline__ void xcd_barrier_complete(unsigned* bar, unsigned x, unsigned& nloc, unsigned& nx) {
    const unsigned G = gridDim.x * gridDim.y * gridDim.z;
    unsigned sum, cnt, mine, sp = 0u;
    for (;;) {
        sum = 0u; cnt = 0u; mine = 0u;
#pragma unroll
        for (unsigned j = 0; j < 16; ++j) { const unsigned c = xb_ld(&bar[XB_XCNT(j)]); sum += c; cnt += (c > 0u) ? 1u : 0u; mine = (j == x) ? c : mine; }
        if (sum == G) break;
        __builtin_amdgcn_s_sleep(1);
        if ((++sp & 255u) == 0u) { if (xb_ld(&bar[XB_TMO])) break; if (sp > XB_SPIN_CAP) { atomicAdd(&bar[XB_TMO], 1u); break; } }
    }
    nloc = mine > 0u ? mine : 1u; nx = cnt > 0u ? cnt : 1u;
}

__device__ __forceinline__ void xcd_barrier(const XcdBarrier& b) {
    asm volatile("s_waitcnt vmcnt(0)" ::: "memory");
    __syncthreads();
    if (threadIdx.x == 0) {
        unsigned* bar = b.bar;
        __builtin_amdgcn_s_waitcnt(0);
        unsigned nloc = b.st[0], nx = b.st[1];
        if (nloc == 0u) { xcd_barrier_complete(bar, b.x, nloc, nx); b.st[0] = nloc; b.st[1] = nx; }
        const unsigned old = xb_add(&bar[XB_XSUB(b.x)], 1u);
        const unsigned gen = old / nloc;
        if (old + 1u == (gen + 1u) * nloc) {
            __builtin_amdgcn_fence(__ATOMIC_RELEASE, "agent");
            asm volatile("s_waitcnt vmcnt(0)" ::: "memory");
            const unsigned og = xb_add(&bar[XB_TOP], 1u);
            const unsigned tg = og / nx;
            if (og + 1u == (tg + 1u) * nx) xb_add(&bar[XB_TOPGEN], 1u);
            else XB_SPIN(xb_ld(&bar[XB_TOPGEN]) == tg, bar);
            __builtin_amdgcn_fence(__ATOMIC_ACQUIRE, "agent");
            xb_add(&bar[XB_XGEN(b.x)], 1u);
            asm volatile("s_waitcnt vmcnt(0)" ::: "memory");
        } else {
            XB_SPIN(xb_ld(&bar[XB_XGEN(b.x)]) == gen, bar);
            __builtin_amdgcn_fence(__ATOMIC_ACQUIRE, "agent");
            asm volatile("s_waitcnt vmcnt(0)" ::: "memory");
        }
    }
    __syncthreads();
}

constexpr int NPHASES = 19;
typedef const Args __attribute__((address_space(4))) CArgs;
__device__ __forceinline__ void load_args(Args& a, CArgs* p) {
#pragma unroll
    for (int i = 0; i < 21; ++i) a.in[i] = p->in[i];
    a.out = p->out; a.ws = p->ws; a.ph_lo = p->ph_lo; a.ph_hi = p->ph_hi; }
__device__ __forceinline__ bool in_range(int k) { CArgs* p = (CArgs*)__builtin_amdgcn_kernarg_segment_ptr(); asm volatile("" : "+s"(p)); return p->ph_lo <= k && k < p->ph_hi; }
#define PHASE_BEGIN() CArgs* ap_ = (CArgs*)__builtin_amdgcn_kernarg_segment_ptr(); asm volatile("" : "+s"(ap_)); Args a; load_args(a, ap_); \
    int tid = threadIdx.x; asm volatile("" : "+v"(tid)); const int lane = tid & 63, wave = __builtin_amdgcn_readfirstlane(tid >> 6); unsigned char* ws = a.ws; const int G = gridDim.x; (void)lane; (void)wave; (void)ws; (void)G;
#ifdef ONLY_PH
#define IN(k) (((k) == ONLY_PH || ((k) >= 2 && (k) - 8 == ONLY_PH)) && in_range(k))
#else
#define IN(k) in_range(k)
#endif
#ifndef REPEAT_PH
#define REPEAT_PH -1
#endif
#define REP(k) for (int rep_ = 0; rep_ < 1 + (REPEAT_PH == (k) ? 1 : 0); ++rep_)
#define SEAM(k) do { if (IN(k) && IN((k) + 1)) { if (hi > 1000) cg::this_grid().sync(); CArgs* apb_ = (CArgs*)__builtin_amdgcn_kernarg_segment_ptr(); asm volatile("" : "+s"(apb_)); \
        XcdBarrier b_; b_.bar = (unsigned*)(apb_->ws + WS_CTL) + CW_BAR; b_.x = xb_xcc_id(); b_.st = (volatile LAS unsigned*)(lds + MISC_OFF); xcd_barrier(b_); } } while (0)
template <int layer> __device__ __forceinline__ void layer_phases(LAS unsigned char* lds, const int hi) {
        const int pb = 2 + 8 * layer;
        if (IN(pb)) REP(pb) { __syncthreads();
            PHASE_BEGIN();
            const int N = layer ? NB : NA;
            pg8::Gemm g{(const bf16*)(ws + WS_HB), (const bf16*)(ws + (layer ? WS_WIN1 : WS_WIN0)), T, N, DM}; pg8::StaticOrder S; S.init(T, N, G, (int)blockIdx.x);
            if constexpr (layer == 0) { pg8::EpiScaleBf16 E{(bf16*)(ws + WS_Z), N, (const float*)(ws + WS_SSQ)};
                pg8::gemm_phase<pg8::EpiScaleBf16, pg8::StaticOrder, PG8_ALIGN, PG8_SP2>(lds, g, S, E); }
            else { pg8::EpiZ1 E{(bf16*)(ws + WS_Z), N, (const float*)(ws + WS_SSQ), a.in[IN_BLB], (float*)(ws + WS_G5)};
                pg8::gemm_phase<pg8::EpiZ1, pg8::StaticOrder, PG8_ALIGN, PG8_SP2>(lds, g, S, E); }
        }
        SEAM(pb);
        if (layer == 0) {
            if (IN(pb + 1)) REP(pb + 1) { __syncthreads(); PHASE_BEGIN();
                const int nkv = (TM / 256) * (2048 / 256), ngs = BATCH * A_H;
                if (G >= 2 * nkv + 2 * ngs) {
                    const int bid = (int)blockIdx.x;
                    if (bid >= G - ngs) { if (wave == 0) mlstm_gate_scan(a, G - 1 - bid, lane); }
                    else if (bid >= nkv) phase_mlstm_conv(a, tid, bid - nkv, G - nkv - ngs);
                } else {
                    if (wave == 0) for (int bh = G - 1 - (int)blockIdx.x; bh < ngs; bh += G) mlstm_gate_scan(a, bh, lane);
                    phase_mlstm_conv(a, tid, (int)blockIdx.x, G);
                }
                __syncthreads();
                pg8::Gemm g{(const bf16*)(ws + WS_MEMB), (const bf16*)(ws + WS_WKV), TM, 2048, DM}; pg8::StaticOrder S; S.init(TM, 2048, G, (int)blockIdx.x);
                pg8::EpiScaleBf16 E{(bf16*)(ws + WS_KV), 2048, (const float*)(ws + WS_SSQM)};
                pg8::gemm_phase<pg8::EpiScaleBf16, pg8::StaticOrder, PG8_ALIGN, PG8_SP2>(lds, g, S, E);
            }
            SEAM(pb + 1);
        }
        if (IN(pb + 2)) REP(pb + 2) { __syncthreads(); PHASE_BEGIN();
            if (layer == 0) phase_mlstm(a, lds, tid, lane, wave);
            else {
                phase_hgrn(a, lds, tid, lane, wave);
                const int nscan = BATCH * B_H * 2;
                if (G > nscan) { if ((int)blockIdx.x >= nscan) phase_attn<1>(a, lds, tid, lane, wave, (int)blockIdx.x - nscan, G - nscan); }
                else phase_attn<1>(a, lds, tid, lane, wave, (int)blockIdx.x, G);
            } }
        SEAM(pb + 2);
        if (IN(pb + 3)) REP(pb + 3) { __syncthreads(); PHASE_BEGIN(); if (layer == 0) { phase_attn<0>(a, lds, tid, lane, wave, (int)blockIdx.x, G); phase_norm<0>(a, lane, wave); } else phase_norm<1>(a, lane, wave); }
        SEAM(pb + 3);
        if (IN(pb + 4)) REP(pb + 4) { __syncthreads();
            PHASE_BEGIN();
            pg8::Gemm g{(const bf16*)(ws + WS_YCAT), (const bf16*)(ws + (layer ? WS_WOUT1 : WS_WOUT0)), T, DM, DM}; pg8::StaticOrder S; S.init(T, DM, G, (int)blockIdx.x);
            if constexpr (layer == 0) { typedef pg8::EpiRes<false, false, true> EpiR; EpiR E{a.in[IN_X], nullptr, nullptr, (bf16*)(ws + WS_HB), (float*)(ws + WS_SSQ)};
                pg8::gemm_phase<EpiR, pg8::StaticOrder, PG8_ALIGN, PG8_SP2>(lds, g, S, E); }
            else { typedef pg8::EpiRes<true, false, true> EpiR; EpiR E{nullptr, (const bf16*)(ws + WS_HB), nullptr, (bf16*)(ws + WS_HB), (float*)(ws + WS_SSQ)};
                pg8::gemm_phase<EpiR, pg8::StaticOrder, PG8_ALIGN, PG8_SP2>(lds, g, S, E); }
        }
        SEAM(pb + 4);
        if (IN(pb + 5)) REP(pb + 5) { __syncthreads();
            PHASE_BEGIN();
            pg8::Gemm g{(const bf16*)(ws + WS_HB), (const bf16*)(ws + (layer ? WS_WUP1 : WS_WUP0)), T, 2 * DFF, DM}; pg8::StaticOrder S; S.init(T, 2 * DFF, G, (int)blockIdx.x);
            pg8::EpiUp E{(bf16*)(ws + WS_Z), (bf16*)(ws + WS_SIDE), (const float*)(ws + WS_SSQ), a.in[IN_FCW] + (size_t)layer * 3 * DFF, a.in[IN_FCB] + (size_t)layer * DFF};
            pg8::gemm_phase<pg8::EpiUp, pg8::StaticOrder, PG8_ALIGN, PG8_SP2>(lds, g, S, E);
        }
        SEAM(pb + 5);
        if (IN(pb + 6)) REP(pb + 6) { __syncthreads(); PHASE_BEGIN(); phase_ffn_fixup(a, layer, tid); }
        SEAM(pb + 6);
        if (IN(pb + 7)) REP(pb + 7) { __syncthreads();
            PHASE_BEGIN();
            pg8::Gemm g{(const bf16*)(ws + WS_Z), (const bf16*)(ws + (layer ? WS_WDN1 : WS_WDN0)), T, DM, DFF}; pg8::StaticOrder S; S.init(T, DM, G, (int)blockIdx.x);
            if constexpr (layer == 0) { typedef pg8::EpiRes<true, false, true> EpiR; EpiR E{nullptr, (const bf16*)(ws + WS_HB), nullptr, (bf16*)(ws + WS_HB), (float*)(ws + WS_SSQ)};
                pg8::gemm_phase<EpiR, pg8::StaticOrder, PG8_ALIGN, PG8_SP2>(lds, g, S, E); }
            else { typedef pg8::EpiRes<true, false, true> EpiR; EpiR E{nullptr, (const bf16*)(ws + WS_HB), nullptr, (bf16*)(ws + WS_HB), (float*)(ws + WS_SSQ)};
                pg8::gemm_phase<EpiR, pg8::StaticOrder, PG8_ALIGN, PG8_SP2>(lds, g, S, E); }
        }
        SEAM(pb + 7);
    }
__global__ void __launch_bounds__(NTHR, 2) mk_fwd(Args a_unused) {
    extern __shared__ __attribute__((aligned(16))) unsigned char lds_raw[];
    LAS unsigned char* lds = (LAS unsigned char*)lds_raw;
    int lo, hi; unsigned* barw; { CArgs* ap0 = (CArgs*)__builtin_amdgcn_kernarg_segment_ptr(); lo = ap0->ph_lo; hi = ap0->ph_hi; barw = (unsigned*)(ap0->ws + WS_CTL) + CW_BAR; }
    volatile LAS unsigned* misc = (volatile LAS unsigned*)(lds + MISC_OFF);
    if (threadIdx.x < 16) misc[threadIdx.x] = 0u;
    __syncthreads();
    if (hi - lo > 1) (void)xcd_barrier_post(barw, misc);
    if (IN(0)) REP(0) { __syncthreads(); PHASE_BEGIN(); phase_prologue(a, lds, tid, lane, wave); }
    SEAM(0);
    layer_phases<0>(lds, hi);
    layer_phases<1>(lds, hi);
    if (IN(18)) REP(18) { __syncthreads(); PHASE_BEGIN(); phase_final_norm(a, lane, wave); }
#undef IN
#undef SEAM
}

#ifndef MK_N_LAUNCHES
#define MK_N_LAUNCHES 1
#endif
extern "C" void kernel_launch(void* const* d_in, const int* in_sizes, int n_in, void* d_out, int out_size, void* d_ws, size_t ws_size, hipStream_t stream) {
    static int grid = 0;
    if (grid == 0) {
        if (n_in != 21 || in_sizes[0] != T * DM || out_size != T * DM || ws_size < WS_END) { fprintf(stderr, "kernel_launch: unexpected sizes n_in %d in0 %d out %d ws %zu (need %zu)\n", n_in, n_in > 0 ? in_sizes[0] : -1, out_size, ws_size, (size_t)WS_END); grid = -1; return; }
        int dev = 0, cus = 0, per_cu = 0;
        if (hipGetDevice(&dev) != hipSuccess || hipDeviceGetAttribute(&cus, hipDeviceAttributeMultiprocessorCount, dev) != hipSuccess) { grid = -1; return; }
        if (hipFuncSetAttribute((const void*)mk_fwd, hipFuncAttributeMaxDynamicSharedMemorySize, LDS_BYTES) != hipSuccess) { fprintf(stderr, "kernel_launch: hipFuncSetAttribute failed\n"); grid = -1; return; }
        if (hipOccupancyMaxActiveBlocksPerMultiprocessor(&per_cu, (const void*)mk_fwd, NTHR, LDS_BYTES) != hipSuccess || per_cu < 1) { fprintf(stderr, "kernel_launch: occupancy query says %d blocks per CU\n", per_cu); (void)hipGetLastError(); grid = -1; return; }
        grid = cus;
    }
    if (grid < 0) return;
    Args a{};
    for (int i = 0; i < 21; ++i) a.in[i] = (const float*)d_in[i];
    a.out = (float*)d_out; a.ws = (unsigned char*)d_ws;
#if MK_N_LAUNCHES == 1
    if (hipMemsetAsync((char*)d_ws + WS_CTL, 0, CTL_ZERO_BYTES, stream) != hipSuccess) { fprintf(stderr, "kernel_launch: memset failed\n"); return; }
    a.ph_lo = 0; a.ph_hi = NPHASES;
    void* args[] = {&a};
    hipError_t e = hipLaunchCooperativeKernel((const void*)mk_fwd, dim3(grid), dim3(NTHR), args, LDS_BYTES, stream);
    if (e != hipSuccess) fprintf(stderr, "kernel_launch: cooperative launch failed: %s (grid %d)\n", hipGetErrorString(e), grid);
#else
    for (int p = 0; p < NPHASES; ++p) { a.ph_lo = p; a.ph_hi = p + 1; hipLaunchKernelGGL(mk_fwd, dim3(grid), dim3(NTHR), LDS_BYTES, stream, a); }
#endif
}
```

```cpp
#include <hip/hip_runtime.h>
#include <hip/hip_cooperative_groups.h>
#include <cstdio>
#include <cstdint>
namespace cg = cooperative_groups;
namespace pg8 {
#define PG8_LAS __attribute__((address_space(3)))
typedef unsigned short bf16_t;
typedef short bf16x8 __attribute__((ext_vector_type(8)));
typedef float f32x4 __attribute__((ext_vector_type(4)));
typedef unsigned u32x4 __attribute__((ext_vector_type(4)));
constexpr int BM = 256, BK = 64, HALF = 128, HTB = HALF * BK * 2  , STAGE_BYTES = 8 * HTB, NXCD = 8, WGM = 8;

__host__ __device__ __forceinline__ int lds_byte(int r, int c) { const int st = (r >> 4) * 2 + (c >> 5), rr = r & 15, cc = c & 31, ob = rr * 64 + cc * 2; return st * 1024 + (ob ^ (((ob >> 9) & 1) << 5)); }
__host__ __device__ __forceinline__ void stage_rc(int b, int& R, int& C) { const int st = b / 1024, sb = b % 1024, swz = sb ^ (((sb >> 9) & 1) << 5); R = (st >> 1) * 16 + swz / 64; C = (st & 1) * 32 + (swz % 64) / 2; }
__host__ __device__ __forceinline__ int perm32(int rho) { const int n = rho >> 4, i = rho & 15; return 8 * (i >> 2) + 4 * n + (i & 3); }

struct Unit { int pm, pn; };
struct Gemm { const bf16_t* A; const bf16_t* Bt; int M, N, K; };

struct StaticOrder {
    int nM, nN, nwg, G, c;
    __host__ __device__ void init(int M, int N, int G_, int c_) { nM = M / BM; nN = N / BM; nwg = nM * nN; G = G_; c = c_; }
    __host__ __device__ bool next(int i, Unit& u) const {
        const long L = (long)i * G + c; if (L >= nwg) return false;
        int wgid = (int)L; { const int q = nwg / NXCD, r = nwg % NXCD, xcd = wgid % NXCD, off = wgid / NXCD; wgid = (xcd < r ? xcd * (q + 1) : r * (q + 1) + (xcd - r) * q) + off; }
        const int nig = WGM * nN, gid = wgid / nig, fm = gid * WGM, gsz = (nM - fm) < WGM ? (nM - fm) : WGM;
        u.pm = fm + ((wgid % nig) % gsz); u.pn = (wgid % nig) / gsz; return true;
    }
    __device__ __forceinline__ void a_ready(const Unit&) const {}
    __device__ __forceinline__ void done(const Unit&) const {}
};

__device__ __forceinline__ unsigned cvt_pk_bf16(float lo, float hi) { unsigned r; asm volatile("v_cvt_pk_bf16_f32 %0, %1, %2" : "=v"(r) : "v"(lo), "v"(hi)); return r; }
typedef unsigned u32x2 __attribute__((ext_vector_type(2)));

__device__ __forceinline__ float row_rstd(const float* ssq, int row, int fq) {
    const f32x4* p = (const f32x4*)(ssq + (size_t)row * 32 + fq * 8);
    const f32x4 a = p[0], b = p[1];
    float s = ((a[0] + a[1]) + (a[2] + a[3])) + ((b[0] + b[1]) + (b[2] + b[3]));
    s += __shfl_xor(s, 16); s += __shfl_xor(s, 32);
    return 1.0f / sqrtf(s * (1.0f / 2048.0f) + 1e-6f);
}

struct EpiScaleBf16 {
    static constexpr bool PERM = true, AFTER_DRAIN = false;
    bf16_t* O; int ldc; const float* ssq;
    __device__ __forceinline__ void operator()(f32x4 (&acc)[2][2][4][2], const Unit& u, int wr, int wc, int fr, int fq) const {
        asm volatile("" : "+v"(fr), "+v"(fq));
        const int row0 = u.pm * BM + wr * 64 + fr, col0 = u.pn * BM + wc * 32 + 8 * fq;
#pragma unroll
        for (int ai = 0; ai < 2; ++ai)
#pragma unroll
            for (int m = 0; m < 4; ++m) { const int row = row0 + ai * HALF + m * 16; const float rs = row_rstd(ssq, row, fq);
                bf16_t* rowp = O + (size_t)row * ldc + col0;
#pragma unroll
                for (int bj = 0; bj < 2; ++bj) { const f32x4 v0 = acc[ai][bj][m][0] * rs, v1 = acc[ai][bj][m][1] * rs;
                    u32x4 w; w.x = cvt_pk_bf16(v0[0], v0[1]); w.y = cvt_pk_bf16(v0[2], v0[3]); w.z = cvt_pk_bf16(v1[0], v1[1]); w.w = cvt_pk_bf16(v1[2], v1[3]);
                    *(u32x4*)(rowp + bj * HALF) = w; } }
    }
};

template <int N> __device__ __forceinline__ float dpp_shr(float v, float fill) { return __builtin_bit_cast(float, __builtin_amdgcn_update_dpp(__builtin_bit_cast(int, fill), __builtin_bit_cast(int, v), 0x110 + N, 0xf, 0xf, false)); }
struct EpiZ1 {
    static constexpr bool PERM = true, AFTER_DRAIN = false;
    bf16_t* O; int ldc; const float* ssq; const float* lbl; float* eg;
    __device__ __forceinline__ void operator()(f32x4 (&acc)[2][2][4][2], const Unit& u, int wr, int wc, int fr, int fq) const {
        asm volatile("" : "+v"(fr), "+v"(fq));
        const int row0 = u.pm * BM + wr * 64 + fr, col0 = u.pn * BM + wc * 32 + 8 * fq;
        if (u.pn < 12) {
            const int ch0 = u.pn * 128 + wc * 32 + 8 * fq;
            const int lane15 = (fq * 16) | 15;
            float lb[8];
            { const f32x4 l0 = *(const f32x4*)(lbl + ch0), l1 = *(const f32x4*)(lbl + ch0 + 4), l2 = *(const f32x4*)(lbl + 1536 + ch0), l3 = *(const f32x4*)(lbl + 1536 + ch0 + 4);
#pragma unroll
              for (int e = 0; e < 4; ++e) { lb[e] = __builtin_amdgcn_rcpf(1.0f + __expf(l0[e] - l2[e])); lb[4 + e] = __builtin_amdgcn_rcpf(1.0f + __expf(l1[e] - l3[e])); } }
#pragma unroll
            for (int ai = 0; ai < 2; ++ai) {
                float carry[8];
#pragma unroll
                for (int c = 0; c < 8; ++c) carry[c] = 1.0f;
#pragma unroll
                for (int m = 0; m < 4; ++m) { const int row = row0 + ai * HALF + m * 16; const float rs = row_rstd(ssq, row, fq);
#pragma unroll
                    for (int n = 0; n < 2; ++n)
#pragma unroll
                        for (int e = 0; e < 4; ++e) { const int c = 4 * n + e; const float qv = acc[ai][0][m][n][e] * rs, fv = acc[ai][1][m][n][e] * rs;
                            const float fg = lb[c] + (1.0f - lb[c]) * __builtin_amdgcn_rcpf(1.0f + __expf(-fv));
                            float x = fg; x *= dpp_shr<1>(x, 1.0f); x *= dpp_shr<2>(x, 1.0f); x *= dpp_shr<4>(x, 1.0f); x *= dpp_shr<8>(x, 1.0f);
                            const float tot = __shfl(x, lane15), cp = x * carry[c]; carry[c] *= tot;
                            acc[ai][0][m][n][e] = qv * __builtin_amdgcn_rcpf(1.0f + __expf(-qv)) * cp;
                            acc[ai][1][m][n][e] = (1.0f - fg) * __builtin_amdgcn_rcpf(fmaxf(cp, 1e-30f)); }
                    bf16_t* rowp = O + (size_t)row * ldc + col0;
#pragma unroll
                    for (int bj = 0; bj < 2; ++bj) { const f32x4 v0 = acc[ai][bj][m][0], v1 = acc[ai][bj][m][1];
                        u32x4 w; w.x = cvt_pk_bf16(v0[0], v0[1]); w.y = cvt_pk_bf16(v0[2], v0[3]); w.z = cvt_pk_bf16(v1[0], v1[1]); w.w = cvt_pk_bf16(v1[2], v1[3]);
                        *(u32x4*)(rowp + bj * HALF) = w; }
                    __builtin_amdgcn_sched_barrier(0); }
                if (fr == 0) { float* ep = eg + (size_t)((u.pm * BM + ai * HALF + wr * 64) >> 6) * 1536 + ch0;
                    *(f32x4*)ep = (f32x4){carry[0], carry[1], carry[2], carry[3]}; *(f32x4*)(ep + 4) = (f32x4){carry[4], carry[5], carry[6], carry[7]}; }
            }
        } else {
#pragma unroll
            for (int ai = 0; ai < 2; ++ai)
#pragma unroll
                for (int m = 0; m < 4; ++m) { const int row = row0 + ai * HALF + m * 16; const float rs = row_rstd(ssq, row, fq);
                    bf16_t* rowp = O + (size_t)row * ldc + col0;
#pragma unroll
                    for (int bj = 0; bj < 2; ++bj) { const f32x4 v0 = acc[ai][bj][m][0] * rs, v1 = acc[ai][bj][m][1] * rs;
                        u32x4 w; w.x = cvt_pk_bf16(v0[0], v0[1]); w.y = cvt_pk_bf16(v0[2], v0[3]); w.z = cvt_pk_bf16(v1[0], v1[1]); w.w = cvt_pk_bf16(v1[2], v1[3]);
                        *(u32x4*)(rowp + bj * HALF) = w; } }
        }
    }
};

template <bool BF_BASE, bool W32, bool W16> struct EpiRes {
    static constexpr bool PERM = false, AFTER_DRAIN = false;
    const float* base32; const bf16_t* base16; float* out; bf16_t* hb; float* ssq;
    __device__ __forceinline__ void operator()(f32x4 (&acc)[2][2][4][2], const Unit& u, int wr, int wc, int fr, int fq) const {
        asm volatile("" : "+v"(fr), "+v"(fq));
        const int row0 = u.pm * BM + wr * 64 + fr, col0 = u.pn * BM + wc * 32 + 4 * fq;
#pragma unroll
        for (int ai = 0; ai < 2; ++ai) {
            f32x4 b[4][2][2];
#pragma unroll
            for (int m = 0; m < 4; ++m)
#pragma unroll
                for (int bj = 0; bj < 2; ++bj)
#pragma unroll
                    for (int n = 0; n < 2; ++n) { const size_t o2 = (size_t)(row0 + ai * HALF + m * 16) * 2048 + col0 + bj * HALF + n * 16;
                        if constexpr (BF_BASE) { const u32x2 w = *(const u32x2*)(base16 + o2); b[m][bj][n] = (f32x4){__builtin_bit_cast(float, w.x << 16), __builtin_bit_cast(float, w.x & 0xffff0000u), __builtin_bit_cast(float, w.y << 16), __builtin_bit_cast(float, w.y & 0xffff0000u)}; }
                        else b[m][bj][n] = *(const f32x4*)(base32 + o2); }
#pragma unroll
            for (int m = 0; m < 4; ++m) { const int row = row0 + ai * HALF + m * 16; const size_t off = (size_t)row * 2048 + col0; float ss = 0.f;
#pragma unroll
                for (int bj = 0; bj < 2; ++bj)
#pragma unroll
                    for (int n = 0; n < 2; ++n) { const size_t o2 = off + bj * HALF + n * 16; const f32x4 o = b[m][bj][n] + acc[ai][bj][m][n];
                        ss += (o[0] * o[0] + o[1] * o[1]) + (o[2] * o[2] + o[3] * o[3]);
                        if constexpr (W32) *(f32x4*)(out + o2) = o;
                        if constexpr (W16) { u32x2 w; w.x = cvt_pk_bf16(o[0], o[1]); w.y = cvt_pk_bf16(o[2], o[3]); *(u32x2*)(hb + o2) = w; } }
                ss += __shfl_xor(ss, 16); ss += __shfl_xor(ss, 32);
                if (fq == 0) ssq[(size_t)row * 32 + u.pn * 4 + wc] = ss; }
            asm volatile("" ::: "memory");
        }
    }
};

template <int N> __device__ __forceinline__ float dpp_ror(float v) { return __builtin_bit_cast(float, __builtin_amdgcn_update_dpp(0, __builtin_bit_cast(int, v), 0x120 + N, 0xf, 0xf, false)); }
struct EpiUp {
    static constexpr bool PERM = true, AFTER_DRAIN = false;
    bf16_t* act; bf16_t* side; const float* ssq; const float* cw; const float* cb;
    __device__ __forceinline__ void operator()(f32x4 (&acc)[2][2][4][2], const Unit& u, int wr, int wc, int fr, int fq) const {
        asm volatile("" : "+v"(fr), "+v"(fq));
        const int row0 = u.pm * BM + wr * 64 + fr, f0 = u.pn * HALF + wc * 32 + 8 * fq;
#pragma unroll
        for (int ai = 0; ai < 2; ++ai) {
#pragma unroll
            for (int m = 0; m < 4; ++m) { const float rs = row_rstd(ssq, row0 + ai * HALF + m * 16, fq);
#pragma unroll
                for (int n = 0; n < 2; ++n) { acc[ai][0][m][n] = acc[ai][0][m][n] * rs; acc[ai][1][m][n] = acc[ai][1][m][n] * rs; } }
            const int grp = (u.pm * BM + ai * HALF + wr * 64) >> 6;
            if (fr < 2) { const f32x4 ga = acc[ai][1][0][0], gb = acc[ai][1][0][1], ua = acc[ai][0][0][0], ub = acc[ai][0][0][1];
                u32x4 wg, wu; wg.x = cvt_pk_bf16(ga[0], ga[1]); wg.y = cvt_pk_bf16(ga[2], ga[3]); wg.z = cvt_pk_bf16(gb[0], gb[1]); wg.w = cvt_pk_bf16(gb[2], gb[3]);
                wu.x = cvt_pk_bf16(ua[0], ua[1]); wu.y = cvt_pk_bf16(ua[2], ua[3]); wu.z = cvt_pk_bf16(ub[0], ub[1]); wu.w = cvt_pk_bf16(ub[2], ub[3]);
                *(u32x4*)(side + ((size_t)grp * 6 + fr) * 5632 + f0) = wg; *(u32x4*)(side + ((size_t)grp * 6 + 2 + fr) * 5632 + f0) = wu; }
            if (fr >= 14) { const f32x4 ga = acc[ai][1][3][0], gb = acc[ai][1][3][1];
                u32x4 wg; wg.x = cvt_pk_bf16(ga[0], ga[1]); wg.y = cvt_pk_bf16(ga[2], ga[3]); wg.z = cvt_pk_bf16(gb[0], gb[1]); wg.w = cvt_pk_bf16(gb[2], gb[3]);
                *(u32x4*)(side + ((size_t)grp * 6 + 4 + (fr - 14)) * 5632 + f0) = wg; }
        }
#pragma unroll
        for (int n = 0; n < 2; ++n) {
            const f32x4 w0 = *(const f32x4*)(cw + f0 + 4 * n), w1 = *(const f32x4*)(cw + 5632 + f0 + 4 * n), w2 = *(const f32x4*)(cw + 2 * 5632 + f0 + 4 * n), bb = *(const f32x4*)(cb + f0 + 4 * n);
#pragma unroll
            for (int ai = 0; ai < 2; ++ai)
#pragma unroll
                for (int m = 0; m < 4; ++m)
#pragma unroll
                    for (int e = 0; e < 4; ++e) { const float g0 = acc[ai][1][m][n][e], gp = acc[ai][1][m > 0 ? m - 1 : 0][n][e];
                        const float p1 = dpp_ror<1>(fr == 15 ? gp : g0), p2 = dpp_ror<2>(fr >= 14 ? gp : g0);
                        const float c = bb[e] + w0[e] * p2 + w1[e] * p1 + w2[e] * g0;
                        acc[ai][0][m][n][e] = c * __builtin_amdgcn_rcpf(1.0f + __expf(-c)) * acc[ai][0][m][n][e]; }
        }
#pragma unroll
        for (int ai = 0; ai < 2; ++ai)
#pragma unroll
            for (int m = 0; m < 4; ++m) { const int row = row0 + ai * HALF + m * 16; const f32x4 oa = acc[ai][0][m][0], ob = acc[ai][0][m][1];
                u32x4 w; w.x = cvt_pk_bf16(oa[0], oa[1]); w.y = cvt_pk_bf16(oa[2], oa[3]); w.z = cvt_pk_bf16(ob[0], ob[1]); w.w = cvt_pk_bf16(ob[2], ob[3]);
                *(u32x4*)(act + (size_t)row * 5632 + f0) = w; }
    }
};

template <class Epi, class Sched, bool ALIGN_EPI = false, bool SP2 = false>
__device__ __forceinline__ void gemm_phase(PG8_LAS unsigned char* lds, const Gemm g, const Sched& S, const Epi& E) {
    const int tid = threadIdx.x, wid = __builtin_amdgcn_readfirstlane(tid >> 6), lane = tid & 63, wr = wid >> 2, wc = wid & 3, fr = lane & 15, fq = lane >> 4;
    const int K = g.K, nt = K / BK;
    unsigned voffA[2], voffB[2];
#pragma unroll
    for (int i = 0; i < 2; ++i) { int R, C; stage_rc(tid * 16 + i * 8192, R, C); const int Rb = Epi::PERM ? ((R & ~31) + perm32(R & 31)) : R;
        voffA[i] = (unsigned)(R * K + C) * 2u; voffB[i] = (unsigned)(Rb * K + C) * 2u; }
    const size_t kstep = (size_t)(BK * 2);
    const size_t hstep = (size_t)HALF * K * 2;
    const size_t tstep = 2 * hstep;
    const unsigned ldsw = (unsigned)wid * 1024u;
    const int aoff = lds_byte(wr * 64 + fr, fq * 8), boff = lds_byte(wc * 32 + fr, fq * 8);
#define PG8_SA(b, h) (((b) * 2 + (h)) * HTB)
#define PG8_SB(b, h) ((4 + (b) * 2 + (h)) * HTB)
#define PG8_STAGE(bufoff, gbase, voff) do { _Pragma("unroll") for (int _i = 0; _i < 2; ++_i) \
        __builtin_amdgcn_global_load_lds((const unsigned*)((const char*)(gbase) + (voff)[_i]), (PG8_LAS unsigned*)(lds + (bufoff) + ldsw + _i * 8192), 16, 0, 0); } while (0)
#define PG8_LDA(dst, b, h) do { _Pragma("unroll") for (int m = 0; m < 4; ++m) _Pragma("unroll") for (int k = 0; k < 2; ++k) dst[m][k] = *(const PG8_LAS bf16x8*)(lds + PG8_SA(b, h) + aoff + m * 2048 + k * 1024); } while (0)
#define PG8_LDB(dst, b, h) do { _Pragma("unroll") for (int n = 0; n < 2; ++n) _Pragma("unroll") for (int k = 0; k < 2; ++k) dst[n][k] = *(const PG8_LAS bf16x8*)(lds + PG8_SB(b, h) + boff + n * 2048 + k * 1024); } while (0)
#define PG8_MMA(ai, bj, At, Bt) do { __builtin_amdgcn_s_setprio(1); _Pragma("unroll") for (int m = 0; m < 4; ++m) _Pragma("unroll") for (int n = 0; n < 2; ++n) _Pragma("unroll") for (int k = 0; k < 2; ++k) \
        acc[ai][bj][m][n] = __builtin_amdgcn_mfma_f32_16x16x32_bf16(Bt[n][k], At[m][k], acc[ai][bj][m][n], 0, 0, 0); __builtin_amdgcn_s_setprio(0); } while (0)
#define PG8_WAIT_V(n) asm volatile("s_waitcnt vmcnt(" #n ")" ::: "memory")
#define PG8_WAIT_L(n) asm volatile("s_waitcnt lgkmcnt(" #n ")" ::: "memory")
#define PG8_BAR __builtin_amdgcn_s_barrier()
#define PG8_SCHED __builtin_amdgcn_sched_barrier(0)
    Unit cur, nxt; int ui = 0;
    if (!S.next(0, cur)) return;
    f32x4 acc[2][2][4][2];
#pragma unroll
    for (int a = 0; a < 2; ++a)
#pragma unroll
        for (int b = 0; b < 2; ++b)
#pragma unroll
            for (int m = 0; m < 4; ++m)
#pragma unroll
                for (int n = 0; n < 2; ++n) acc[a][b][m][n] = (f32x4){0.f, 0.f, 0.f, 0.f};
    bf16x8 At[4][2], B0[2][2], B1[2][2];
    const char* cA = (const char*)g.A + (size_t)cur.pm * tstep; const char* cB = (const char*)g.Bt + (size_t)cur.pn * tstep;
    S.a_ready(cur);
    if constexpr (SP2) {
        PG8_STAGE(PG8_SB(0, 0), cB, voffB); PG8_STAGE(PG8_SB(0, 1), cB + hstep, voffB); PG8_STAGE(PG8_SA(0, 0), cA, voffA); PG8_STAGE(PG8_SA(0, 1), cA + hstep, voffA);
        if (wr == 1) PG8_BAR;
        PG8_WAIT_V(2); PG8_BAR;
        PG8_STAGE(PG8_SB(1, 0), cB + kstep, voffB); PG8_STAGE(PG8_SA(1, 0), cA + kstep, voffA); PG8_STAGE(PG8_SB(1, 1), cB + hstep + kstep, voffB);
        PG8_WAIT_V(6); PG8_BAR;
    } else {
        PG8_STAGE(PG8_SB(0, 0), cB, voffB); PG8_STAGE(PG8_SA(0, 0), cA, voffA); PG8_STAGE(PG8_SB(0, 1), cB + hstep, voffB); PG8_STAGE(PG8_SA(0, 1), cA + hstep, voffA);
        if (wr == 1) PG8_BAR;
        PG8_WAIT_V(4); PG8_BAR;
        PG8_STAGE(PG8_SB(1, 0), cB + kstep, voffB); PG8_STAGE(PG8_SA(1, 0), cA + kstep, voffA); PG8_STAGE(PG8_SB(1, 1), cB + hstep + kstep, voffB);
        PG8_WAIT_V(6); PG8_BAR;
    }
    for (;;) {
        const bool has_next = S.next(ui + 1, nxt);
        const char* nA = has_next ? (const char*)g.A + (size_t)nxt.pm * tstep : cA; const char* nB = has_next ? (const char*)g.Bt + (size_t)nxt.pn * tstep : cB;
        for (int t = 0; t < nt; t += 2) {
            const bool last = (t == nt - 2);
            const char* a1 = cA + (size_t)(t + 1) * kstep;
            const char* a2 = last ? nA : cA + (size_t)(t + 2) * kstep; const char* b2 = last ? nB : cB + (size_t)(t + 2) * kstep;
            const char* a3 = a2 + kstep; const char* b3 = b2 + kstep;
            if (last && has_next) S.a_ready(nxt);
            if constexpr (SP2) {
            PG8_LDB(B0, 0, 0); PG8_LDB(B1, 0, 1); PG8_SCHED; PG8_LDA(At, 0, 0); PG8_STAGE(PG8_SA(1, 1), a1 + hstep, voffA);
            PG8_WAIT_V(8); PG8_WAIT_L(0); PG8_BAR; PG8_MMA(0, 0, At, B0); PG8_MMA(0, 1, At, B1); PG8_BAR; PG8_SCHED;
            PG8_LDA(At, 0, 1); PG8_STAGE(PG8_SB(0, 0), b2, voffB); PG8_STAGE(PG8_SB(0, 1), b2 + hstep, voffB); PG8_STAGE(PG8_SA(0, 0), a2, voffA);
            PG8_WAIT_V(8); PG8_WAIT_L(0); PG8_BAR; PG8_MMA(1, 0, At, B0); PG8_MMA(1, 1, At, B1); PG8_BAR; PG8_SCHED;
            PG8_LDB(B0, 1, 0); PG8_LDB(B1, 1, 1); PG8_SCHED; PG8_LDA(At, 1, 0); PG8_STAGE(PG8_SA(0, 1), a2 + hstep, voffA);
            PG8_WAIT_V(8); PG8_WAIT_L(0); PG8_BAR; PG8_MMA(0, 0, At, B0); PG8_MMA(0, 1, At, B1); PG8_BAR; PG8_SCHED;
            PG8_LDA(At, 1, 1); PG8_STAGE(PG8_SB(1, 0), b3, voffB); PG8_STAGE(PG8_SB(1, 1), b3 + hstep, voffB); PG8_STAGE(PG8_SA(1, 0), a3, voffA);
            PG8_WAIT_V(8); PG8_WAIT_L(0); PG8_BAR; PG8_MMA(1, 0, At, B0); PG8_MMA(1, 1, At, B1); PG8_BAR; PG8_SCHED;
            } else {
            PG8_LDB(B0, 0, 0); PG8_SCHED; PG8_LDA(At, 0, 0); PG8_STAGE(PG8_SA(1, 1), a1 + hstep, voffA);
            PG8_WAIT_L(8); PG8_BAR; PG8_WAIT_L(0); PG8_MMA(0, 0, At, B0); PG8_BAR; PG8_SCHED;
            PG8_LDB(B1, 0, 1); PG8_STAGE(PG8_SB(0, 0), b2, voffB);
            PG8_BAR; PG8_WAIT_L(0); PG8_MMA(0, 1, At, B1); PG8_BAR;
            PG8_LDA(At, 0, 1); PG8_STAGE(PG8_SA(0, 0), a2, voffA);
            PG8_BAR; PG8_WAIT_L(0); PG8_MMA(1, 0, At, B0); PG8_BAR; PG8_SCHED;
            PG8_STAGE(PG8_SB(0, 1), b2 + hstep, voffB);
            PG8_WAIT_V(6); PG8_BAR; PG8_MMA(1, 1, At, B1); PG8_BAR;
            PG8_LDB(B0, 1, 0); PG8_SCHED; PG8_LDA(At, 1, 0); PG8_STAGE(PG8_SA(0, 1), a2 + hstep, voffA);
            PG8_WAIT_L(8); PG8_BAR; PG8_WAIT_L(0); PG8_MMA(0, 0, At, B0); PG8_BAR; PG8_SCHED;
            PG8_LDB(B1, 1, 1); PG8_STAGE(PG8_SB(1, 0), b3, voffB);
            PG8_BAR; PG8_WAIT_L(0); PG8_MMA(0, 1, At, B1); PG8_BAR;
            PG8_LDA(At, 1, 1); PG8_STAGE(PG8_SA(1, 0), a3, voffA);
            PG8_BAR; PG8_WAIT_L(0); PG8_MMA(1, 0, At, B0); PG8_BAR; PG8_SCHED;
            PG8_STAGE(PG8_SB(1, 1), b3 + hstep, voffB);
            PG8_WAIT_V(6); PG8_BAR; PG8_MMA(1, 1, At, B1); PG8_BAR;
            }
        }
        if constexpr (ALIGN_EPI) { if (wr == 0) PG8_BAR; }
        if constexpr (!Epi::AFTER_DRAIN) { E(acc, cur, wr, wc, fr, fq); S.done(cur); }
        if (!has_next) break;
#pragma unroll
        for (int a = 0; a < 2; ++a)
#pragma unroll
            for (int b = 0; b < 2; ++b)
#pragma unroll
                for (int m = 0; m < 4; ++m)
#pragma unroll
                    for (int n = 0; n < 2; ++n) acc[a][b][m][n] = (f32x4){0.f, 0.f, 0.f, 0.f};
        cur = nxt; cA = nA; cB = nB; ++ui;
        if constexpr (ALIGN_EPI) { if (wr == 1) PG8_BAR; }
    }
    PG8_WAIT_V(0);
    if constexpr (!ALIGN_EPI) { if (wr == 0) PG8_BAR; }
    PG8_BAR;
    if constexpr (Epi::AFTER_DRAIN) { E.fused(acc, cur, wr, wc, fr, fq, lds, wid, lane); S.done(cur); }
#undef PG8_SA
#undef PG8_SB
#undef PG8_STAGE
#undef PG8_LDA
#undef PG8_LDB
#undef PG8_MMA
#undef PG8_WAIT_V
#undef PG8_WAIT_L
#undef PG8_BAR
#undef PG8_SCHED
}
}

#ifndef PG8_SP2
#define PG8_SP2 true
#endif
#ifndef PG8_ALIGN
#define PG8_ALIGN true
#endif
constexpr int NWAVES = 8, NTHR = 512;
constexpr int BATCH = 8, SEQ = 4096, DM = 2048, T = BATCH * SEQ, MEMLEN = 256, TM = BATCH * MEMLEN;
constexpr int XAW = 512, XAH = 4, XAD = 128, MIXW = 1536;
constexpr int A_H = 4, A_DV = 384, A_DK = 192;
constexpr int B_H = 12, B_DK = 128, B_DV = 128;
constexpr int DFF = 5632;
constexpr int COLS_A = 5128, NA = 5120, NB = 6656;
constexpr int ZA_K = 768, ZA_V = 1536, ZA_O = 3072, ZA_XQ = 4608;
constexpr int ZB_F = 1536, ZB_I = 3072, ZB_G = 4608, ZB_XQ = 6144;
constexpr float EPS = 1e-6f;

constexpr size_t MiB = 1u << 20;
constexpr size_t WS_CTL = 0, WS_GATES = 1 * MiB, WS_SSQ = 2 * MiB, WS_SSQM = 6 * MiB, WS_MEMB = 8 * MiB, WS_KV = 16 * MiB, WS_SIDE = 24 * MiB;
constexpr size_t WS_WIN0 = 58 * MiB, WS_WOUT0 = 78 * MiB, WS_WUP0 = 86 * MiB, WS_WDN0 = 130 * MiB, WS_WIN1 = 152 * MiB, WS_WOUT1 = 178 * MiB, WS_WUP1 = 186 * MiB, WS_WDN1 = 230 * MiB, WS_WKV = 252 * MiB;
constexpr size_t WS_HRAW1 = WS_SIDE;
constexpr size_t WS_HB = 260 * MiB, WS_YCAT = 388 * MiB, WS_Z = 516 * MiB, WS_G5 = 932 * MiB, WS_END = 936 * MiB;
static_assert(WS_SIDE + (size_t)512 * 6 * DFF * 2 <= WS_WIN0 && WS_WIN0 + (size_t)NA * DM * 2 <= WS_WOUT0 && WS_WOUT0 + (size_t)DM * DM * 2 <= WS_WUP0 && WS_WUP0 + (size_t)2 * DFF * DM * 2 <= WS_WDN0 && WS_WDN0 + (size_t)DM * DFF * 2 <= WS_WIN1 &&
              WS_WIN1 + (size_t)NB * DM * 2 <= WS_WOUT1 && WS_WOUT1 + (size_t)DM * DM * 2 <= WS_WUP1 && WS_WUP1 + (size_t)2 * DFF * DM * 2 <= WS_WDN1 && WS_WDN1 + (size_t)DM * DFF * 2 <= WS_WKV && WS_WKV + (size_t)2048 * DM * 2 <= WS_HB &&
              WS_HRAW1 + (size_t)T * MIXW * 2 <= WS_WIN1 && WS_HB + (size_t)T * DM * 2 <= WS_YCAT && WS_YCAT + (size_t)T * DM * 2 <= WS_Z && WS_Z + (size_t)T * NB * 2 <= WS_G5, "d_ws map");
constexpr int LDS_BYTES = 160 * 1024, MISC_OFF = LDS_BYTES - 64;
constexpr size_t CTL_ZERO_BYTES = 65536;
constexpr int CW_BAR = 1024;

#define LAS __attribute__((address_space(3)))
typedef unsigned short bf16;
typedef float f32x4 __attribute__((ext_vector_type(4)));
typedef short bf16x8 __attribute__((ext_vector_type(8)));
typedef unsigned u32x4 __attribute__((ext_vector_type(4)));
typedef unsigned u32x2 __attribute__((ext_vector_type(2)));

typedef __bf16 bf16v2 __attribute__((ext_vector_type(2)));
__device__ __forceinline__ unsigned short f2bf(float f) { const __bf16 b = (__bf16)f; return __builtin_bit_cast(unsigned short, b); }
__device__ __forceinline__ unsigned pk2(float lo, float hi) { bf16v2 v; v[0] = (__bf16)lo; v[1] = (__bf16)hi; return __builtin_bit_cast(unsigned, v); }
__device__ __forceinline__ float bf2f(unsigned short b) { return __builtin_bit_cast(float, (unsigned)b << 16); }
__device__ __forceinline__ float wave_sum(float v) {
#pragma unroll
    for (int o = 1; o < 64; o <<= 1) v += __shfl_xor(v, o);
    return v;
}
__device__ __forceinline__ float sigmoidf_(float x) { return __builtin_amdgcn_rcpf(1.0f + __expf(-x)); }
__device__ __forceinline__ float siluf_(float x) { return x * __builtin_amdgcn_rcpf(1.0f + __expf(-x)); }

template <int KS> struct Frag { bf16x8 v[KS]; };
template <int KS> __device__ __forceinline__ void ldfrag(Frag<KS>& f, const LAS bf16* p, int ld, int fr, int fq) {
    const LAS bf16* q = p + fr * ld + fq * 8;
#pragma unroll
    for (int k = 0; k < KS; ++k) f.v[k] = *(const LAS bf16x8*)(q + 32 * k);
}
typedef short s16x4 __attribute__((ext_vector_type(4)));
template <int KS> __device__ __forceinline__ void ldfrag_tr(Frag<KS>& f, const LAS bf16* X, int ld, int c0, int fr, int fq) {
    const LAS bf16* q = X + (8 * fq + (fr >> 2)) * ld + c0 + 4 * (fr & 3);
#pragma unroll
    for (int k = 0; k < KS; ++k) { const s16x4 lo = __builtin_amdgcn_ds_read_tr16_b64_v4i16((LAS s16x4*)(q + 32 * k * ld)), hi = __builtin_amdgcn_ds_read_tr16_b64_v4i16((LAS s16x4*)(q + (32 * k + 4) * ld));
        f.v[k] = (bf16x8){lo[0], lo[1], lo[2], lo[3], hi[0], hi[1], hi[2], hi[3]}; }
}
template <int KS> __device__ __forceinline__ void ldfrag_trp(Frag<KS>& f, const LAS bf16* X, int ld, int c0, int fr, int fq) {
    const LAS bf16* q = X + (4 * fq + (fr >> 2)) * ld + c0 + 4 * (fr & 3);
#pragma unroll
    for (int k = 0; k < KS; ++k) { const s16x4 lo = __builtin_amdgcn_ds_read_tr16_b64_v4i16((LAS s16x4*)(q + 32 * k * ld)), hi = __builtin_amdgcn_ds_read_tr16_b64_v4i16((LAS s16x4*)(q + (32 * k + 16) * ld));
        f.v[k] = (bf16x8){lo[0], lo[1], lo[2], lo[3], hi[0], hi[1], hi[2], hi[3]}; }
}
template <int KS> __device__ __forceinline__ f32x4 mmaf(const Frag<KS>& a, const Frag<KS>& b, f32x4 acc) {
#pragma unroll
    for (int k = 0; k < KS; ++k) acc = __builtin_amdgcn_mfma_f32_16x16x32_bf16(a.v[k], b.v[k], acc, 0, 0, 0);
    return acc;
}
struct Args { const float* in[21]; float* out; unsigned char* ws; int ph_lo, ph_hi; };
enum { IN_X = 0, IN_MEM, IN_NMIX, IN_NMEM, IN_NFFN, IN_NOUT, IN_WKV, IN_AWIN, IN_AGB, IN_ACW, IN_ACB, IN_AHG, IN_AWOUT, IN_BWIN, IN_BLB, IN_BHG, IN_BWOUT, IN_FUP, IN_FCW, IN_FCB, IN_FDN };

struct WDesc { const float* src; bf16* dst; const float* scale; int K, Nsrc, Ndst, kind; };
__device__ __forceinline__ int src_col(int kind, int n) {
    if (kind == 1) return n < 4608 ? n : n + 8;
    if (kind == 2) { const int pn = n >> 8, r = n & 255; return (r >> 7) * DFF + pn * 128 + (r & 127); }
    if (kind == 3) { if (n >= 2 * MIXW) return n; const int hh = n >> 8, r = n & 255; return (r >> 7) * MIXW + hh * 128 + (r & 127); }
    return n;
}
__device__ __forceinline__ WDesc get_wdesc(const Args& a, int i) {
    unsigned char* ws = a.ws; WDesc d;
    switch (i) {
    case 0:  d = WDesc{a.in[IN_AWIN], (bf16*)(ws + WS_WIN0), a.in[IN_NMIX], DM, COLS_A, NA, 1}; break;
    case 1:  d = WDesc{a.in[IN_BWIN], (bf16*)(ws + WS_WIN1), a.in[IN_NMIX] + DM, DM, NB, NB, 3}; break;
    case 2:  d = WDesc{a.in[IN_AWOUT], (bf16*)(ws + WS_WOUT0), nullptr, DM, DM, DM, 0}; break;
    case 3:  d = WDesc{a.in[IN_BWOUT], (bf16*)(ws + WS_WOUT1), nullptr, DM, DM, DM, 0}; break;
    case 4:  d = WDesc{a.in[IN_FUP], (bf16*)(ws + WS_WUP0), a.in[IN_NFFN], DM, 2 * DFF, 2 * DFF, 2}; break;
    case 5:  d = WDesc{a.in[IN_FUP] + (size_t)DM * 2 * DFF, (bf16*)(ws + WS_WUP1), a.in[IN_NFFN] + DM, DM, 2 * DFF, 2 * DFF, 2}; break;
    case 6:  d = WDesc{a.in[IN_FDN], (bf16*)(ws + WS_WDN0), nullptr, DFF, DM, DM, 0}; break;
    case 7:  d = WDesc{a.in[IN_FDN] + (size_t)DFF * DM, (bf16*)(ws + WS_WDN1), nullptr, DFF, DM, DM, 0}; break;
    case 8:  d = WDesc{a.in[IN_WKV], (bf16*)(ws + WS_WKV), a.in[IN_NMEM], DM, 1024, 1024, 0}; break;
    default: d = WDesc{a.in[IN_WKV] + (size_t)DM * 1024, (bf16*)(ws + WS_WKV) + (size_t)1024 * DM, a.in[IN_NMEM] + DM, DM, 1024, 1024, 0}; break;
    }
    return d;
}
struct WTile { const float* src; bf16* dst; const float* scale; int K, Nsrc; };
__device__ __forceinline__ bool wtile_get(const Args& a, int it, WTile& t, int lane) {
    int base = 0;
#pragma unroll 1
    for (int wi = 0; wi < 10; ++wi) { const WDesc d = get_wdesc(a, wi); const int nnb = d.Ndst / 256, nit = (d.K / 64) * nnb;
        if (it < base + nit) { const int r = it - base, kb = r / nnb, nb = r - kb * nnb, k0 = 64 * kb, n0 = 256 * nb;
            const int sc = src_col(d.kind, n0 + 128 * (lane >> 5)) + 4 * (lane & 31);
            t.src = d.src + (size_t)k0 * d.Nsrc + sc; t.dst = d.dst + (size_t)n0 * d.K + k0; t.scale = d.scale ? d.scale + k0 : nullptr; t.K = d.K; t.Nsrc = d.Nsrc; return true; }
        base += nit; }
    return false;
}
constexpr int WT_ITEMS = (DM / 64) * (NA / 256) + (DM / 64) * (NB / 256) + 2 * (DM / 64) * (DM / 256) + 2 * (DM / 64) * (2 * DFF / 256) + 2 * (DFF / 64) * (DM / 256) + 2 * (DM / 64) * (1024 / 256);
__device__ __forceinline__ void phase_prologue(const Args& a, LAS unsigned char* lds, int tid, int lane, int wave) {
    unsigned char* ws = a.ws;
    LAS float* wg = (LAS float*)lds;
    { const float* W = a.in[IN_AWIN]; const float* g = a.in[IN_NMIX];
      for (int i = tid; i < DM * 8; i += NTHR) { const int k = i >> 3, j = i & 7; wg[j * DM + k] = W[(size_t)k * COLS_A + 4608 + j] * g[k]; } }
    __syncthreads();
    const int gw = blockIdx.x * NWAVES + wave, NGW = gridDim.x * NWAVES;
    { const float* x = a.in[IN_X]; bf16* hb = (bf16*)(ws + WS_HB); float* ssq = (float*)(ws + WS_SSQ); float* gates = (float*)(ws + WS_GATES); const float* gb = a.in[IN_AGB];
      for (int row = gw; row < T; row += NGW) {
        const f32x4* xr = (const f32x4*)(x + (size_t)row * DM) + lane; f32x4 v[8]; float s = 0.f;
#pragma unroll
        for (int j = 0; j < 8; ++j) { v[j] = xr[64 * j]; s += (v[j][0] * v[j][0] + v[j][1] * v[j][1]) + (v[j][2] * v[j][2] + v[j][3] * v[j][3]); }
        s = wave_sum(s);
        u32x2* o8 = (u32x2*)(hb + (size_t)row * DM) + lane;
#pragma unroll
        for (int j = 0; j < 8; ++j) { u32x2 w; w.x = pk2(v[j][0], v[j][1]); w.y = pk2(v[j][2], v[j][3]); o8[64 * j] = w; }
        float mine = 0.f;
#pragma unroll 1
        for (int q = 0; q < 8; ++q) { float t = 0.f;
#pragma unroll
            for (int j = 0; j < 8; ++j) { const f32x4 w = *(const LAS f32x4*)(wg + q * DM + 256 * j + 4 * lane); t += (v[j][0] * w[0] + v[j][1] * w[1]) + (v[j][2] * w[2] + v[j][3] * w[3]); }
            t = wave_sum(t); mine = (lane == q) ? t : mine; }
        const float rstd = 1.0f / sqrtf(s * (1.0f / DM) + EPS);
        if (lane < 32) ssq[(size_t)row * 32 + lane] = lane == 0 ? s : 0.f;
        if (lane < 8) { float pre = mine * rstd + gb[lane]; if (lane >= 4) pre = fminf(pre, 0.f) - log1pf(__expf(-fabsf(pre))); gates[(size_t)row * 8 + lane] = pre; }
      } }
    { const float* x = a.in[IN_MEM]; bf16* mb = (bf16*)(ws + WS_MEMB); float* ssq = (float*)(ws + WS_SSQM);
      for (int row = gw; row < TM; row += NGW) {
        const f32x4* xr = (const f32x4*)(x + (size_t)row * DM) + lane; f32x4 v[8]; float s = 0.f;
#pragma unroll
        for (int j = 0; j < 8; ++j) { v[j] = xr[64 * j]; s += (v[j][0] * v[j][0] + v[j][1] * v[j][1]) + (v[j][2] * v[j][2] + v[j][3] * v[j][3]); }
        s = wave_sum(s);
        u32x2* o8 = (u32x2*)(mb + (size_t)row * DM) + lane;
#pragma unroll
        for (int j = 0; j < 8; ++j) { u32x2 w; w.x = pk2(v[j][0], v[j][1]); w.y = pk2(v[j][2], v[j][3]); o8[64 * j] = w; }
        if (lane < 32) ssq[(size_t)row * 32 + lane] = lane == 0 ? s : 0.f;
      } }
    __syncthreads();
    {   LAS float* tile0 = (LAS float*)lds;
        f32x4 pf[8]; WTile cur, nxt; int it = blockIdx.x; bool have = wtile_get(a, it, cur, lane);
        if (have) {
#pragma unroll
            for (int i = 0; i < 8; ++i) pf[i] = *(const f32x4*)(cur.src + (size_t)(8 * wave + i) * cur.Nsrc); }
        int buf = 0;
        while (have) {
            LAS float* tl = tile0 + buf * (64 * 260);
#pragma unroll
            for (int i = 0; i < 8; ++i) { f32x4 v = pf[i]; if (cur.scale) v = v * cur.scale[8 * wave + i]; *(LAS f32x4*)(tl + (8 * wave + i) * 260 + 4 * lane) = v; }
            const bool have_n = wtile_get(a, it + (int)gridDim.x, nxt, lane);
            if (have_n) {
#pragma unroll
                for (int i = 0; i < 8; ++i) pf[i] = *(const f32x4*)(nxt.src + (size_t)(8 * wave + i) * nxt.Nsrc); }
            __syncthreads();
#pragma unroll
            for (int j = 0; j < 4; ++j) { const int n = lane + 64 * j; const LAS float* sp = tl + (8 * wave) * 260 + n;
                u32x4 o; o.x = pk2(sp[0], sp[260]); o.y = pk2(sp[2 * 260], sp[3 * 260]); o.z = pk2(sp[4 * 260], sp[5 * 260]); o.w = pk2(sp[6 * 260], sp[7 * 260]);
                *(u32x4*)(cur.dst + (size_t)n * cur.K + 8 * wave) = o; }
            cur = nxt; have = have_n; it += gridDim.x; buf ^= 1;
        }
    }
}

#ifndef HGRN_DUP
#define HGRN_DUP 0
#endif
#ifndef MLSTM_DUP
#define MLSTM_DUP 0
#endif
__device__ __forceinline__ void mlstm_gate_scan(const Args& a, int bh, int lane) {
    const float* gates = (const float*)(a.ws + WS_GATES); float* g5 = (float*)(a.ws + WS_G5);
    const int b = bh >> 2, h = bh & 3; float m_st = 0.f;
    const float* gp = gates + ((size_t)b * SEQ + lane) * 8 + h;
    float pig[8], plf[8];
#pragma unroll
    for (int j = 0; j < 8; ++j) { pig[j] = gp[(size_t)64 * j * 8]; plf[j] = gp[(size_t)64 * j * 8 + 4]; }
    for (int c0 = 0; c0 < SEQ / 64; c0 += 8) {
#pragma unroll
        for (int j = 0; j < 8; ++j) {
            const int c = c0 + j; const size_t t = (size_t)b * SEQ + 64 * c + lane;
            const float ig = pig[j], lf = plf[j];
            if (c + 8 < SEQ / 64) { pig[j] = gp[(size_t)64 * (c + 8) * 8]; plf[j] = gp[(size_t)64 * (c + 8) * 8 + 4]; }
            float g = lf;
#pragma unroll
            for (int o = 1; o < 64; o <<= 1) { const float x = __shfl_up(g, o); if (lane >= o) g += x; }
            const float u = ig - g; float pm = u;
#pragma unroll
            for (int o = 1; o < 64; o <<= 1) { const float x = __shfl_up(pm, o); if (lane >= o) pm = fmaxf(pm, x); }
            const float M = fmaxf(m_st, pm), M63 = __shfl(M, 63), g63 = __shfl(g, 63);
            f32x4 o0, o1; o0[0] = u; o0[1] = M; o0[2] = __expf(m_st - M); o0[3] = __expf(u - M63); o1[0] = __expf(-(g + M)); o1[1] = __expf(m_st - M63); o1[2] = 0.f; o1[3] = 0.f;
            f32x4* dst = (f32x4*)(g5 + (t * 4 + h) * 8); dst[0] = o0; dst[1] = o1;
            m_st = g63 + M63;
        }
    }
}
__device__ __forceinline__ void phase_mlstm_conv(const Args& a, int tid, int first, int stride) {
    const bf16* Z = (const bf16*)(a.ws + WS_Z); bf16* QK = (bf16*)(a.ws + WS_YCAT);
    if (tid >= 384) return;
    const int cg = tid % 192, rg2 = tid / 192, c0 = cg * 8; const float osc = cg >= 96 ? 0.07216878364870322f : 1.0f;
    float w[4][8], bias[8];
    { const float* cw = a.in[IN_ACW]; const float* cb = a.in[IN_ACB];
#pragma unroll
      for (int k = 0; k < 4; ++k) { const f32x4 x0 = *(const f32x4*)(cw + k * 1536 + c0), x1 = *(const f32x4*)(cw + k * 1536 + c0 + 4);
#pragma unroll
          for (int e = 0; e < 4; ++e) { w[k][e] = x0[e]; w[k][4 + e] = x1[e]; } }
      const f32x4 b0 = *(const f32x4*)(cb + c0), b1 = *(const f32x4*)(cb + c0 + 4);
#pragma unroll
      for (int e = 0; e < 4; ++e) { bias[e] = b0[e]; bias[4 + e] = b1[e]; } }
    for (int it = first; it < T / 16; it += stride) {
        const int t0 = it * 16 + rg2 * 8; const bool start = (t0 % SEQ) == 0;
        float x[11][8];
#pragma unroll
        for (int r = 0; r < 11; ++r) { u32x4 v = (u32x4){0u, 0u, 0u, 0u}; if (r >= 3 || !start) v = *(const u32x4*)(Z + (size_t)(t0 - 3 + r) * NA + c0);
            const unsigned vv[4] = {v.x, v.y, v.z, v.w};
#pragma unroll
            for (int e = 0; e < 4; ++e) { x[r][2 * e] = bf2f((bf16)(vv[e] & 0xffffu)); x[r][2 * e + 1] = bf2f((bf16)(vv[e] >> 16)); } }
#pragma unroll
        for (int r = 0; r < 8; ++r) { float y[8];
#pragma unroll
            for (int e = 0; e < 8; ++e) { const float c = bias[e] + w[0][e] * x[r][e] + w[1][e] * x[r + 1][e] + w[2][e] * x[r + 2][e] + w[3][e] * x[r + 3][e]; y[e] = siluf_(c) * osc; }
            u32x4 o; o.x = pk2(y[0], y[1]); o.y = pk2(y[2], y[3]); o.z = pk2(y[4], y[5]); o.w = pk2(y[6], y[7]);
            *(u32x4*)(QK + (size_t)(t0 + r) * MIXW + c0) = o; }
    }
}
__device__ __forceinline__ void phase_mlstm(const Args& a, LAS unsigned char* lds, int tid, int lane, int wave) {
    unsigned char* ws = a.ws;
    const bf16* Z = (const bf16*)(ws + WS_Z); const bf16* QK = (const bf16*)(ws + WS_YCAT); const float* g5 = (const float*)(ws + WS_G5); bf16* hraw = (bf16*)(ws + WS_HB);
    LAS bf16* Qs = (LAS bf16*)lds;
    LAS bf16* Ks = (LAS bf16*)(lds + 25600);
    LAS bf16* Vs = (LAS bf16*)(lds + 51200);
    LAS bf16* VWs = (LAS bf16*)(lds + 60416);
    LAS bf16* Ps = (LAS bf16*)(lds + 69632);
    LAS bf16* CT0 = (LAS bf16*)(lds + 78848);
    LAS float* fu = (LAS float*)(lds + 130048);
    LAS float* fM = fu + 64; LAS float* fwi = fu + 128; LAS float* fem = fu + 192; LAS float* fdec = fu + 256;
    const int fr = lane & 15, fq = lane >> 4;
    for (int item = blockIdx.x; item < BATCH * A_H * 8; item += gridDim.x) {
        const int bh = (item & 7) * 4 + (item >> 6), js = (item >> 3) & 7, b = bh >> 2, h = bh & 3;
        __syncthreads();
        for (int i = tid; i < 2 * 64 * 200 / 2; i += NTHR) ((LAS unsigned*)CT0)[i] = 0u;
        for (int i = tid; i < 64 * 72 / 2; i += NTHR) ((LAS unsigned*)VWs)[i] = 0u;
        for (int i = tid; i < 64 * 72; i += NTHR) Vs[i] = (i % 72 == 48) ? (bf16)0x3f80 : (bf16)0;
        f32x4 cacc[6];
#pragma unroll
        for (int i = 0; i < 6; ++i) cacc[i] = (f32x4){0.f, 0.f, 0.f, 0.f};
        __syncthreads();
        const int vrow = tid / 6, vcc = tid - vrow * 6;
        const int grow = tid >> 1, ghalf = tid & 1;
        const bf16* qkbase = QK + (size_t)b * SEQ * MIXW + h * A_DK;
        const bf16* vbase = Z + (size_t)b * SEQ * NA + ZA_V + h * A_DV + js * 48 + vcc * 8;
        const float* gbase = g5 + ((size_t)b * SEQ * 4 + h) * 8;
        u32x4 pq[3], pk[3], pv; f32x4 pg; float pws;
#define MLSTM_PREFETCH(c_) do { const size_t tt = (size_t)64 * (c_); int tp_ = tid; asm volatile("" : "+v"(tp_)); \
            _Pragma("unroll") for (int j = 0; j < 3; ++j) { const int i = tp_ + NTHR * j, row = i / 24, cc = i - row * 24; pq[j] = *(const u32x4*)(qkbase + (tt + row) * MIXW + cc * 8); pk[j] = *(const u32x4*)(qkbase + (tt + row) * MIXW + 768 + cc * 8); } \
            if (tid < 384) { pv = *(const u32x4*)(vbase + (tt + vrow) * NA); pws = gbase[(tt + vrow) * 32 + 3]; } \
            if (tid < 128) pg = *(const f32x4*)(gbase + (tt + grow) * 32 + 4 * ghalf); } while (0)
        MLSTM_PREFETCH(0);
        for (int c = 0; c < SEQ / 64; ++c) {
            const size_t t0 = (size_t)b * SEQ + 64 * c; const int cur = c & 1;
            LAS bf16* CTc = CT0 + cur * 64 * 200; LAS bf16* CTn = CT0 + (cur ^ 1) * 64 * 200;
            {
            int ts_ = tid; asm volatile("" : "+v"(ts_));
#pragma unroll
            for (int j = 0; j < 3; ++j) { const int i = ts_ + NTHR * j, row = i / 24, cc = i - row * 24;
                *(LAS u32x4*)(Qs + row * 200 + cc * 8) = pq[j]; *(LAS u32x4*)(Ks + row * 200 + cc * 8) = pk[j]; }
            if (tid < 384) { *(LAS u32x4*)(Vs + vrow * 72 + vcc * 8) = pv; const unsigned vv[4] = {pv.x, pv.y, pv.z, pv.w}; unsigned ww[4];
#pragma unroll
                for (int e = 0; e < 4; ++e) ww[e] = pk2(bf2f((bf16)(vv[e] & 0xffffu)) * pws, bf2f((bf16)(vv[e] >> 16)) * pws);
                *(LAS u32x4*)(VWs + vrow * 72 + vcc * 8) = (u32x4){ww[0], ww[1], ww[2], ww[3]}; }
            if (tid < 128) { if (ghalf == 0) { fu[grow] = pg[0]; fM[grow] = pg[1]; fwi[grow] = pg[2]; VWs[grow * 72 + 48] = f2bf(pg[3]); } else { fem[grow] = pg[0]; if (grow == 0) fdec[0] = pg[1]; } }
            }
            __syncthreads();
            if (c + 1 < SEQ / 64) MLSTM_PREFETCH(c + 1);
            {
                const int li = wave >> 1, half = wave & 1, l = 16 * li + fr; const float wil = fwi[l], Ml = fM[l];
                Frag<6> fqq; ldfrag(fqq, Qs + 16 * li * 200, 200, fr, fq);
                unsigned pb[4][2];
#pragma unroll
                for (int si = 0; si < 4; ++si) { pb[si][0] = 0u; pb[si][1] = 0u;
                    if (si <= li) { Frag<6> fk; ldfrag(fk, Ks + 16 * si * 200, 200, fr, fq); const f32x4 sacc = mmaf<6>(fk, fqq, (f32x4){0.f, 0.f, 0.f, 0.f}); float p[4];
#pragma unroll
                        for (int r = 0; r < 4; ++r) { const int sx = 16 * si + 4 * fq + r; p[r] = (sx <= l) ? sacc[r] * __expf(fu[sx] - Ml) : 0.f; }
                        pb[si][0] = pk2(p[0], p[1]); pb[si][1] = pk2(p[2], p[3]); } }
                Frag<2> fp;
#pragma unroll
                for (int k = 0; k < 2; ++k) { const u32x4 w = (u32x4){pb[2 * k][0], pb[2 * k][1], pb[2 * k + 1][0], pb[2 * k + 1][1]}; fp.v[k] = __builtin_bit_cast(bf16x8, w); }
                const int vfa = half ? 2 : 0;
                Frag<6> ca, cd; Frag<2> va, vd; ldfrag(ca, CTc + 16 * vfa * 200, 200, fr, fq); ldfrag(cd, CTc + 16 * 3 * 200, 200, fr, fq); ldfrag_trp(va, Vs, 72, 16 * vfa, fr, fq); ldfrag_trp(vd, Vs, 72, 48, fr, fq);
                f32x4 oa = (f32x4){0.f, 0.f, 0.f, 0.f}, od = oa, ob = oa;
#pragma unroll
                for (int k = 0; k < 6; ++k) { oa = __builtin_amdgcn_mfma_f32_16x16x32_bf16(ca.v[k], fqq.v[k], oa, 0, 0, 0); od = __builtin_amdgcn_mfma_f32_16x16x32_bf16(cd.v[k], fqq.v[k], od, 0, 0, 0); }
                oa = oa * wil; od = od * wil;
#pragma unroll
                for (int k = 0; k < 2; ++k) { oa = __builtin_amdgcn_mfma_f32_16x16x32_bf16(va.v[k], fp.v[k], oa, 0, 0, 0); od = __builtin_amdgcn_mfma_f32_16x16x32_bf16(vd.v[k], fp.v[k], od, 0, 0, 0); }
                if (!half) { Frag<6> cb; Frag<2> vb; ldfrag(cb, CTc + 16 * 200, 200, fr, fq); ldfrag_trp(vb, Vs, 72, 16, fr, fq);
                    ob = mmaf<6>(cb, fqq, ob); ob = ob * wil; ob = mmaf<2>(vb, fp, ob); }
                const float den = __shfl(od[0], fr), dinv = __builtin_amdgcn_rcpf(fmaxf(fabsf(den), fem[l]));
                bf16* orow = hraw + (t0 + l) * MIXW + h * A_DV + js * 48 + 4 * fq;
                { u32x2 w2; w2.x = pk2(oa[0] * dinv, oa[1] * dinv); w2.y = pk2(oa[2] * dinv, oa[3] * dinv); *(u32x2*)(orow + 16 * vfa) = w2; }
                if (!half) { u32x2 w2; w2.x = pk2(ob[0] * dinv, ob[1] * dinv); w2.y = pk2(ob[2] * dinv, ob[3] * dinv); *(u32x2*)(orow + 16) = w2; }
            }
            {
                const float decay = fdec[0];
                Frag<2> fv[4];
#pragma unroll
                for (int vf = 0; vf < 4; ++vf) ldfrag_tr(fv[vf], VWs, 72, 16 * vf, fr, fq);
                const int dk0 = (6 * wave) >> 2;
                Frag<2> fka, fkb; ldfrag_tr(fka, Ks, 200, 16 * dk0, fr, fq); ldfrag_tr(fkb, Ks, 200, 16 * (dk0 + 1), fr, fq);
#pragma unroll
                for (int i = 0; i < 6; ++i) cacc[i] = cacc[i] * decay;
                if (wave & 1) {
                    cacc[0] = mmaf<2>(fka, fv[2], cacc[0]); cacc[1] = mmaf<2>(fka, fv[3], cacc[1]); cacc[2] = mmaf<2>(fkb, fv[0], cacc[2]); cacc[3] = mmaf<2>(fkb, fv[1], cacc[3]); cacc[4] = mmaf<2>(fkb, fv[2], cacc[4]); cacc[5] = mmaf<2>(fkb, fv[3], cacc[5]);
                } else {
                    cacc[0] = mmaf<2>(fka, fv[0], cacc[0]); cacc[1] = mmaf<2>(fka, fv[1], cacc[1]); cacc[2] = mmaf<2>(fka, fv[2], cacc[2]); cacc[3] = mmaf<2>(fka, fv[3], cacc[3]); cacc[4] = mmaf<2>(fkb, fv[0], cacc[4]); cacc[5] = mmaf<2>(fkb, fv[1], cacc[5]);
                }
#pragma unroll
                for (int i = 0; i < 6; ++i) { const int f = 6 * wave + i, dkf = f >> 2, vf = f & 3;
                    u32x2 w2; w2.x = pk2(cacc[i][0], cacc[i][1]); w2.y = pk2(cacc[i][2], cacc[i][3]);
                    *(LAS u32x2*)(CTn + (16 * vf + fr) * 200 + 16 * dkf + 4 * fq) = w2; }
            }
            __syncthreads();
        }
#undef MLSTM_PREFETCH
    }
}

__device__ __forceinline__ void phase_hgrn(const Args& a, LAS unsigned char* lds, int tid, int lane, int wave) {
    unsigned char* ws = a.ws;
    const bf16* Z = (const bf16*)(ws + WS_Z); bf16* hraw = (bf16*)(ws + WS_HRAW1);
    LAS bf16* Qg0 = (LAS bf16*)lds;
    LAS bf16* Kg0 = (LAS bf16*)(lds + 34816);
    LAS bf16* VT0 = (LAS bf16*)(lds + 69632);
    LAS bf16* ST0 = (LAS bf16*)(lds + 88064);
    LAS float* eg0 = (LAS float*)(lds + 122880);
    const int fr = lane & 15, fq = lane >> 4;
    const int vrow = tid >> 3, vcc = tid & 7;
    for (int item = blockIdx.x; item < BATCH * B_H * 2; item += gridDim.x) {
        const int bh = item >> 1, js = item & 1, b = bh / B_H, h = bh - b * B_H;
        __syncthreads();
        for (int i = tid; i < 2 * 64 * 136 / 2; i += NTHR) ((LAS unsigned*)ST0)[i] = 0u;
        f32x4 sacc[4];
#pragma unroll
        for (int i = 0; i < 4; ++i) sacc[i] = (f32x4){0.f, 0.f, 0.f, 0.f};
        const bf16* qbase = Z + (size_t)b * SEQ * NB + 256 * h;
        const bf16* vbase = Z + ((size_t)b * SEQ + vrow) * NB + ZB_I + h * B_DV + js * 64 + vcc * 8;
        const float* egbase = (const float*)(ws + WS_G5) + (size_t)b * (SEQ / 64) * 1536 + h * B_DK;
        u32x4 pq[2], pk[2], pv; float peg = 0.f;
#define HGRN_PREFETCH(c_) do { const size_t tt = (size_t)64 * (c_); \
            _Pragma("unroll") for (int j = 0; j < 2; ++j) { const int i = tid + NTHR * j, row = i >> 4, cc = i & 15; pq[j] = *(const u32x4*)(qbase + (tt + row) * NB + cc * 8); pk[j] = *(const u32x4*)(qbase + (tt + row) * NB + 128 + cc * 8); } \
            pv = *(const u32x4*)(vbase + tt * NB); if (tid < 128) peg = egbase[(size_t)(c_) * 1536 + tid]; } while (0)
#define HGRN_ELEMENTWISE(bi_) do { LAS bf16* Qg_ = Qg0 + (bi_) * 64 * 136; LAS bf16* Kg_ = Kg0 + (bi_) * 64 * 136; \
            _Pragma("unroll") for (int j = 0; j < 2; ++j) { const int i = tid + NTHR * j, row = i >> 4, cc = i & 15; *(LAS u32x4*)(Qg_ + row * 136 + cc * 8) = pq[j]; *(LAS u32x4*)(Kg_ + row * 136 + cc * 8) = pk[j]; } \
            if (tid < 128) eg0[(bi_) * 128 + tid] = peg; \
            *(LAS u32x4*)(VT0 + (bi_) * 64 * 72 + vrow * 72 + vcc * 8) = pv; } while (0)
        HGRN_PREFETCH(0);
        HGRN_ELEMENTWISE(0);
        HGRN_PREFETCH(1);
        __syncthreads();
        for (int c = 0; c < SEQ / 64; ++c) {
            const size_t t0 = (size_t)b * SEQ + 64 * c; const int cur = c & 1;
            const LAS bf16* Qg = Qg0 + cur * 64 * 136; const LAS bf16* Kg = Kg0 + cur * 64 * 136; const LAS bf16* VT = VT0 + cur * 64 * 72;
            const LAS bf16* STc = ST0 + cur * 64 * 136; LAS bf16* STn = ST0 + (cur ^ 1) * 64 * 136; const LAS float* eg = eg0 + cur * 128;
            if (c + 1 < SEQ / 64) { HGRN_ELEMENTWISE(cur ^ 1); if (c + 2 < SEQ / 64) HGRN_PREFETCH(c + 2); }
            {
                const int li = wave >> 1, l = 16 * li + fr, vf0 = 2 * (wave & 1);
                Frag<4> fqq; ldfrag(fqq, Qg + 16 * li * 136, 136, fr, fq);
                unsigned pb[4][2];
#pragma unroll
                for (int si = 0; si < 4; ++si) { pb[si][0] = 0u; pb[si][1] = 0u;
                    if (si <= li) { Frag<4> fk; ldfrag(fk, Kg + 16 * si * 136, 136, fr, fq); const f32x4 sa = mmaf<4>(fk, fqq, (f32x4){0.f, 0.f, 0.f, 0.f}); float p[4];
#pragma unroll
                        for (int r = 0; r < 4; ++r) { const int sx = 16 * si + 4 * fq + r; p[r] = (sx <= l) ? sa[r] : 0.f; }
                        pb[si][0] = pk2(p[0], p[1]); pb[si][1] = pk2(p[2], p[3]); } }
                Frag<2> fp;
#pragma unroll
                for (int k = 0; k < 2; ++k) { const u32x4 w = (u32x4){pb[2 * k][0], pb[2 * k][1], pb[2 * k + 1][0], pb[2 * k + 1][1]}; fp.v[k] = __builtin_bit_cast(bf16x8, w); }
                Frag<4> sa, sb; Frag<2> va, vb;
                ldfrag(sa, STc + 16 * vf0 * 136, 136, fr, fq); ldfrag(sb, STc + 16 * (vf0 + 1) * 136, 136, fr, fq);
                ldfrag_trp(va, VT, 72, 16 * vf0, fr, fq); ldfrag_trp(vb, VT, 72, 16 * (vf0 + 1), fr, fq);
                f32x4 oa = (f32x4){0.f, 0.f, 0.f, 0.f}, ob = oa;
#pragma unroll
                for (int k = 0; k < 4; ++k) { oa = __builtin_amdgcn_mfma_f32_16x16x32_bf16(sa.v[k], fqq.v[k], oa, 0, 0, 0); ob = __builtin_amdgcn_mfma_f32_16x16x32_bf16(sb.v[k], fqq.v[k], ob, 0, 0, 0); }
#pragma unroll
                for (int k = 0; k < 2; ++k) { oa = __builtin_amdgcn_mfma_f32_16x16x32_bf16(va.v[k], fp.v[k], oa, 0, 0, 0); ob = __builtin_amdgcn_mfma_f32_16x16x32_bf16(vb.v[k], fp.v[k], ob, 0, 0, 0); }
                bf16* orow = hraw + (t0 + l) * MIXW + h * B_DV + js * 64 + 4 * fq;
                u32x2 w2; w2.x = pk2(oa[0], oa[1]); w2.y = pk2(oa[2], oa[3]); *(u32x2*)(orow + 16 * vf0) = w2;
                w2.x = pk2(ob[0], ob[1]); w2.y = pk2(ob[2], ob[3]); *(u32x2*)(orow + 16 * vf0 + 16) = w2;
            }
            {
                Frag<2> fke, fv[4]; ldfrag_tr(fke, Kg, 136, 16 * wave, fr, fq);
#pragma unroll
                for (int vf = 0; vf < 4; ++vf) ldfrag_tr(fv[vf], VT, 72, 16 * vf, fr, fq);
                float egr[4];
#pragma unroll
                for (int r = 0; r < 4; ++r) egr[r] = eg[16 * wave + 4 * fq + r];
#pragma unroll
                for (int i = 0; i < 4; ++i) {
                    sacc[i] = mmaf<2>(fke, fv[i], sacc[i]);
#pragma unroll
                    for (int r = 0; r < 4; ++r) sacc[i][r] *= egr[r];
                    u32x2 w; w.x = pk2(sacc[i][0], sacc[i][1]); w.y = pk2(sacc[i][2], sacc[i][3]);
                    *(LAS u32x2*)(STn + (16 * i + fr) * 136 + 16 * wave + 4 * fq) = w; }
            }
            __syncthreads();
        }
#undef HGRN_PREFETCH
#undef HGRN_ELEMENTWISE
    }
}

template <int LAYER>
__device__ __forceinline__ void phase_attn(const Args& a, LAS unsigned char* lds, int tid, int lane, int wave, int item0, int istride) {
    unsigned char* ws = a.ws;
    constexpr int NZ = LAYER == 0 ? NA : NB, XQ = LAYER == 0 ? ZA_XQ : ZB_XQ;
    const bf16* Z = (const bf16*)(ws + WS_Z); const bf16* KV = (const bf16*)(ws + WS_KV); bf16* ycat = (bf16*)(ws + WS_YCAT);
    LAS bf16* Ks = (LAS bf16*)lds;
    LAS bf16* Vs = (LAS bf16*)(lds + 69632);
    const int fr = lane & 15, fq = lane >> 4;
    for (int item = item0; item < BATCH * XAH * 8; item += istride) {
        const int bh = item >> 3, part = item & 7, b = bh >> 2, h = bh & 3;
        __syncthreads();
        { const bf16* kp = KV + (size_t)b * MEMLEN * 2048 + LAYER * 1024 + h * XAD;
          for (int i = tid; i < 256 * 16; i += NTHR) { const int key = i >> 4, c8 = i & 15;
              *(LAS u32x4*)(Ks + key * 136 + c8 * 8) = *(const u32x4*)(kp + (size_t)key * 2048 + c8 * 8);
              *(LAS u32x4*)(Vs + key * 136 + c8 * 8) = *(const u32x4*)(kp + (size_t)key * 2048 + 512 + c8 * 8); } }
        __syncthreads();
        for (int tile = 0; tile < 4; ++tile) {
            const size_t tq0 = (size_t)b * SEQ + part * 512 + tile * 128 + 16 * wave;
            bf16x8 aq[4];
#pragma unroll
            for (int ks = 0; ks < 4; ++ks) aq[ks] = *(const bf16x8*)(Z + (tq0 + fr) * NZ + XQ + h * XAD + 32 * ks + 8 * fq);
            f32x4 s[16];
#pragma unroll
            for (int nf = 0; nf < 16; ++nf) { f32x4 acc = (f32x4){0.f, 0.f, 0.f, 0.f};
#pragma unroll
                for (int ks = 0; ks < 4; ++ks) { const bf16x8 bk = *(const LAS bf16x8*)(Ks + (16 * nf + fr) * 136 + 32 * ks + 8 * fq); acc = __builtin_amdgcn_mfma_f32_16x16x32_bf16(bk, aq[ks], acc, 0, 0, 0); }
                s[nf] = acc; }
            float mx = s[0][0];
#pragma unroll
            for (int nf = 0; nf < 16; ++nf)
#pragma unroll
                for (int r = 0; r < 4; ++r) mx = fmaxf(mx, s[nf][r]);
            mx = fmaxf(mx, __shfl_xor(mx, 16)); mx = fmaxf(mx, __shfl_xor(mx, 32));
            constexpr float SC = 0.08838834764831845f * 1.4426950408889634f;
            float sm = 0.f;
#pragma unroll
            for (int nf = 0; nf < 16; ++nf)
#pragma unroll
                for (int r = 0; r < 4; ++r) { const float p = __builtin_amdgcn_exp2f((s[nf][r] - mx) * SC); s[nf][r] = p; sm += p; }
            sm += __shfl_xor(sm, 16); sm += __shfl_xor(sm, 32);
            const float inv = __builtin_amdgcn_rcpf(sm);
            f32x4 o[8];
#pragma unroll
            for (int df = 0; df < 8; ++df) o[df] = (f32x4){0.f, 0.f, 0.f, 0.f};
#pragma unroll
            for (int k2 = 0; k2 < 8; ++k2) {
                const u32x4 w = (u32x4){pk2(s[2 * k2][0], s[2 * k2][1]), pk2(s[2 * k2][2], s[2 * k2][3]), pk2(s[2 * k2 + 1][0], s[2 * k2 + 1][1]), pk2(s[2 * k2 + 1][2], s[2 * k2 + 1][3])};
                const bf16x8 fp = __builtin_bit_cast(bf16x8, w);
#pragma unroll
                for (int df = 0; df < 8; ++df) { Frag<1> va; ldfrag_trp(va, Vs + 32 * k2 * 136, 136, 16 * df, fr, fq); o[df] = __builtin_amdgcn_mfma_f32_16x16x32_bf16(va.v[0], fp, o[df], 0, 0, 0); }
                __builtin_amdgcn_sched_barrier(0);
            }
            bf16* orow = ycat + (tq0 + fr) * DM + MIXW + h * XAD + 4 * fq;
#pragma unroll
            for (int df = 0; df < 8; ++df) { u32x2 w2; w2.x = pk2(o[df][0] * inv, o[df][1] * inv); w2.y = pk2(o[df][2] * inv, o[df][3] * inv); *(u32x2*)(orow + 16 * df) = w2; }
        }
    }
}
template <int LAYER>
__device__ __forceinline__ void phase_norm(const Args& a, int lane, int wave) {
    unsigned char* ws = a.ws;
    const bf16* Z = (const bf16*)(ws + WS_Z); bf16* ycat = (bf16*)(ws + WS_YCAT); const bf16* hraw = (const bf16*)(ws + (LAYER == 0 ? WS_HB : WS_HRAW1));
    const int gw = blockIdx.x * NWAVES + wave, NGW = gridDim.x * NWAVES;
    if (LAYER == 0) {
        const float* hg = a.in[IN_AHG];
        for (int t = gw; t < T; t += NGW) {
            const bf16* hp = hraw + (size_t)t * MIXW + 24 * lane; const bf16* op = Z + (size_t)t * NA + ZA_O + 24 * lane;
            float v[24], og[24]; float ss = 0.f;
#pragma unroll
            for (int j = 0; j < 3; ++j) { const u32x4 w = *(const u32x4*)(hp + 8 * j), wo = *(const u32x4*)(op + 8 * j); const unsigned ww[4] = {w.x, w.y, w.z, w.w}, wwo[4] = {wo.x, wo.y, wo.z, wo.w};
#pragma unroll
                for (int e = 0; e < 4; ++e) { v[8 * j + 2 * e] = bf2f((bf16)(ww[e] & 0xffffu)); v[8 * j + 2 * e + 1] = bf2f((bf16)(ww[e] >> 16)); og[8 * j + 2 * e] = bf2f((bf16)(wwo[e] & 0xffffu)); og[8 * j + 2 * e + 1] = bf2f((bf16)(wwo[e] >> 16)); } }
#pragma unroll
            for (int i = 0; i < 24; ++i) ss += v[i] * v[i];
            ss += __shfl_xor(ss, 1); ss += __shfl_xor(ss, 2); ss += __shfl_xor(ss, 4); ss += __shfl_xor(ss, 8);
            const float rstd = 1.0f / sqrtf(ss * (1.0f / A_DV) + EPS);
            bf16* yp = ycat + (size_t)t * DM + 24 * lane;
#pragma unroll
            for (int j = 0; j < 3; ++j) { float y[8];
#pragma unroll
                for (int e = 0; e < 8; ++e) { const int i = 8 * j + e; y[e] = sigmoidf_(og[i]) * v[i] * rstd * hg[24 * lane + i]; }
                u32x4 w; w.x = pk2(y[0], y[1]); w.y = pk2(y[2], y[3]); w.z = pk2(y[4], y[5]); w.w = pk2(y[6], y[7]); *(u32x4*)(yp + 8 * j) = w; }
        }
    } else {
        const float* hg = a.in[IN_BHG];
        for (int t = gw; t < T; t += NGW) {
#pragma unroll
            for (int j = 0; j < 3; ++j) { const int c0 = 8 * lane + 512 * j;
                const u32x4 w = *(const u32x4*)(hraw + (size_t)t * MIXW + c0), wo = *(const u32x4*)(Z + (size_t)t * NB + ZB_G + c0); const unsigned ww[4] = {w.x, w.y, w.z, w.w}, wwo[4] = {wo.x, wo.y, wo.z, wo.w};
                float v[8], og[8]; float ss = 0.f;
#pragma unroll
                for (int e = 0; e < 4; ++e) { v[2 * e] = bf2f((bf16)(ww[e] & 0xffffu)); v[2 * e + 1] = bf2f((bf16)(ww[e] >> 16)); og[2 * e] = bf2f((bf16)(wwo[e] & 0xffffu)); og[2 * e + 1] = bf2f((bf16)(wwo[e] >> 16)); }
#pragma unroll
                for (int e = 0; e < 8; ++e) ss += v[e] * v[e];
                ss += __shfl_xor(ss, 1); ss += __shfl_xor(ss, 2); ss += __shfl_xor(ss, 4); ss += __shfl_xor(ss, 8);
                const float rstd = 1.0f / sqrtf(ss * (1.0f / B_DV) + EPS);
                float y[8];
#pragma unroll
                for (int e = 0; e < 8; ++e) y[e] = v[e] * rstd * hg[c0 + e] * siluf_(og[e]);
                u32x4 wy; wy.x = pk2(y[0], y[1]); wy.y = pk2(y[2], y[3]); wy.z = pk2(y[4], y[5]); wy.w = pk2(y[6], y[7]); *(u32x4*)(ycat + (size_t)t * DM + c0) = wy; }
        }
    }
}

__device__ __forceinline__ void phase_ffn_fixup(const Args& a, int layer, int tid) {
    unsigned char* ws = a.ws; const bf16* side = (const bf16*)(ws + WS_SIDE); bf16* act = (bf16*)(ws + WS_Z);
    const float* cw = a.in[IN_FCW] + (size_t)layer * 3 * DFF; const float* cb = a.in[IN_FCB] + (size_t)layer * DFF;
    const int total = 512 * 2 * DFF;
    for (int i = blockIdx.x * NTHR + tid; i < total; i += gridDim.x * NTHR) {
        const int f = i % DFF, gr = i / DFF, grp = gr >> 1, r = gr & 1; const int t = grp * 64 + r; const bool start = (grp & 63) == 0;
        const bf16* sg = side + (size_t)grp * 6 * DFF; const bf16* sp = sg - (size_t)6 * DFF;
        const float g0 = bf2f(sg[(size_t)r * DFF + f]), u0 = bf2f(sg[(size_t)(2 + r) * DFF + f]);
        float g1, g2;
        if (r == 0) { g1 = start ? 0.f : bf2f(sp[(size_t)5 * DFF + f]); g2 = start ? 0.f : bf2f(sp[(size_t)4 * DFF + f]); }
        else { g1 = bf2f(sg[f]); g2 = start ? 0.f : bf2f(sp[(size_t)5 * DFF + f]); }
        const float c = cb[f] + cw[f] * g2 + cw[DFF + f] * g1 + cw[2 * DFF + f] * g0;
        act[(size_t)t * DFF + f] = f2bf(siluf_(c) * u0);
    }
}
__device__ __forceinline__ void phase_final_norm(const Args& a, int lane, int wave) {
    const float* ssq = (const float*)(a.ws + WS_SSQ); const float* g = a.in[IN_NOUT]; float* out = a.out; const bf16* hb = (const bf16*)(a.ws + WS_HB);
    const int gw = blockIdx.x * NWAVES + wave, NGW = gridDim.x * NWAVES;
    for (int row = gw; row < T; row += NGW) {
        float s = lane < 32 ? ssq[(size_t)row * 32 + lane] : 0.f; s = wave_sum(s);
        const float rstd = 1.0f / sqrtf(s * (1.0f / DM) + EPS);
        const u32x4* hr = (const u32x4*)(hb + (size_t)row * DM) + lane; f32x4* xr = (f32x4*)(out + (size_t)row * DM);
#pragma unroll
        for (int j = 0; j < 4; ++j) { const u32x4 w = hr[64 * j]; const int c8 = 8 * (lane + 64 * j); const f32x4 g0 = *(const f32x4*)(g + c8), g1 = *(const f32x4*)(g + c8 + 4);
            f32x4 v0 = (f32x4){__builtin_bit_cast(float, w.x << 16), __builtin_bit_cast(float, w.x & 0xffff0000u), __builtin_bit_cast(float, w.y << 16), __builtin_bit_cast(float, w.y & 0xffff0000u)};
            f32x4 v1 = (f32x4){__builtin_bit_cast(float, w.z << 16), __builtin_bit_cast(float, w.z & 0xffff0000u), __builtin_bit_cast(float, w.w << 16), __builtin_bit_cast(float, w.w & 0xffff0000u)};
            xr[c8 / 4] = v0 * rstd * g0; xr[c8 / 4 + 1] = v1 * rstd * g1; }
    }
}

#define XB_TMO      128
#define XB_XCNT(j)  (256  + 64 * (j))
#define XB_XSUB(j)  (1280 + 64 * (j))
#define XB_XGEN(j)  (2304 + 64 * (j))
#define XB_TOP      3328
#define XB_TOPGEN   3392
#define XCD_BAR_WORDS 3456
#define XB_SPIN_CAP (1u << 18)

__device__ __forceinline__ unsigned xb_ld(unsigned* p)              { return __hip_atomic_load(p, __ATOMIC_RELAXED, __HIP_MEMORY_SCOPE_AGENT); }
__device__ __forceinline__ unsigned xb_add(unsigned* p, unsigned v) { return __hip_atomic_fetch_add(p, v, __ATOMIC_RELAXED, __HIP_MEMORY_SCOPE_AGENT); }
__device__ __forceinline__ unsigned xb_xcc_id() { return (unsigned)__builtin_amdgcn_s_getreg((3 << 11) | 20) & 0xFu; }
#define XB_SPIN(cond, bar) do { unsigned _sp = 0; while (cond) { __builtin_amdgcn_s_sleep(1); \
    if ((++_sp & 255u) == 0u) { if (xb_ld(&(bar)[XB_TMO])) break; if (_sp > XB_SPIN_CAP) { atomicAdd(&(bar)[XB_TMO], 1u); break; } } } } while (0)

struct XcdBarrier {
    unsigned* bar; unsigned x;
    volatile LAS unsigned* st;
};

__device__ __forceinline__ XcdBarrier xcd_barrier_post(unsigned* bar, volatile LAS unsigned* st) {
    XcdBarrier b; b.bar = bar; b.x = xb_xcc_id(); b.st = st;
    if (threadIdx.x == 0) (void)xb_add(&bar[XB_XCNT(b.x)], 1u);
    return b;
}
__device__ __forceinline__ void xcd_barrier_complete(unsigned* bar, unsigned x, unsigned& nloc, unsigned& nx) {
    const unsigned G = gridDim.x * gridDim.y * gridDim.z;
    unsigned sum, cnt, mine, sp = 0u;
    for (;;) {
        sum = 0u; cnt = 0u; mine = 0u;
#pragma unroll
        for (unsigned j = 0; j < 16; ++j) { const unsigned c = xb_ld(&bar[XB_XCNT(j)]); sum += c; cnt += (c > 0u) ? 1u : 0u; mine = (j == x) ? c : mine; }
        if (sum == G) break;
        __builtin_amdgcn_s_sleep(1);
        if ((++sp & 255u) == 0u) { if (xb_ld(&bar[XB_TMO])) break; if (sp > XB_SPIN_CAP) { atomicAdd(&bar[XB_TMO], 1u); break; } }
    }
    nloc = mine > 0u ? mine : 1u; nx = cnt > 0u ? cnt : 1u;
}

__device__ __forceinline__ void xcd_barrier(const XcdBarrier& b) {
    asm volatile("s_waitcnt vmcnt(0)" ::: "memory");
    __syncthreads();
    if (threadIdx.x == 0) {
        unsigned* bar = b.bar;
        __builtin_amdgcn_s_waitcnt(0);
        unsigned nloc = b.st[0], nx = b.st[1];
        if (nloc == 0u) { xcd_barrier_complete(bar, b.x, nloc, nx); b.st[0] = nloc; b.st[1] = nx; }
        const unsigned old = xb_add(&bar[XB_XSUB(b.x)], 1u);
        const unsigned gen = old / nloc;
        if (old + 1u == (gen + 1u) * nloc) {
            __builtin_amdgcn_fence(__ATOMIC_RELEASE, "agent");
            asm volatile("s_waitcnt vmcnt(0)" ::: "memory");
            const unsigned og = xb_add(&bar[XB_TOP], 1u);
            const unsigned tg = og / nx;
            if (og + 1u == (tg + 1u) * nx) xb_add(&bar[XB_TOPGEN], 1u);
            else XB_SPIN(xb_ld(&bar[XB_TOPGEN]) == tg, bar);
            __builtin_amdgcn_fence(__ATOMIC_ACQUIRE, "agent");
            xb_add(&bar[XB_XGEN(b.x)], 1u);
            asm volatile("s_waitcnt vmcnt(0)" ::: "memory");
        } else {
            XB_SPIN(xb_ld(&bar[XB_XGEN(b.x)]) == gen, bar);
            __builtin_amdgcn_fence(__ATOMIC_ACQUIRE, "agent");
            asm volatile("s_waitcnt vmcnt(0)" ::: "memory");
        }
    }
    __syncthreads();
}

constexpr int NPHASES = 19;
typedef const Args __attribute__((address_space(4))) CArgs;
__device__ __forceinline__ void load_args(Args& a, CArgs* p) {
#pragma unroll
    for (int i = 0; i < 21; ++i) a.in[i] = p->in[i];
    a.out = p->out; a.ws = p->ws; a.ph_lo = p->ph_lo; a.ph_hi = p->ph_hi; }
__device__ __forceinline__ bool in_range(int k) { CArgs* p = (CArgs*)__builtin_amdgcn_kernarg_segment_ptr(); asm volatile("" : "+s"(p)); return p->ph_lo <= k && k < p->ph_hi; }
#define PHASE_BEGIN() CArgs* ap_ = (CArgs*)__builtin_amdgcn_kernarg_segment_ptr(); asm volatile("" : "+s"(ap_)); Args a; load_args(a, ap_); \
    int tid = threadIdx.x; asm volatile("" : "+v"(tid)); const int lane = tid & 63, wave = __builtin_amdgcn_readfirstlane(tid >> 6); unsigned char* ws = a.ws; const int G = gridDim.x; (void)lane; (void)wave; (void)ws; (void)G;
#ifdef ONLY_PH
#define IN(k) (((k) == ONLY_PH || ((k) >= 2 && (k) - 8 == ONLY_PH)) && in_range(k))
#else
#define IN(k) in_range(k)
#endif
#ifndef REPEAT_PH
#define REPEAT_PH -1
#endif
#define REP(k) for (int rep_ = 0; rep_ < 1 + (REPEAT_PH == (k) ? 1 : 0); ++rep_)
#define SEAM(k) do { if (IN(k) && IN((k) + 1)) { if (hi > 1000) cg::this_grid().sync(); CArgs* apb_ = (CArgs*)__builtin_amdgcn_kernarg_segment_ptr(); asm volatile("" : "+s"(apb_)); \
        XcdBarrier b_; b_.bar = (unsigned*)(apb_->ws + WS_CTL) + CW_BAR; b_.x = xb_xcc_id(); b_.st = (volatile LAS unsigned*)(lds + MISC_OFF); xcd_barrier(b_); } } while (0)
template <int layer> __device__ __forceinline__ void layer_phases(LAS unsigned char* lds, const int hi) {
        const int pb = 2 + 8 * layer;
        if (IN(pb)) REP(pb) { __syncthreads();
            PHASE_BEGIN();
            const int N = layer ? NB : NA;
            pg8::Gemm g{(const bf16*)(ws + WS_HB), (const bf16*)(ws + (layer ? WS_WIN1 : WS_WIN0)), T, N, DM}; pg8::StaticOrder S; S.init(T, N, G, (int)blockIdx.x);
            if constexpr (layer == 0) { pg8::EpiScaleBf16 E{(bf16*)(ws + WS_Z), N, (const float*)(ws + WS_SSQ)};
                pg8::gemm_phase<pg8::EpiScaleBf16, pg8::StaticOrder, PG8_ALIGN, PG8_SP2>(lds, g, S, E); }
            else { pg8::EpiZ1 E{(bf16*)(ws + WS_Z), N, (const float*)(ws + WS_SSQ), a.in[IN_BLB], (float*)(ws + WS_G5)};
                pg8::gemm_phase<pg8::EpiZ1, pg8::StaticOrder, PG8_ALIGN, PG8_SP2>(lds, g, S, E); }
        }
        SEAM(pb);
        if (layer == 0) {
            if (IN(pb + 1)) REP(pb + 1) { __syncthreads(); PHASE_BEGIN();
                const int nkv = (TM / 256) * (2048 / 256), ngs = BATCH * A_H;
                if (G >= 2 * nkv + 2 * ngs) {
                    const int bid = (int)blockIdx.x;
                    if (bid >= G - ngs) { if (wave == 0) mlstm_gate_scan(a, G - 1 - bid, lane); }
                    else if (bid >= nkv) phase_mlstm_conv(a, tid, bid - nkv, G - nkv - ngs);
                } else {
                    if (wave == 0) for (int bh = G - 1 - (int)blockIdx.x; bh < ngs; bh += G) mlstm_gate_scan(a, bh, lane);
                    phase_mlstm_conv(a, tid, (int)blockIdx.x, G);
                }
                __syncthreads();
                pg8::Gemm g{(const bf16*)(ws + WS_MEMB), (const bf16*)(ws + WS_WKV), TM, 2048, DM}; pg8::StaticOrder S; S.init(TM, 2048, G, (int)blockIdx.x);
                pg8::EpiScaleBf16 E{(bf16*)(ws + WS_KV), 2048, (const float*)(ws + WS_SSQM)};
                pg8::gemm_phase<pg8::EpiScaleBf16, pg8::StaticOrder, PG8_ALIGN, PG8_SP2>(lds, g, S, E);
            }
            SEAM(pb + 1);
        }
        if (IN(pb + 2)) REP(pb + 2) { __syncthreads(); PHASE_BEGIN();
            if (layer == 0) phase_mlstm(a, lds, tid, lane, wave);
            else {
                phase_hgrn(a, lds, tid, lane, wave);
                const int nscan = BATCH * B_H * 2;
                if (G > nscan) { if ((int)blockIdx.x >= nscan) phase_attn<1>(a, lds, tid, lane, wave, (int)blockIdx.x - nscan, G - nscan); }
                else phase_attn<1>(a, lds, tid, lane, wave, (int)blockIdx.x, G);
            } }
        SEAM(pb + 2);
        if (IN(pb + 3)) REP(pb + 3) { __syncthreads(); PHASE_BEGIN(); if (layer == 0) { phase_attn<0>(a, lds, tid, lane, wave, (int)blockIdx.x, G); phase_norm<0>(a, lane, wave); } else phase_norm<1>(a, lane, wave); }
        SEAM(pb + 3);
        if (IN(pb + 4)) REP(pb + 4) { __syncthreads();
            PHASE_BEGIN();
            pg8::Gemm g{(const bf16*)(ws + WS_YCAT), (const bf16*)(ws + (layer ? WS_WOUT1 : WS_WOUT0)), T, DM, DM}; pg8::StaticOrder S; S.init(T, DM, G, (int)blockIdx.x);
            if constexpr (layer == 0) { typedef pg8::EpiRes<false, false, true> EpiR; EpiR E{a.in[IN_X], nullptr, nullptr, (bf16*)(ws + WS_HB), (float*)(ws + WS_SSQ)};
                pg8::gemm_phase<EpiR, pg8::StaticOrder, PG8_ALIGN, PG8_SP2>(lds, g, S, E); }
            else { typedef pg8::EpiRes<true, false, true> EpiR; EpiR E{nullptr, (const bf16*)(ws + WS_HB), nullptr, (bf16*)(ws + WS_HB), (float*)(ws + WS_SSQ)};
                pg8::gemm_phase<EpiR, pg8::StaticOrder, PG8_ALIGN, PG8_SP2>(lds, g, S, E); }
        }
        SEAM(pb + 4);
        if (IN(pb + 5)) REP(pb + 5) { __syncthreads();
            PHASE_BEGIN();
            pg8::Gemm g{(const bf16*)(ws + WS_HB), (const bf16*)(ws + (layer ? WS_WUP1 : WS_WUP0)), T, 2 * DFF, DM}; pg8::StaticOrder S; S.init(T, 2 * DFF, G, (int)blockIdx.x);
            pg8::EpiUp E{(bf16*)(ws + WS_Z), (bf16*)(ws + WS_SIDE), (const float*)(ws + WS_SSQ), a.in[IN_FCW] + (size_t)layer * 3 * DFF, a.in[IN_FCB] + (size_t)layer * DFF};
            pg8::gemm_phase<pg8::EpiUp, pg8::StaticOrder, PG8_ALIGN, PG8_SP2>(lds, g, S, E);
        }
        SEAM(pb + 5);
        if (IN(pb + 6)) REP(pb + 6) { __syncthreads(); PHASE_BEGIN(); phase_ffn_fixup(a, layer, tid); }
        SEAM(pb + 6);
        if (IN(pb + 7)) REP(pb + 7) { __syncthreads();
            PHASE_BEGIN();
            pg8::Gemm g{(const bf16*)(ws + WS_Z), (const bf16*)(ws + (layer ? WS_WDN1 : WS_WDN0)), T, DM, DFF}; pg8::StaticOrder S; S.init(T, DM, G, (int)blockIdx.x);
            if constexpr (layer == 0) { typedef pg8::EpiRes<true, false, true> EpiR; EpiR E{nullptr, (const bf16*)(ws + WS_HB), nullptr, (bf16*)(ws + WS_HB), (float*)(ws + WS_SSQ)};
                pg8::gemm_phase<EpiR, pg8::StaticOrder, PG8_ALIGN, PG8_SP2>(lds, g, S, E); }
            else { typedef pg8::EpiRes<true, false, true> EpiR; EpiR E{nullptr, (const bf16*)(ws + WS_HB), nullptr, (bf16*)(ws + WS_HB), (float*)(ws + WS_SSQ)};
                pg8::gemm_phase<EpiR, pg8::StaticOrder, PG8_ALIGN, PG8_SP2>(lds, g, S, E); }
        }
        SEAM(pb + 7);
    }
__global__ void __launch_bounds__(NTHR, 2) mk_fwd(Args a_unused) {
    extern __shared__ __attribute__((aligned(16))) unsigned char lds_raw[];
    LAS unsigned char* lds = (LAS unsigned char*)lds_raw;
    int lo, hi; unsigned* barw; { CArgs* ap0 = (CArgs*)__builtin_amdgcn_kernarg_segment_ptr(); lo = ap0->ph_lo; hi = ap0->ph_hi; barw = (unsigned*)(ap0->ws + WS_CTL) + CW_BAR; }
    volatile LAS unsigned* misc = (volatile LAS unsigned*)(lds + MISC_OFF);
    if (threadIdx.x < 16) misc[threadIdx.x] = 0u;
    __syncthreads();
    if (hi - lo > 1) (void)xcd_barrier_post(barw, misc);
    if (IN(0)) REP(0) { __syncthreads(); PHASE_BEGIN(); phase_prologue(a, lds, tid, lane, wave); }
    SEAM(0);
    layer_phases<0>(lds, hi);
    layer_phases<1>(lds, hi);
    if (IN(18)) REP(18) { __syncthreads(); PHASE_BEGIN(); phase_final_norm(a, lane, wave); }
#undef IN
#undef SEAM
}

#ifndef MK_N_LAUNCHES
#define MK_N_LAUNCHES 1
#endif
extern "C" void kernel_launch(void* const* d_in, const int* in_sizes, int n_in, void* d_out, int out_size, void* d_ws, size_t ws_size, hipStream_t stream) {
    static int grid = 0;
    if (grid == 0) {
        if (n_in != 21 || in_sizes[0] != T * DM || out_size != T * DM || ws_size < WS_END) { fprintf(stderr, "kernel_launch: unexpected sizes n_in %d in0 %d out %d ws %zu (need %zu)\n", n_in, n_in > 0 ? in_sizes[0] : -1, out_size, ws_size, (size_t)WS_END); grid = -1; return; }
        int dev = 0, cus = 0, per_cu = 0;
        if (hipGetDevice(&dev) != hipSuccess || hipDeviceGetAttribute(&cus, hipDeviceAttributeMultiprocessorCount, dev) != hipSuccess) { grid = -1; return; }
        if (hipFuncSetAttribute((const void*)mk_fwd, hipFuncAttributeMaxDynamicSharedMemorySize, LDS_BYTES) != hipSuccess) { fprintf(stderr, "kernel_launch: hipFuncSetAttribute failed\n"); grid = -1; return; }
        if (hipOccupancyMaxActiveBlocksPerMultiprocessor(&per_cu, (const void*)mk_fwd, NTHR, LDS_BYTES) != hipSuccess || per_cu < 1) { fprintf(stderr, "kernel_launch: occupancy query says %d blocks per CU\n", per_cu); (void)hipGetLastError(); grid = -1; return; }
        grid = cus;
    }
    if (grid < 0) return;
    Args a{};
    for (int i = 0; i < 21; ++i) a.in[i] = (const float*)d_in[i];
    a.out = (float*)d_out; a.ws = (unsigned char*)d_ws;
#if MK_N_LAUNCHES == 1
    if (hipMemsetAsync((char*)d_ws + WS_CTL, 0, CTL_ZERO_BYTES, stream) != hipSuccess) { fprintf(stderr, "kernel_launch: memset failed\n"); return; }
    a.ph_lo = 0; a.ph_hi = NPHASES;
    void* args[] = {&a};
    hipError_t e = hipLaunchCooperativeKernel((const void*)mk_fwd, dim3(grid), dim3(NTHR), args, LDS_BYTES, stream);
    if (e != hipSuccess) fprintf(stderr, "kernel_launch: cooperative launch failed: %s (grid %d)\n", hipGetErrorString(e), grid);
#else
    for (int p = 0; p < NPHASES; ++p) { a.ph_lo = p; a.ph_hi = p + 1; hipLaunchKernelGGL(mk_fwd, dim3(grid), dim3(NTHR), LDS_BYTES, stream, a); }
#endif
}
```

```cpp
#include <hip/hip_runtime.h>
#include <hip/hip_cooperative_groups.h>
#include <cstdio>
#include <cstdint>
namespace cg = cooperative_groups;
namespace pg8 {
#define PG8_LAS __attribute__((address_space(3)))
typedef unsigned short bf16_t;
typedef short bf16x8 __attribute__((ext_vector_type(8)));
typedef float f32x4 __attribute__((ext_vector_type(4)));
typedef unsigned u32x4 __attribute__((ext_vector_type(4)));
constexpr int BM = 256, BK = 64, HALF = 128, HTB = HALF * BK * 2  , STAGE_BYTES = 8 * HTB, NXCD = 8, WGM = 8;

__host__ __device__ __forceinline__ int lds_byte(int r, int c) { const int st = (r >> 4) * 2 + (c >> 5), rr = r & 15, cc = c & 31, ob = rr * 64 + cc * 2; return st * 1024 + (ob ^ (((ob >> 9) & 1) << 5)); }
__host__ __device__ __forceinline__ void stage_rc(int b, int& R, int& C) { const int st = b / 1024, sb = b % 1024, swz = sb ^ (((sb >> 9) & 1) << 5); R = (st >> 1) * 16 + swz / 64; C = (st & 1) * 32 + (swz % 64) / 2; }
__host__ __device__ __forceinline__ int perm32(int rho) { const int n = rho >> 4, i = rho & 15; return 8 * (i >> 2) + 4 * n + (i & 3); }

struct Unit { int pm, pn; };
struct Gemm { const bf16_t* A; const bf16_t* Bt; int M, N, K; };

struct StaticOrder {
    int nM, nN, nwg, G, c;
    __host__ __device__ void init(int M, int N, int G_, int c_) { nM = M / BM; nN = N / BM; nwg = nM * nN; G = G_; c = c_; }
    __host__ __device__ bool next(int i, Unit& u) const {
        const long L = (long)i * G + c; if (L >= nwg) return false;
        int wgid = (int)L; { const int q = nwg / NXCD, r = nwg % NXCD, xcd = wgid % NXCD, off = wgid / NXCD; wgid = (xcd < r ? xcd * (q + 1) : r * (q + 1) + (xcd - r) * q) + off; }
        const int nig = WGM * nN, gid = wgid / nig, fm = gid * WGM, gsz = (nM - fm) < WGM ? (nM - fm) : WGM;
        u.pm = fm + ((wgid % nig) % gsz); u.pn = (wgid % nig) / gsz; return true;
    }
    __device__ __forceinline__ void a_ready(const Unit&) const {}
    __device__ __forceinline__ void done(const Unit&) const {}
};

struct KvOrder { int c;
    __host__ __device__ bool next(int i, Unit& u) const { if (i > 0 || c >= 64) return false; u.pm = c & 7; u.pn = c >> 3; return true; }
    __device__ __forceinline__ void a_ready(const Unit&) const {}
    __device__ __forceinline__ void done(const Unit&) const {}
};

__device__ __forceinline__ unsigned cvt_pk_bf16(float lo, float hi) { unsigned r; asm volatile("v_cvt_pk_bf16_f32 %0, %1, %2" : "=v"(r) : "v"(lo), "v"(hi)); return r; }
typedef unsigned u32x2 __attribute__((ext_vector_type(2)));
__device__ __forceinline__ void swap16(float& a, float& b) { asm volatile("s_nop 1\n\tv_permlane16_swap_b32 %0, %1" : "+v"(a), "+v"(b)); }
__device__ __forceinline__ void swap32(float& a, float& b) { asm volatile("s_nop 1\n\tv_permlane32_swap_b32 %0, %1" : "+v"(a), "+v"(b)); }
__device__ __forceinline__ float sum_fq(float v) { float a = v, b = v; swap16(a, b); v = a + b; a = v; b = v; swap32(a, b); return a + b; }
__device__ __forceinline__ float max_fq(float v) { float a = v, b = v; swap16(a, b); v = fmaxf(a, b); a = v; b = v; swap32(a, b); return fmaxf(a, b); }
__device__ __forceinline__ float bcast_row0(float v) { float a = v, b = v; swap16(a, b); b = a; swap32(a, b); return a; }

__device__ __forceinline__ float row_rstd(const float* ssq, int row, int fq) {
    const f32x4* p = (const f32x4*)(ssq + (size_t)row * 32 + fq * 8);
    const f32x4 a = p[0], b = p[1];
    float s = ((a[0] + a[1]) + (a[2] + a[3])) + ((b[0] + b[1]) + (b[2] + b[3]));
    s += __shfl_xor(s, 16); s += __shfl_xor(s, 32);
    return 1.0f / sqrtf(s * (1.0f / 2048.0f) + 1e-6f);
}

struct RstdTab { const PG8_LAS float* tab; int pm_base;
    __device__ __forceinline__ float get(const Unit& u, int r) const { return tab[(((u.pm - pm_base) >> 3) << 8) + r]; } };
template <class Sched> __device__ __forceinline__ RstdTab rstd_table_build(PG8_LAS unsigned char* lds, const float* ssq, const Sched& S, int nM) {
    RstdTab rt; rt.tab = (const PG8_LAS float*)(lds + STAGE_BYTES); rt.pm_base = 0;
    Unit u0;
    if (S.next(0, u0)) { rt.pm_base = u0.pm; const int tid = threadIdx.x, pm = u0.pm + 8 * (tid >> 8), r = tid & 255;
        if (pm < nM) { const f32x4* p = (const f32x4*)(ssq + ((size_t)pm * BM + r) * 32); float s = 0.f;
#pragma unroll
            for (int j = 0; j < 8; ++j) { const f32x4 v = p[j]; s += (v[0] + v[1]) + (v[2] + v[3]); }
            ((PG8_LAS float*)(lds + STAGE_BYTES))[tid] = 1.0f / sqrtf(s * (1.0f / 2048.0f) + 1e-6f); } }
    __syncthreads();
    return rt;
}
constexpr int TAP_SLOTS = 11, TAP_OFF = 2048, TAP_IDX_OFF = TAP_OFF + TAP_SLOTS * 2048;
struct TapTab { const PG8_LAS float* taps; const PG8_LAS int* idx; };
template <class Sched> __device__ __forceinline__ TapTab tap_table_build(PG8_LAS unsigned char* lds, const float* cw, const float* cb, const Sched& S) {
    PG8_LAS float* taps = (PG8_LAS float*)(lds + STAGE_BYTES + TAP_OFF); PG8_LAS int* idx = (PG8_LAS int*)(lds + STAGE_BYTES + TAP_IDX_OFF);
    const int tid = threadIdx.x;
    if (S.G == 256 && S.nN == 44) {
        if (tid < 64) idx[tid] = tid >> 2;
        if (tid < TAP_SLOTS) idx[64 + tid] = 4 * tid + (S.c >> 6);
        if (tid == 0) idx[64 + TAP_SLOTS] = TAP_SLOTS;
    } else {
        if (tid < 64) idx[tid] = -1;
        __syncthreads();
        if (tid == 0) { int ns = 0; Unit u;
            for (int i = 0; S.next(i, u); ++i) if (idx[u.pn] < 0 && ns < TAP_SLOTS) { idx[u.pn] = ns; idx[64 + ns] = u.pn; ++ns; }
            idx[64 + TAP_SLOTS] = ns; }
    }
    __syncthreads();
    const int ns = idx[64 + TAP_SLOTS], arr = tid >> 7, f = tid & 127;
    for (int sl = 0; sl < ns; ++sl) { const int pn = idx[64 + sl]; taps[sl * 512 + tid] = 1.4426950408889634f * (arr < 3 ? cw[arr * 5632 + pn * 128 + f] : cb[pn * 128 + f]); }
    __syncthreads();
    TapTab t; t.taps = taps; t.idx = idx; return t;
}
__device__ __forceinline__ const PG8_LAS float* lb_table_build(PG8_LAS unsigned char* lds, const float* lbl) {
    PG8_LAS float* tab = (PG8_LAS float*)(lds + STAGE_BYTES + TAP_OFF);
    for (int c = threadIdx.x; c < 1536; c += 512) tab[c] = __builtin_amdgcn_rcpf(1.0f + __expf(lbl[c] - lbl[1536 + c]));
    __syncthreads();
    return tab;
}
struct EpiScaleBf16 {
    static constexpr bool PERM = true, AFTER_DRAIN = false;
    bf16_t* O; int ldc; RstdTab rt;
    __device__ __forceinline__ void operator()(f32x4 (&acc)[2][2][4][2], const Unit& u, int wr, int wc, int fr, int fq) const {
        asm volatile("" : "+v"(fr), "+v"(fq));
        const int row0 = u.pm * BM + wr * 64 + fr, col0 = u.pn * BM + wc * 32 + 8 * fq;
        float rs[2][4];
#pragma unroll
        for (int ai = 0; ai < 2; ++ai)
#pragma unroll
            for (int m = 0; m < 4; ++m) rs[ai][m] = rt.get(u, ai * HALF + wr * 64 + m * 16 + fr);
#pragma unroll
        for (int ai = 0; ai < 2; ++ai)
#pragma unroll
            for (int m = 0; m < 4; ++m) { const int row = row0 + ai * HALF + m * 16; const float r1 = rs[ai][m];
                bf16_t* rowp = O + (size_t)row * ldc + col0;
#pragma unroll
                for (int bj = 0; bj < 2; ++bj) { const f32x4 v0 = acc[ai][bj][m][0] * r1, v1 = acc[ai][bj][m][1] * r1;
                    u32x4 w; w.x = cvt_pk_bf16(v0[0], v0[1]); w.y = cvt_pk_bf16(v0[2], v0[3]); w.z = cvt_pk_bf16(v1[0], v1[1]); w.w = cvt_pk_bf16(v1[2], v1[3]);
                    *(u32x4*)(rowp + bj * HALF) = w; } }
    }
};

template <int N> __device__ __forceinline__ float dpp_shr(float v, float fill) { return __builtin_bit_cast(float, __builtin_amdgcn_update_dpp(__builtin_bit_cast(int, fill), __builtin_bit_cast(int, v), 0x110 + N, 0xf, 0xf, false)); }
__device__ __forceinline__ void scan4_mul_tot(float& a, float& b, float& c, float& d, float& ta, float& tb, float& tc, float& td) {
#define PG8_SC(N) "v_mul_f32_dpp %0, %0, %0 row_shr:" #N " row_mask:0xf bank_mask:0xf\n\tv_mul_f32_dpp %1, %1, %1 row_shr:" #N " row_mask:0xf bank_mask:0xf\n\tv_mul_f32_dpp %2, %2, %2 row_shr:" #N " row_mask:0xf bank_mask:0xf\n\tv_mul_f32_dpp %3, %3, %3 row_shr:" #N " row_mask:0xf bank_mask:0xf\n\t"
#define PG8_RT(N) "v_mul_f32_dpp %4, %4, %4 row_ror:" #N " row_mask:0xf bank_mask:0xf\n\tv_mul_f32_dpp %5, %5, %5 row_ror:" #N " row_mask:0xf bank_mask:0xf\n\tv_mul_f32_dpp %6, %6, %6 row_ror:" #N " row_mask:0xf bank_mask:0xf\n\tv_mul_f32_dpp %7, %7, %7 row_ror:" #N " row_mask:0xf bank_mask:0xf\n\t"
    asm volatile("s_nop 1\n\t"
        "v_mul_f32_dpp %4, %0, %0 row_ror:8 row_mask:0xf bank_mask:0xf\n\tv_mul_f32_dpp %5, %1, %1 row_ror:8 row_mask:0xf bank_mask:0xf\n\tv_mul_f32_dpp %6, %2, %2 row_ror:8 row_mask:0xf bank_mask:0xf\n\tv_mul_f32_dpp %7, %3, %3 row_ror:8 row_mask:0xf bank_mask:0xf\n\t"
        PG8_SC(1) PG8_RT(4) PG8_SC(2) PG8_RT(2) PG8_SC(4) PG8_RT(1) PG8_SC(8)
        : "+v"(a), "+v"(b), "+v"(c), "+v"(d), "=&v"(ta), "=&v"(tb), "=&v"(tc), "=&v"(td));
#undef PG8_SC
#undef PG8_RT
}
__device__ __forceinline__ void scan4_mul(float& a, float& b, float& c, float& d) {
#define PG8_SC(N) "v_mul_f32_dpp %0, %0, %0 row_shr:" #N " row_mask:0xf bank_mask:0xf\n\tv_mul_f32_dpp %1, %1, %1 row_shr:" #N " row_mask:0xf bank_mask:0xf\n\tv_mul_f32_dpp %2, %2, %2 row_shr:" #N " row_mask:0xf bank_mask:0xf\n\tv_mul_f32_dpp %3, %3, %3 row_shr:" #N " row_mask:0xf bank_mask:0xf\n\t"
    asm volatile("s_nop 1\n\t" PG8_SC(1) PG8_SC(2) PG8_SC(4) PG8_SC(8) : "+v"(a), "+v"(b), "+v"(c), "+v"(d));
#undef PG8_SC
}
struct EpiZ1 {
    static constexpr bool PERM = true, AFTER_DRAIN = false;
    bf16_t* O; int ldc; RstdTab rt; const PG8_LAS float* lbt; float* eg;
    __device__ __forceinline__ void operator()(f32x4 (&acc)[2][2][4][2], const Unit& u, int wr, int wc, int fr, int fq) const {
        asm volatile("" : "+v"(fr), "+v"(fq));
        const int row0 = u.pm * BM + wr * 64 + fr, col0 = u.pn * BM + wc * 32 + 8 * fq;
        if (u.pn < 12) {
            const int ch0 = u.pn * 128 + wc * 32 + 8 * fq;
            const int lane15 = (fq * 16) | 15;
            float lb[8];
            { const f32x4 l0 = *(const PG8_LAS f32x4*)(lbt + ch0), l1 = *(const PG8_LAS f32x4*)(lbt + ch0 + 4);
#pragma unroll
              for (int e = 0; e < 4; ++e) { lb[e] = l0[e]; lb[4 + e] = l1[e]; } }
            float rsa[2][4];
#pragma unroll
            for (int ai = 0; ai < 2; ++ai)
#pragma unroll
                for (int m = 0; m < 4; ++m) rsa[ai][m] = rt.get(u, ai * HALF + wr * 64 + m * 16 + fr);
#pragma unroll
            for (int ai = 0; ai < 2; ++ai) {
                float carry[8];
#pragma unroll
                for (int c = 0; c < 8; ++c) carry[c] = 1.0f;
#pragma unroll
                for (int m = 0; m < 4; ++m) { const int row = row0 + ai * HALF + m * 16; const float rs = rsa[ai][m];
#pragma unroll
                    for (int n = 0; n < 2; ++n) { float xs[4];
#pragma unroll
                        for (int e = 0; e < 4; ++e) { const int c = 4 * n + e; const float qv = acc[ai][0][m][n][e] * rs, fv = acc[ai][1][m][n][e] * rs;
                            const float fg = lb[c] + (1.0f - lb[c]) * __builtin_amdgcn_rcpf(1.0f + __expf(-fv));
                            xs[e] = fg; acc[ai][0][m][n][e] = qv * __builtin_amdgcn_rcpf(1.0f + __expf(-qv)); acc[ai][1][m][n][e] = 1.0f - fg; }
                        float tt[4]; scan4_mul_tot(xs[0], xs[1], xs[2], xs[3], tt[0], tt[1], tt[2], tt[3]);
#pragma unroll
                        for (int e = 0; e < 4; ++e) { const int c = 4 * n + e;
                            const float tot = tt[e], cp = xs[e] * carry[c]; carry[c] *= tot;
                            acc[ai][0][m][n][e] *= cp;
                            acc[ai][1][m][n][e] *= __builtin_amdgcn_rcpf(fmaxf(cp, 1e-30f)); } }
                    bf16_t* rowp = O + (size_t)row * ldc + col0;
#pragma unroll
                    for (int bj = 0; bj < 2; ++bj) { const f32x4 v0 = acc[ai][bj][m][0], v1 = acc[ai][bj][m][1];
                        u32x4 w; w.x = cvt_pk_bf16(v0[0], v0[1]); w.y = cvt_pk_bf16(v0[2], v0[3]); w.z = cvt_pk_bf16(v1[0], v1[1]); w.w = cvt_pk_bf16(v1[2], v1[3]);
                        *(u32x4*)(rowp + bj * HALF) = w; }
                    __builtin_amdgcn_sched_barrier(0); }
                if (fr == 0) { float* ep = eg + (size_t)((u.pm * BM + ai * HALF + wr * 64) >> 6) * 1536 + ch0;
                    *(f32x4*)ep = (f32x4){carry[0], carry[1], carry[2], carry[3]}; *(f32x4*)(ep + 4) = (f32x4){carry[4], carry[5], carry[6], carry[7]}; }
            }
        } else {
            float rsb[2][4];
#pragma unroll
            for (int ai = 0; ai < 2; ++ai)
#pragma unroll
                for (int m = 0; m < 4; ++m) rsb[ai][m] = rt.get(u, ai * HALF + wr * 64 + m * 16 + fr);
#pragma unroll
            for (int ai = 0; ai < 2; ++ai)
#pragma unroll
                for (int m = 0; m < 4; ++m) { const int row = row0 + ai * HALF + m * 16; const float rs = rsb[ai][m];
                    bf16_t* rowp = O + (size_t)row * ldc + col0;
#pragma unroll
                    for (int bj = 0; bj < 2; ++bj) { const f32x4 v0 = acc[ai][bj][m][0] * rs, v1 = acc[ai][bj][m][1] * rs;
                        u32x4 w; w.x = cvt_pk_bf16(v0[0], v0[1]); w.y = cvt_pk_bf16(v0[2], v0[3]); w.z = cvt_pk_bf16(v1[0], v1[1]); w.w = cvt_pk_bf16(v1[2], v1[3]);
                        *(u32x4*)(rowp + bj * HALF) = w; } }
        }
    }
};

template <bool BF_BASE, bool W32, bool W16> struct EpiRes {
    static constexpr bool PERM = true, AFTER_DRAIN = false;
    const float* base32; const bf16_t* base16; float* out; bf16_t* hb; float* ssq;
    __device__ __forceinline__ void operator()(f32x4 (&acc)[2][2][4][2], const Unit& u, int wr, int wc, int fr, int fq) const {
        asm volatile("" : "+v"(fr), "+v"(fq));
        const int row0 = u.pm * BM + wr * 64 + fr, col0 = u.pn * BM + wc * 32 + 8 * fq;
#pragma unroll
        for (int ai = 0; ai < 2; ++ai) {
            f32x4 b[4][2][2];
#pragma unroll
            for (int m = 0; m < 4; ++m)
#pragma unroll
                for (int bj = 0; bj < 2; ++bj) { const size_t o2 = (size_t)(row0 + ai * HALF + m * 16) * 2048 + col0 + bj * HALF;
                    if constexpr (BF_BASE) { const u32x4 w = *(const u32x4*)(base16 + o2);
                        b[m][bj][0] = (f32x4){__builtin_bit_cast(float, w.x << 16), __builtin_bit_cast(float, w.x & 0xffff0000u), __builtin_bit_cast(float, w.y << 16), __builtin_bit_cast(float, w.y & 0xffff0000u)};
                        b[m][bj][1] = (f32x4){__builtin_bit_cast(float, w.z << 16), __builtin_bit_cast(float, w.z & 0xffff0000u), __builtin_bit_cast(float, w.w << 16), __builtin_bit_cast(float, w.w & 0xffff0000u)}; }
                    else { b[m][bj][0] = *(const f32x4*)(base32 + o2); b[m][bj][1] = *(const f32x4*)(base32 + o2 + 4); } }
#pragma unroll
            for (int m = 0; m < 4; ++m) { const int row = row0 + ai * HALF + m * 16; const size_t off = (size_t)row * 2048 + col0; float ss = 0.f;
#pragma unroll
                for (int bj = 0; bj < 2; ++bj) { const size_t o2 = off + bj * HALF; const f32x4 o0 = b[m][bj][0] + acc[ai][bj][m][0], o1 = b[m][bj][1] + acc[ai][bj][m][1];
                    ss += ((o0[0] * o0[0] + o0[1] * o0[1]) + (o0[2] * o0[2] + o0[3] * o0[3])) + ((o1[0] * o1[0] + o1[1] * o1[1]) + (o1[2] * o1[2] + o1[3] * o1[3]));
                    if constexpr (W32) { *(f32x4*)(out + o2) = o0; *(f32x4*)(out + o2 + 4) = o1; }
                    if constexpr (W16) { u32x4 w; w.x = cvt_pk_bf16(o0[0], o0[1]); w.y = cvt_pk_bf16(o0[2], o0[3]); w.z = cvt_pk_bf16(o1[0], o1[1]); w.w = cvt_pk_bf16(o1[2], o1[3]); *(u32x4*)(hb + o2) = w; } }
                ss = sum_fq(ss);
                if (fq == 0) ssq[(size_t)row * 32 + u.pn * 4 + wc] = ss; }
            asm volatile("" ::: "memory");
        }
    }
};

template <int N> __device__ __forceinline__ float dpp_ror(float v) { return __builtin_bit_cast(float, __builtin_amdgcn_update_dpp(0, __builtin_bit_cast(int, v), 0x120 + N, 0xf, 0xf, false)); }
__device__ __forceinline__ void conv4_dpp(float (&c)[4], const float (&s1)[4], const float (&s2)[4], const f32x4 w1, const f32x4 w0) {
    float w10 = w1[0], w11 = w1[1], w12 = w1[2], w13 = w1[3], w00 = w0[0], w01 = w0[1], w02 = w0[2], w03 = w0[3];
    asm volatile("s_nop 1\n\t"
        "v_fmac_f32_dpp %0, %4, %12 row_ror:1 row_mask:0xf bank_mask:0xf\n\tv_fmac_f32_dpp %1, %5, %13 row_ror:1 row_mask:0xf bank_mask:0xf\n\t"
        "v_fmac_f32_dpp %2, %6, %14 row_ror:1 row_mask:0xf bank_mask:0xf\n\tv_fmac_f32_dpp %3, %7, %15 row_ror:1 row_mask:0xf bank_mask:0xf\n\t"
        "v_fmac_f32_dpp %0, %8, %16 row_ror:2 row_mask:0xf bank_mask:0xf\n\tv_fmac_f32_dpp %1, %9, %17 row_ror:2 row_mask:0xf bank_mask:0xf\n\t"
        "v_fmac_f32_dpp %2, %10, %18 row_ror:2 row_mask:0xf bank_mask:0xf\n\tv_fmac_f32_dpp %3, %11, %19 row_ror:2 row_mask:0xf bank_mask:0xf"
        : "+v"(c[0]), "+v"(c[1]), "+v"(c[2]), "+v"(c[3])
        : "v"(s1[0]), "v"(s1[1]), "v"(s1[2]), "v"(s1[3]), "v"(s2[0]), "v"(s2[1]), "v"(s2[2]), "v"(s2[3]), "v"(w10), "v"(w11), "v"(w12), "v"(w13), "v"(w00), "v"(w01), "v"(w02), "v"(w03));
}
struct EpiUp {
    static constexpr bool PERM = true, AFTER_DRAIN = false;
    bf16_t* act; bf16_t* side; RstdTab rt; TapTab tt;
    __device__ __forceinline__ void operator()(f32x4 (&acc)[2][2][4][2], const Unit& u, int wr, int wc, int fr, int fq) const {
        asm volatile("" : "+v"(fr), "+v"(fq));
        const int row0 = u.pm * BM + wr * 64 + fr, f0 = u.pn * HALF + wc * 32 + 8 * fq;
        float rs[2][4];
#pragma unroll
        for (int ai = 0; ai < 2; ++ai)
#pragma unroll
            for (int m = 0; m < 4; ++m) rs[ai][m] = rt.get(u, ai * HALF + wr * 64 + m * 16 + fr);
        f32x4 cw0[2], cw1[2], cw2[2], cbb[2];
        { const PG8_LAS float* tp = tt.taps + tt.idx[u.pn] * 512 + wc * 32 + 8 * fq;
#pragma unroll
          for (int n = 0; n < 2; ++n) { cw0[n] = *(const PG8_LAS f32x4*)(tp + 4 * n); cw1[n] = *(const PG8_LAS f32x4*)(tp + 128 + 4 * n); cw2[n] = *(const PG8_LAS f32x4*)(tp + 256 + 4 * n); cbb[n] = *(const PG8_LAS f32x4*)(tp + 384 + 4 * n); } }
#pragma unroll
        for (int ai = 0; ai < 2; ++ai) {
#pragma unroll
            for (int m = 0; m < 4; ++m) { const float r1 = rs[ai][m], r1u = r1 * 0.6931471805599453f;
#pragma unroll
                for (int n = 0; n < 2; ++n) { acc[ai][0][m][n] = acc[ai][0][m][n] * r1u; acc[ai][1][m][n] = acc[ai][1][m][n] * r1; } }
            const int grp = (u.pm * BM + ai * HALF + wr * 64) >> 6;
            if (fr < 2) { const f32x4 ga = acc[ai][1][0][0], gb = acc[ai][1][0][1], ua = acc[ai][0][0][0], ub = acc[ai][0][0][1];
                u32x4 wg, wu; wg.x = cvt_pk_bf16(ga[0], ga[1]); wg.y = cvt_pk_bf16(ga[2], ga[3]); wg.z = cvt_pk_bf16(gb[0], gb[1]); wg.w = cvt_pk_bf16(gb[2], gb[3]);
                wu.x = cvt_pk_bf16(ua[0], ua[1]); wu.y = cvt_pk_bf16(ua[2], ua[3]); wu.z = cvt_pk_bf16(ub[0], ub[1]); wu.w = cvt_pk_bf16(ub[2], ub[3]);
                *(u32x4*)(side + ((size_t)grp * 6 + fr) * 5632 + f0) = wg; *(u32x4*)(side + ((size_t)grp * 6 + 2 + fr) * 5632 + f0) = wu; }
            if (fr >= 14) { const f32x4 ga = acc[ai][1][3][0], gb = acc[ai][1][3][1];
                u32x4 wg; wg.x = cvt_pk_bf16(ga[0], ga[1]); wg.y = cvt_pk_bf16(ga[2], ga[3]); wg.z = cvt_pk_bf16(gb[0], gb[1]); wg.w = cvt_pk_bf16(gb[2], gb[3]);
                *(u32x4*)(side + ((size_t)grp * 6 + 4 + (fr - 14)) * 5632 + f0) = wg; }
        }
#pragma unroll
        for (int ai = 0; ai < 2; ++ai)
#pragma unroll
            for (int m = 0; m < 4; ++m) {
#pragma unroll
                for (int n = 0; n < 2; ++n) { float c[4], s1[4], s2[4]; const f32x4 gv = acc[ai][1][m][n], cv = __builtin_elementwise_fma(cw2[n], gv, cbb[n]);
#pragma unroll
                    for (int e = 0; e < 4; ++e) { const float g0 = gv[e];
                        if (m > 0) { const float gp = acc[ai][1][m > 0 ? m - 1 : 0][n][e]; s1[e] = fr == 15 ? gp : g0; s2[e] = fr >= 14 ? gp : g0; }
                        else { s1[e] = g0; s2[e] = g0; }
                        c[e] = cv[e]; }
                    conv4_dpp(c, s1, s2, cw1[n], cw0[n]);
                    const f32x4 c2 = (f32x4){c[0], c[1], c[2], c[3]};
                    f32x4 ex;
#pragma unroll
                    for (int e = 0; e < 4; ++e) ex[e] = __builtin_amdgcn_exp2f(-c[e]);
                    ex = ex + 1.0f;
                    f32x4 rc;
#pragma unroll
                    for (int e = 0; e < 4; ++e) rc[e] = __builtin_amdgcn_rcpf(ex[e]);
                    acc[ai][0][m][n] = (c2 * rc) * acc[ai][0][m][n]; }
                const int row = row0 + ai * HALF + m * 16; const f32x4 oa = acc[ai][0][m][0], ob = acc[ai][0][m][1];
                u32x4 w; w.x = cvt_pk_bf16(oa[0], oa[1]); w.y = cvt_pk_bf16(oa[2], oa[3]); w.z = cvt_pk_bf16(ob[0], ob[1]); w.w = cvt_pk_bf16(ob[2], ob[3]);
                *(u32x4*)(act + ((((size_t)(row >> 8) * 88 + (f0 >> 6)) * 256 + (row & 255)) << 6) + (f0 & 63)) = w;
                __builtin_amdgcn_sched_barrier(0); }
    }
};

struct NoHook { static constexpr bool ENABLED = false; };
template <int NH, int PER, int NSLOT, int DV> struct HeadScaleHook {
    static constexpr bool ENABLED = true;
    const float* ssqh;
    __device__ __forceinline__ void stage(PG8_LAS float* tab, int pm, int tid) const {
        if (tid < 256) { const f32x4* p = (const f32x4*)(ssqh + (size_t)(pm * BM + tid) * 64); float sr[NH + 1];
#pragma unroll
            for (int h = 0; h < NH; ++h) { float a = 0.f;
#pragma unroll
                for (int j = 0; j < NSLOT / 4; ++j) { const f32x4 v = p[h * (NSLOT / 4) + j]; a += (v[0] + v[1]) + (v[2] + v[3]); }
                sr[h] = 1.0f / sqrtf(a * (1.0f / DV) + 1e-6f); }
            sr[NH] = 1.0f;
#pragma unroll
            for (int h = 0; h < NH; ++h) tab[tid * NH + h] = sr[h] / sr[h + 1]; }
    }
    __device__ __forceinline__ void apply(f32x4 (&acc)[2][2][4][2], const PG8_LAS float* tab, int t, int wr, int fr) const {
        if (t > 0 && t <= NH * PER && (t % PER) == 0) { const int hidx = t / PER - 1;
#pragma unroll
            for (int ai = 0; ai < 2; ++ai)
#pragma unroll
                for (int m = 0; m < 4; ++m) { const float f = tab[(ai * HALF + wr * 64 + m * 16 + fr) * NH + hidx];
#pragma unroll
                    for (int bj = 0; bj < 2; ++bj)
#pragma unroll
                        for (int n = 0; n < 2; ++n) acc[ai][bj][m][n] = acc[ai][bj][m][n] * f; } }
    }
};
template <class Epi, class Sched, bool ALIGN_EPI = false, bool SP2 = false, class Hook = NoHook, bool ABLK = false>
__device__ __forceinline__ void gemm_phase(PG8_LAS unsigned char* lds, const Gemm g, const Sched& S, const Epi& E, const Hook& HK = Hook()) {
    PG8_LAS float* hktab = (PG8_LAS float*)(lds + STAGE_BYTES);
    const int tid = threadIdx.x, wid = __builtin_amdgcn_readfirstlane(tid >> 6), lane = tid & 63, wr = wid >> 2, wc = wid & 3, fr = lane & 15, fq = lane >> 4;
    const int K = g.K, nt = K / BK;
    unsigned voffA[2], voffB[2];
#pragma unroll
    for (int i = 0; i < 2; ++i) { int R, C; stage_rc(tid * 16 + i * 8192, R, C); const int Rb = Epi::PERM ? ((R & ~31) + perm32(R & 31)) : R;
        voffA[i] = ABLK ? (unsigned)(R * BK + C) * 2u : (unsigned)(R * K + C) * 2u; voffB[i] = (unsigned)(Rb * BK + C) * 2u; }
    const size_t kstep = (size_t)(BK * 2);
    const size_t hstep = (size_t)HALF * K * 2;
    const size_t tstep = 2 * hstep;
    const size_t kstepB = (size_t)BM * BK * 2, hstepB = (size_t)HALF * BK * 2;
    const size_t kstepA = ABLK ? (size_t)BM * BK * 2 : kstep, hstepA = ABLK ? (size_t)HALF * BK * 2 : hstep, tstepA = tstep;
    const unsigned ldsw = (unsigned)wid * 1024u;
    const int aoff = lds_byte(wr * 64 + fr, fq * 8), boff = lds_byte(wc * 32 + fr, fq * 8);
#define PG8_SA(b, h) (((b) * 2 + (h)) * HTB)
#define PG8_SB(b, h) ((4 + (b) * 2 + (h)) * HTB)
#define PG8_STAGE(bufoff, gbase, voff) do { _Pragma("unroll") for (int _i = 0; _i < 2; ++_i) \
        __builtin_amdgcn_global_load_lds((const unsigned*)((const char*)(gbase) + (voff)[_i]), (PG8_LAS unsigned*)(lds + (bufoff) + ldsw + _i * 8192), 16, 0, 0); } while (0)
#define PG8_LDA(dst, b, h) do { _Pragma("unroll") for (int m = 0; m < 4; ++m) _Pragma("unroll") for (int k = 0; k < 2; ++k) dst[m][k] = *(const PG8_LAS bf16x8*)(lds + PG8_SA(b, h) + aoff + m * 2048 + k * 1024); } while (0)
#define PG8_LDB(dst, b, h) do { _Pragma("unroll") for (int n = 0; n < 2; ++n) _Pragma("unroll") for (int k = 0; k < 2; ++k) dst[n][k] = *(const PG8_LAS bf16x8*)(lds + PG8_SB(b, h) + boff + n * 2048 + k * 1024); } while (0)
#define PG8_MMA(ai, bj, At, Bt) do { __builtin_amdgcn_s_setprio(1); _Pragma("unroll") for (int m = 0; m < 4; ++m) _Pragma("unroll") for (int n = 0; n < 2; ++n) _Pragma("unroll") for (int k = 0; k < 2; ++k) \
        acc[ai][bj][m][n] = __builtin_amdgcn_mfma_f32_16x16x32_bf16(Bt[n][k], At[m][k], acc[ai][bj][m][n], 0, 0, 0); __builtin_amdgcn_s_setprio(0); } while (0)
#define PG8_WAIT_V(n) asm volatile("s_waitcnt vmcnt(" #n ")" ::: "memory")
#define PG8_WAIT_L(n) asm volatile("s_waitcnt lgkmcnt(" #n ")" ::: "memory")
#define PG8_BAR __builtin_amdgcn_s_barrier()
#define PG8_SCHED __builtin_amdgcn_sched_barrier(0)
    Unit cur, nxt; int ui = 0;
    if (!S.next(0, cur)) return;
    f32x4 acc[2][2][4][2];
#pragma unroll
    for (int a = 0; a < 2; ++a)
#pragma unroll
        for (int b = 0; b < 2; ++b)
#pragma unroll
            for (int m = 0; m < 4; ++m)
#pragma unroll
                for (int n = 0; n < 2; ++n) acc[a][b][m][n] = (f32x4){0.f, 0.f, 0.f, 0.f};
    bf16x8 At[4][2], B0[2][2], B1[2][2];
    const char* cA = (const char*)g.A + (size_t)cur.pm * tstepA; const char* cB = (const char*)g.Bt + (size_t)cur.pn * tstep;
    if constexpr (Hook::ENABLED) { HK.stage(hktab, cur.pm, tid); }
    S.a_ready(cur);
    if constexpr (SP2) {
        PG8_STAGE(PG8_SB(0, 0), cB, voffB); PG8_STAGE(PG8_SB(0, 1), cB + hstepB, voffB); PG8_STAGE(PG8_SA(0, 0), cA, voffA); PG8_STAGE(PG8_SA(0, 1), cA + hstepA, voffA);
        if (wr == 1) PG8_BAR;
        PG8_WAIT_V(2); PG8_BAR;
        PG8_STAGE(PG8_SB(1, 0), cB + kstepB, voffB); PG8_STAGE(PG8_SA(1, 0), cA + kstepA, voffA); PG8_STAGE(PG8_SB(1, 1), cB + hstepB + kstepB, voffB);
        PG8_WAIT_V(6); PG8_BAR;
    } else {
        PG8_STAGE(PG8_SB(0, 0), cB, voffB); PG8_STAGE(PG8_SA(0, 0), cA, voffA); PG8_STAGE(PG8_SB(0, 1), cB + hstepB, voffB); PG8_STAGE(PG8_SA(0, 1), cA + hstepA, voffA);
        if (wr == 1) PG8_BAR;
        PG8_WAIT_V(4); PG8_BAR;
        PG8_STAGE(PG8_SB(1, 0), cB + kstepB, voffB); PG8_STAGE(PG8_SA(1, 0), cA + kstepA, voffA); PG8_STAGE(PG8_SB(1, 1), cB + hstepB + kstepB, voffB);
        PG8_WAIT_V(6); PG8_BAR;
    }
    for (;;) {
        const bool has_next = S.next(ui + 1, nxt);
        const char* nA = has_next ? (const char*)g.A + (size_t)nxt.pm * tstepA : cA; const char* nB = has_next ? (const char*)g.Bt + (size_t)nxt.pn * tstep : cB;
        for (int t = 0; t < nt; t += 2) {
            const bool last = (t == nt - 2);
            const char* a1 = cA + (size_t)(t + 1) * kstepA;
            const char* a2 = last ? nA : cA + (size_t)(t + 2) * kstepA; const char* b2 = last ? nB : cB + (size_t)(t + 2) * kstepB;
            const char* a3 = a2 + kstepA; const char* b3 = b2 + kstepB;
            if (last && has_next) S.a_ready(nxt);
            if constexpr (Hook::ENABLED) HK.apply(acc, hktab, t, wr, fr);
            if constexpr (SP2) {
            PG8_LDB(B0, 0, 0); PG8_LDB(B1, 0, 1); PG8_SCHED; PG8_LDA(At, 0, 0); PG8_STAGE(PG8_SA(1, 1), a1 + hstepA, voffA);
            PG8_WAIT_V(8); PG8_WAIT_L(0); PG8_BAR; PG8_MMA(0, 0, At, B0); PG8_MMA(0, 1, At, B1); PG8_BAR; PG8_SCHED;
            PG8_LDA(At, 0, 1); PG8_STAGE(PG8_SB(0, 0), b2, voffB); PG8_STAGE(PG8_SB(0, 1), b2 + hstepB, voffB); PG8_STAGE(PG8_SA(0, 0), a2, voffA);
            PG8_WAIT_V(8); PG8_WAIT_L(0); PG8_BAR; PG8_MMA(1, 0, At, B0); PG8_MMA(1, 1, At, B1); PG8_BAR; PG8_SCHED;
            PG8_LDB(B0, 1, 0); PG8_LDB(B1, 1, 1); PG8_SCHED; PG8_LDA(At, 1, 0); PG8_STAGE(PG8_SA(0, 1), a2 + hstepA, voffA);
            PG8_WAIT_V(8); PG8_WAIT_L(0); PG8_BAR; PG8_MMA(0, 0, At, B0); PG8_MMA(0, 1, At, B1); PG8_BAR; PG8_SCHED;
            PG8_LDA(At, 1, 1); PG8_STAGE(PG8_SB(1, 0), b3, voffB); PG8_STAGE(PG8_SB(1, 1), b3 + hstepB, voffB); PG8_STAGE(PG8_SA(1, 0), a3, voffA);
            PG8_WAIT_V(8); PG8_WAIT_L(0); PG8_BAR; PG8_MMA(1, 0, At, B0); PG8_MMA(1, 1, At, B1); PG8_BAR; PG8_SCHED;
            } else {
            PG8_LDB(B0, 0, 0); PG8_SCHED; PG8_LDA(At, 0, 0); PG8_STAGE(PG8_SA(1, 1), a1 + hstepA, voffA);
            PG8_WAIT_L(8); PG8_BAR; PG8_WAIT_L(0); PG8_MMA(0, 0, At, B0); PG8_BAR; PG8_SCHED;
            PG8_LDB(B1, 0, 1); PG8_STAGE(PG8_SB(0, 0), b2, voffB);
            PG8_BAR; PG8_WAIT_L(0); PG8_MMA(0, 1, At, B1); PG8_BAR;
            PG8_LDA(At, 0, 1); PG8_STAGE(PG8_SA(0, 0), a2, voffA);
            PG8_BAR; PG8_WAIT_L(0); PG8_MMA(1, 0, At, B0); PG8_BAR; PG8_SCHED;
            PG8_STAGE(PG8_SB(0, 1), b2 + hstepB, voffB);
            PG8_WAIT_V(6); PG8_BAR; PG8_MMA(1, 1, At, B1); PG8_BAR;
            PG8_LDB(B0, 1, 0); PG8_SCHED; PG8_LDA(At, 1, 0); PG8_STAGE(PG8_SA(0, 1), a2 + hstepA, voffA);
            PG8_WAIT_L(8); PG8_BAR; PG8_WAIT_L(0); PG8_MMA(0, 0, At, B0); PG8_BAR; PG8_SCHED;
            PG8_LDB(B1, 1, 1); PG8_STAGE(PG8_SB(1, 0), b3, voffB);
            PG8_BAR; PG8_WAIT_L(0); PG8_MMA(0, 1, At, B1); PG8_BAR;
            PG8_LDA(At, 1, 1); PG8_STAGE(PG8_SA(1, 0), a3, voffA);
            PG8_BAR; PG8_WAIT_L(0); PG8_MMA(1, 0, At, B0); PG8_BAR; PG8_SCHED;
            PG8_STAGE(PG8_SB(1, 1), b3 + hstepB, voffB);
            PG8_WAIT_V(6); PG8_BAR; PG8_MMA(1, 1, At, B1); PG8_BAR;
            }
        }
        if constexpr (ALIGN_EPI) { if (wr == 0) PG8_BAR; }
        if constexpr (!Epi::AFTER_DRAIN) { E(acc, cur, wr, wc, fr, fq); S.done(cur); }
        if (!has_next) break;
#pragma unroll
        for (int a = 0; a < 2; ++a)
#pragma unroll
            for (int b = 0; b < 2; ++b)
#pragma unroll
                for (int m = 0; m < 4; ++m)
#pragma unroll
                    for (int n = 0; n < 2; ++n) acc[a][b][m][n] = (f32x4){0.f, 0.f, 0.f, 0.f};
        if constexpr (Hook::ENABLED) { if (nxt.pm != cur.pm) HK.stage(hktab, nxt.pm, tid); }
        cur = nxt; cA = nA; cB = nB; ++ui;
        if constexpr (ALIGN_EPI) { if (wr == 1) PG8_BAR; }
    }
    PG8_WAIT_V(0);
    if constexpr (!ALIGN_EPI) { if (wr == 0) PG8_BAR; }
    PG8_BAR;
    if constexpr (Epi::AFTER_DRAIN) { E.fused(acc, cur, wr, wc, fr, fq, lds, wid, lane); S.done(cur); }
#undef PG8_SA
#undef PG8_SB
#undef PG8_STAGE
#undef PG8_LDA
#undef PG8_LDB
#undef PG8_MMA
#undef PG8_WAIT_V
#undef PG8_WAIT_L
#undef PG8_BAR
#undef PG8_SCHED
}
}

#ifndef PG8_SP2
#define PG8_SP2 true
#endif
#ifndef PG8_ALIGN
#define PG8_ALIGN true
#endif
constexpr int NWAVES = 8, NTHR = 512;
constexpr int BATCH = 8, SEQ = 4096, DM = 2048, T = BATCH * SEQ, MEMLEN = 256, TM = BATCH * MEMLEN;
constexpr int XAW = 512, XAH = 4, XAD = 128, MIXW = 1536;
constexpr int A_H = 4, A_DV = 384, A_DK = 192;
constexpr int B_H = 12, B_DK = 128, B_DV = 128;
constexpr int DFF = 5632;
constexpr int COLS_A = 5128, NA = 5120, NB = 6656;
constexpr int ZA_K = 768, ZA_V = 1536, ZA_O = 3072, ZA_XQ = 4608;
constexpr int ZB_F = 1536, ZB_I = 3072, ZB_G = 4608, ZB_XQ = 6144;
constexpr float EPS = 1e-6f;

constexpr size_t MiB = 1u << 20;
constexpr size_t WS_CTL = 0, WS_GATES = 1 * MiB, WS_SSQ = 2 * MiB, WS_SSQM = 6 * MiB, WS_MEMB = 8 * MiB, WS_KV = 16 * MiB, WS_SIDE = 24 * MiB;
constexpr size_t WS_WIN0 = 58 * MiB, WS_WOUT0 = 78 * MiB, WS_WUP0 = 86 * MiB, WS_WDN0 = 130 * MiB, WS_WIN1 = 152 * MiB, WS_WOUT1 = 178 * MiB, WS_WUP1 = 186 * MiB, WS_WDN1 = 230 * MiB, WS_WKV = 252 * MiB;
constexpr size_t WS_HRAW1 = WS_SIDE;
constexpr size_t WS_HB = 260 * MiB, WS_YCAT = 388 * MiB, WS_Z = 516 * MiB, WS_G5 = 932 * MiB, WS_SSQH = 936 * MiB, WS_END = 944 * MiB;
static_assert(WS_SIDE + (size_t)512 * 6 * DFF * 2 <= WS_WIN0 && WS_WIN0 + (size_t)NA * DM * 2 <= WS_WOUT0 && WS_WOUT0 + (size_t)DM * DM * 2 <= WS_WUP0 && WS_WUP0 + (size_t)2 * DFF * DM * 2 <= WS_WDN0 && WS_WDN0 + (size_t)DM * DFF * 2 <= WS_WIN1 &&
              WS_WIN1 + (size_t)NB * DM * 2 <= WS_WOUT1 && WS_WOUT1 + (size_t)DM * DM * 2 <= WS_WUP1 && WS_WUP1 + (size_t)2 * DFF * DM * 2 <= WS_WDN1 && WS_WDN1 + (size_t)DM * DFF * 2 <= WS_WKV && WS_WKV + (size_t)2048 * DM * 2 <= WS_HB &&
              WS_HRAW1 + (size_t)T * MIXW * 2 <= WS_WIN1 && WS_HB + (size_t)T * DM * 2 <= WS_YCAT && WS_YCAT + (size_t)T * DM * 2 <= WS_Z && WS_Z + (size_t)T * NB * 2 <= WS_G5 && WS_SSQH + (size_t)T * 64 * 4 <= WS_END, "d_ws map");
constexpr int LDS_BYTES = 160 * 1024, MISC_OFF = LDS_BYTES - 64;
constexpr size_t CTL_ZERO_BYTES = 65536;
constexpr int CW_BAR = 1024;

#define LAS __attribute__((address_space(3)))
typedef unsigned short bf16;
typedef float f32x4 __attribute__((ext_vector_type(4)));
typedef short bf16x8 __attribute__((ext_vector_type(8)));
typedef unsigned u32x4 __attribute__((ext_vector_type(4)));
typedef unsigned u32x2 __attribute__((ext_vector_type(2)));

typedef __bf16 bf16v2 __attribute__((ext_vector_type(2)));
__device__ __forceinline__ unsigned short f2bf(float f) { const __bf16 b = (__bf16)f; return __builtin_bit_cast(unsigned short, b); }
__device__ __forceinline__ unsigned pk2(float lo, float hi) { bf16v2 v; v[0] = (__bf16)lo; v[1] = (__bf16)hi; return __builtin_bit_cast(unsigned, v); }
__device__ __forceinline__ float bf2f(unsigned short b) { return __builtin_bit_cast(float, (unsigned)b << 16); }
__device__ __forceinline__ float wave_sum(float v) {
#pragma unroll
    for (int o = 1; o < 64; o <<= 1) v += __shfl_xor(v, o);
    return v;
}
__device__ __forceinline__ float sigmoidf_(float x) { return __builtin_amdgcn_rcpf(1.0f + __expf(-x)); }
__device__ __forceinline__ float siluf_(float x) { return x * __builtin_amdgcn_rcpf(1.0f + __expf(-x)); }

template <int KS> struct Frag { bf16x8 v[KS]; };
template <int KS> __device__ __forceinline__ void ldfrag(Frag<KS>& f, const LAS bf16* p, int ld, int fr, int fq) {
    const LAS bf16* q = p + fr * ld + fq * 8;
#pragma unroll
    for (int k = 0; k < KS; ++k) f.v[k] = *(const LAS bf16x8*)(q + 32 * k);
}
typedef short s16x4 __attribute__((ext_vector_type(4)));
template <int KS> __device__ __forceinline__ void ldfrag_tr(Frag<KS>& f, const LAS bf16* X, int ld, int c0, int fr, int fq) {
    const LAS bf16* q = X + (8 * fq + (fr >> 2)) * ld + c0 + 4 * (fr & 3);
#pragma unroll
    for (int k = 0; k < KS; ++k) { const s16x4 lo = __builtin_amdgcn_ds_read_tr16_b64_v4i16((LAS s16x4*)(q + 32 * k * ld)), hi = __builtin_amdgcn_ds_read_tr16_b64_v4i16((LAS s16x4*)(q + (32 * k + 4) * ld));
        f.v[k] = (bf16x8){lo[0], lo[1], lo[2], lo[3], hi[0], hi[1], hi[2], hi[3]}; }
}
template <int KS> __device__ __forceinline__ void ldfrag_trp(Frag<KS>& f, const LAS bf16* X, int ld, int c0, int fr, int fq) {
    const LAS bf16* q = X + (4 * fq + (fr >> 2)) * ld + c0 + 4 * (fr & 3);
#pragma unroll
    for (int k = 0; k < KS; ++k) { const s16x4 lo = __builtin_amdgcn_ds_read_tr16_b64_v4i16((LAS s16x4*)(q + 32 * k * ld)), hi = __builtin_amdgcn_ds_read_tr16_b64_v4i16((LAS s16x4*)(q + (32 * k + 16) * ld));
        f.v[k] = (bf16x8){lo[0], lo[1], lo[2], lo[3], hi[0], hi[1], hi[2], hi[3]}; }
}
template <int KS> __device__ __forceinline__ f32x4 mmaf(const Frag<KS>& a, const Frag<KS>& b, f32x4 acc) {
#pragma unroll
    for (int k = 0; k < KS; ++k) acc = __builtin_amdgcn_mfma_f32_16x16x32_bf16(a.v[k], b.v[k], acc, 0, 0, 0);
    return acc;
}
struct Args { const float* in[21]; float* out; unsigned char* ws; int ph_lo, ph_hi; };
enum { IN_X = 0, IN_MEM, IN_NMIX, IN_NMEM, IN_NFFN, IN_NOUT, IN_WKV, IN_AWIN, IN_AGB, IN_ACW, IN_ACB, IN_AHG, IN_AWOUT, IN_BWIN, IN_BLB, IN_BHG, IN_BWOUT, IN_FUP, IN_FCW, IN_FCB, IN_FDN };

struct WDesc { const float* src; bf16* dst; const float* scale; int K, Nsrc, Ndst, kind, slen; };
__device__ __forceinline__ int src_col(int kind, int n) {
    if (kind == 1) return n < 4608 ? n : n + 8;
    if (kind == 2) { const int pn = n >> 8, r = n & 255; return (r >> 7) * DFF + pn * 128 + (r & 127); }
    if (kind == 3) { if (n >= 2 * MIXW) return n; const int hh = n >> 8, r = n & 255; return (r >> 7) * MIXW + hh * 128 + (r & 127); }
    return n;
}
__device__ __forceinline__ WDesc get_wdesc(const Args& a, int i) {
    unsigned char* ws = a.ws; WDesc d;
    switch (i) {
    case 0:  d = WDesc{a.in[IN_AWIN], (bf16*)(ws + WS_WIN0), a.in[IN_NMIX], DM, COLS_A, NA, 1, 1 << 30}; break;
    case 1:  d = WDesc{a.in[IN_BWIN], (bf16*)(ws + WS_WIN1), a.in[IN_NMIX] + DM, DM, NB, NB, 3, 1 << 30}; break;
    case 2:  d = WDesc{a.in[IN_AWOUT], (bf16*)(ws + WS_WOUT0), a.in[IN_AHG], DM, DM, DM, 0, MIXW}; break;
    case 3:  d = WDesc{a.in[IN_BWOUT], (bf16*)(ws + WS_WOUT1), a.in[IN_BHG], DM, DM, DM, 0, MIXW}; break;
    case 4:  d = WDesc{a.in[IN_FUP], (bf16*)(ws + WS_WUP0), a.in[IN_NFFN], DM, 2 * DFF, 2 * DFF, 2, 1 << 30}; break;
    case 5:  d = WDesc{a.in[IN_FUP] + (size_t)DM * 2 * DFF, (bf16*)(ws + WS_WUP1), a.in[IN_NFFN] + DM, DM, 2 * DFF, 2 * DFF, 2, 1 << 30}; break;
    case 6:  d = WDesc{a.in[IN_FDN], (bf16*)(ws + WS_WDN0), nullptr, DFF, DM, DM, 0, 1 << 30}; break;
    case 7:  d = WDesc{a.in[IN_FDN] + (size_t)DFF * DM, (bf16*)(ws + WS_WDN1), nullptr, DFF, DM, DM, 0, 1 << 30}; break;
    case 8:  d = WDesc{a.in[IN_WKV], (bf16*)(ws + WS_WKV), a.in[IN_NMEM], DM, 1024, 1024, 0, 1 << 30}; break;
    default: d = WDesc{a.in[IN_WKV] + (size_t)DM * 1024, (bf16*)(ws + WS_WKV) + (size_t)1024 * DM, a.in[IN_NMEM] + DM, DM, 1024, 1024, 0, 1 << 30}; break;
    }
    return d;
}
struct WTile { const float* src; bf16* dst; const float* scale; int K, Nsrc; };
__device__ __forceinline__ bool wtile_get(const Args& a, int it, WTile& t, int lane) {
    int base = 0;
#pragma unroll 1
    for (int wi = 0; wi < 10; ++wi) { const WDesc d = get_wdesc(a, wi); const int nnb = d.Ndst / 256, nit = (d.K / 64) * nnb;
        if (it < base + nit) { const int r = it - base, kb = r / nnb, nb = r - kb * nnb, k0 = 64 * kb, n0 = 256 * nb;
            const int sc = src_col(d.kind, n0 + 128 * (lane >> 5)) + 4 * (lane & 31);
            t.src = d.src + (size_t)k0 * d.Nsrc + sc; t.dst = d.dst + ((size_t)nb * (d.K / 64) + kb) * (256 * 64);     t.scale = (d.scale && k0 < d.slen) ? d.scale + k0 : nullptr; t.K = d.K; t.Nsrc = d.Nsrc; return true; }
        base += nit; }
    return false;
}
constexpr int WT_ITEMS = (DM / 64) * (NA / 256) + (DM / 64) * (NB / 256) + 2 * (DM / 64) * (DM / 256) + 2 * (DM / 64) * (2 * DFF / 256) + 2 * (DFF / 64) * (DM / 256) + 2 * (DM / 64) * (1024 / 256);
__device__ __forceinline__ void phase_prologue(const Args& a, LAS unsigned char* lds, int tid, int lane, int wave) {
    unsigned char* ws = a.ws;
    LAS float* wg = (LAS float*)lds;
    { const float* W = a.in[IN_AWIN]; const float* g = a.in[IN_NMIX];
      for (int i = tid; i < DM * 8; i += NTHR) { const int k = i >> 3, j = i & 7; wg[j * DM + k] = W[(size_t)k * COLS_A + 4608 + j] * g[k]; } }
    __syncthreads();
    const int gw = blockIdx.x * NWAVES + wave, NGW = gridDim.x * NWAVES;
    { const float* x = a.in[IN_X]; bf16* hb = (bf16*)(ws + WS_HB); float* ssq = (float*)(ws + WS_SSQ); float* gates = (float*)(ws + WS_GATES); const float* gb = a.in[IN_AGB];
      for (int row = gw; row < T; row += NGW) {
        const f32x4* xr = (const f32x4*)(x + (size_t)row * DM) + lane; f32x4 v[8]; float s = 0.f;
#pragma unroll
        for (int j = 0; j < 8; ++j) { v[j] = xr[64 * j]; s += (v[j][0] * v[j][0] + v[j][1] * v[j][1]) + (v[j][2] * v[j][2] + v[j][3] * v[j][3]); }
        s = wave_sum(s);
        u32x2* o8 = (u32x2*)(hb + (size_t)row * DM) + lane;
#pragma unroll
        for (int j = 0; j < 8; ++j) { u32x2 w; w.x = pk2(v[j][0], v[j][1]); w.y = pk2(v[j][2], v[j][3]); o8[64 * j] = w; }
        float mine = 0.f;
#pragma unroll 1
        for (int q = 0; q < 8; ++q) { float t = 0.f;
#pragma unroll
            for (int j = 0; j < 8; ++j) { const f32x4 w = *(const LAS f32x4*)(wg + q * DM + 256 * j + 4 * lane); t += (v[j][0] * w[0] + v[j][1] * w[1]) + (v[j][2] * w[2] + v[j][3] * w[3]); }
            t = wave_sum(t); mine = (lane == q) ? t : mine; }
        const float rstd = 1.0f / sqrtf(s * (1.0f / DM) + EPS);
        if (lane < 32) ssq[(size_t)row * 32 + lane] = lane == 0 ? s : 0.f;
        if (lane < 8) { float pre = mine * rstd + gb[lane]; if (lane >= 4) pre = fminf(pre, 0.f) - log1pf(__expf(-fabsf(pre))); gates[(size_t)row * 8 + lane] = pre; }
      } }
    { const float* x = a.in[IN_MEM]; bf16* mb = (bf16*)(ws + WS_MEMB); float* ssq = (float*)(ws + WS_SSQM);
      for (int row = gw; row < TM; row += NGW) {
        const f32x4* xr = (const f32x4*)(x + (size_t)row * DM) + lane; f32x4 v[8]; float s = 0.f;
#pragma unroll
        for (int j = 0; j < 8; ++j) { v[j] = xr[64 * j]; s += (v[j][0] * v[j][0] + v[j][1] * v[j][1]) + (v[j][2] * v[j][2] + v[j][3] * v[j][3]); }
        s = wave_sum(s);
        u32x2* o8 = (u32x2*)(mb + (size_t)row * DM) + lane;
#pragma unroll
        for (int j = 0; j < 8; ++j) { u32x2 w; w.x = pk2(v[j][0], v[j][1]); w.y = pk2(v[j][2], v[j][3]); o8[64 * j] = w; }
        if (lane < 32) ssq[(size_t)row * 32 + lane] = lane == 0 ? s : 0.f;
      } }
    __syncthreads();
    {   LAS float* tile0 = (LAS float*)lds;
        f32x4 pf[8]; WTile cur, nxt; int it = blockIdx.x; bool have = wtile_get(a, it, cur, lane);
        if (have) {
#pragma unroll
            for (int i = 0; i < 8; ++i) pf[i] = *(const f32x4*)(cur.src + (size_t)(8 * wave + i) * cur.Nsrc); }
        int buf = 0;
        while (have) {
            LAS float* tl = tile0 + buf * (64 * 260);
#pragma unroll
            for (int i = 0; i < 8; ++i) { f32x4 v = pf[i]; if (cur.scale) v = v * cur.scale[8 * wave + i]; *(LAS f32x4*)(tl + (8 * wave + i) * 260 + ((4 * lane + 4 * ((10 * wave) & 15)) & 255)) = v; }
            const bool have_n = wtile_get(a, it + (int)gridDim.x, nxt, lane);
            if (have_n) {
#pragma unroll
                for (int i = 0; i < 8; ++i) pf[i] = *(const f32x4*)(nxt.src + (size_t)(8 * wave + i) * nxt.Nsrc); }
            __syncthreads();
#pragma unroll
            for (int j = 0; j < 4; ++j) { const int kq = lane & 7, n = 32 * wave + 8 * j + (lane >> 3); const LAS float* sp = tl + (8 * kq) * 260 + ((n + 4 * ((10 * kq) & 15)) & 255);
                u32x4 o; o.x = pk2(sp[0], sp[260]); o.y = pk2(sp[2 * 260], sp[3 * 260]); o.z = pk2(sp[4 * 260], sp[5 * 260]); o.w = pk2(sp[6 * 260], sp[7 * 260]);
                *(u32x4*)(cur.dst + (size_t)n * 64 + 8 * kq) = o; }
            cur = nxt; have = have_n; it += gridDim.x; buf ^= 1;
        }
    }
}

#ifndef HGRN_DUP
#define HGRN_DUP 0
#endif
#ifndef MLSTM_DUP
#define MLSTM_DUP 0
#endif
__device__ __forceinline__ void mlstm_gate_scan(const Args& a, int bh, int lane, int wave, LAS float* sc) {
    const float* gates = (const float*)(a.ws + WS_GATES); float* g5 = (float*)(a.ws + WS_G5);
    const int b = bh >> 2, h = bh & 3;
    const float* gp = gates + ((size_t)b * SEQ + lane) * 8 + h;
    float pig[8], plf[8], gg[8], uu[8], pmx[8];
#pragma unroll
    for (int k = 0; k < 8; ++k) { const int c = wave + 8 * k; pig[k] = gp[(size_t)64 * c * 8]; plf[k] = gp[(size_t)64 * c * 8 + 4]; }
#pragma unroll
    for (int k = 0; k < 8; ++k) {
        float g = plf[k];
#pragma unroll
        for (int o = 1; o < 64; o <<= 1) { const float x = __shfl_up(g, o); if (lane >= o) g += x; }
        const float u = pig[k] - g; float pm = u;
#pragma unroll
        for (int o = 1; o < 64; o <<= 1) { const float x = __shfl_up(pm, o); if (lane >= o) pm = fmaxf(pm, x); }
        gg[k] = g; uu[k] = u; pmx[k] = pm;
        if (lane == 63) { sc[wave + 8 * k] = g; sc[64 + wave + 8 * k] = pm; }
    }
    __syncthreads();
    const float g63c = sc[lane], pm63c = sc[64 + lane];
    float mst[8]; float m = 0.f;
#pragma unroll
    for (int c = 0; c < 64; ++c) { const float gq = __builtin_bit_cast(float, __builtin_amdgcn_readlane(__builtin_bit_cast(int, g63c), c)), pq = __builtin_bit_cast(float, __builtin_amdgcn_readlane(__builtin_bit_cast(int, pm63c), c));
        mst[c >> 3] = ((c & 7) == wave) ? m : mst[c >> 3];
        m = gq + fmaxf(m, pq); }
#pragma unroll
    for (int k = 0; k < 8; ++k) { const int c = wave + 8 * k; const size_t t = (size_t)b * SEQ + 64 * c + lane;
        const float m_st = mst[k], g = gg[k], u = uu[k];
        const float M = fmaxf(m_st, pmx[k]), M63 = __shfl(M, 63);
        f32x4 o0, o1; o0[0] = u; o0[1] = M; o0[2] = __expf(m_st - M); o0[3] = __expf(u - M63); o1[0] = __expf(-(g + M)); o1[1] = __expf(m_st - M63); o1[2] = 0.f; o1[3] = 0.f;
        f32x4* dst = (f32x4*)(g5 + (t * 4 + h) * 8); dst[0] = o0; dst[1] = o1; }
}
__device__ __forceinline__ void phase_mlstm_conv(const Args& a, int tid, int first, int stride, int end) {
    const bf16* Z = (const bf16*)(a.ws + WS_Z); bf16* QK = (bf16*)(a.ws + WS_HB);
    if (tid >= 384) return;
    const int cg = tid % 192, rg2 = tid / 192, c0 = cg * 8; const float osc = cg >= 96 ? 0.07216878364870322f : 1.0f;
    float w[4][8], bias[8];
    { const float* cw = a.in[IN_ACW]; const float* cb = a.in[IN_ACB];
#pragma unroll
      for (int k = 0; k < 4; ++k) { const f32x4 x0 = *(const f32x4*)(cw + k * 1536 + c0), x1 = *(const f32x4*)(cw + k * 1536 + c0 + 4);
#pragma unroll
          for (int e = 0; e < 4; ++e) { w[k][e] = x0[e]; w[k][4 + e] = x1[e]; } }
      const f32x4 b0 = *(const f32x4*)(cb + c0), b1 = *(const f32x4*)(cb + c0 + 4);
#pragma unroll
      for (int e = 0; e < 4; ++e) { bias[e] = b0[e]; bias[4 + e] = b1[e]; } }
    for (int it = first; it < end; it += stride) {
        const int t0 = it * 16 + rg2 * 8; const bool start = (t0 % SEQ) == 0;
        float x[11][8];
#pragma unroll
        for (int r = 0; r < 11; ++r) { u32x4 v = (u32x4){0u, 0u, 0u, 0u}; if (r >= 3 || !start) v = *(const u32x4*)(Z + (size_t)(t0 - 3 + r) * NA + c0);
            const unsigned vv[4] = {v.x, v.y, v.z, v.w};
#pragma unroll
            for (int e = 0; e < 4; ++e) { x[r][2 * e] = bf2f((bf16)(vv[e] & 0xffffu)); x[r][2 * e + 1] = bf2f((bf16)(vv[e] >> 16)); } }
#pragma unroll
        for (int r = 0; r < 8; ++r) { float y[8];
#pragma unroll
            for (int e = 0; e < 8; ++e) { const float c = bias[e] + w[0][e] * x[r][e] + w[1][e] * x[r + 1][e] + w[2][e] * x[r + 2][e] + w[3][e] * x[r + 3][e]; y[e] = siluf_(c) * osc; }
            u32x4 o; o.x = pk2(y[0], y[1]); o.y = pk2(y[2], y[3]); o.z = pk2(y[4], y[5]); o.w = pk2(y[6], y[7]);
            *(u32x4*)(QK + (size_t)(t0 + r) * MIXW + c0) = o; }
    }
}
template <int LI> __device__ __forceinline__ void mlstm_scores(const LAS bf16* Ks, const LAS float* fu, const Frag<6>& fqq, float Ml, int fr, int fq, unsigned (&pb)[4][2]) {
#pragma unroll
    for (int s0 = 0; s0 < 4; s0 += 2) {
        if (s0 <= LI) { constexpr int dummy = 0; (void)dummy; const bool two = s0 + 1 <= LI;
            Frag<6> fk0, fk1; f32x4 sa0 = (f32x4){0.f, 0.f, 0.f, 0.f}, sa1 = sa0;
            ldfrag(fk0, Ks + 16 * s0 * 200, 200, fr, fq); const f32x4 u0 = *(const LAS f32x4*)(fu + 16 * s0 + 4 * fq); f32x4 u1 = u0;
            if (two) { ldfrag(fk1, Ks + 16 * (s0 + 1) * 200, 200, fr, fq); u1 = *(const LAS f32x4*)(fu + 16 * (s0 + 1) + 4 * fq); }
#pragma unroll
            for (int k = 0; k < 6; ++k) { sa0 = __builtin_amdgcn_mfma_f32_16x16x32_bf16(fk0.v[k], fqq.v[k], sa0, 0, 0, 0); if (two) sa1 = __builtin_amdgcn_mfma_f32_16x16x32_bf16(fk1.v[k], fqq.v[k], sa1, 0, 0, 0); }
            { float p[4];
#pragma unroll
              for (int r = 0; r < 4; ++r) { const float v = sa0[r] * __expf(u0[r] - Ml); p[r] = (s0 < LI || 4 * fq + r <= fr) ? v : 0.f; }
              pb[s0][0] = pk2(p[0], p[1]); pb[s0][1] = pk2(p[2], p[3]); }
            if (two) { float p[4];
#pragma unroll
              for (int r = 0; r < 4; ++r) { const float v = sa1[r] * __expf(u1[r] - Ml); p[r] = (s0 + 1 < LI || 4 * fq + r <= fr) ? v : 0.f; }
              pb[s0 + 1][0] = pk2(p[0], p[1]); pb[s0 + 1][1] = pk2(p[2], p[3]); }
            else { pb[s0 + 1][0] = 0u; pb[s0 + 1][1] = 0u; } }
        else { pb[s0][0] = 0u; pb[s0][1] = 0u; pb[s0 + 1][0] = 0u; pb[s0 + 1][1] = 0u; } }
}
__device__ __forceinline__ void phase_mlstm(const Args& a, LAS unsigned char* lds, int tid, int lane, int wave) {
    unsigned char* ws = a.ws;
    const bf16* Z = (const bf16*)(ws + WS_Z); const bf16* QK = (const bf16*)(ws + WS_HB); const float* g5 = (const float*)(ws + WS_G5); bf16* ycat = (bf16*)(ws + WS_YCAT); float* ssqh = (float*)(ws + WS_SSQH);
    LAS bf16* Qs = (LAS bf16*)lds;
    LAS bf16* Ks = (LAS bf16*)(lds + 25600);
    LAS bf16* Vs = (LAS bf16*)(lds + 51200);
    LAS bf16* VWs = (LAS bf16*)(lds + 60416);
    LAS bf16* Ps = (LAS bf16*)(lds + 69632);
    LAS bf16* CT0 = (LAS bf16*)(lds + 78848);
    LAS float* fu = (LAS float*)(lds + 130048);
    LAS float* fM = fu + 64; LAS float* fwi = fu + 128; LAS float* fem = fu + 192; LAS float* fdec = fu + 256;
    const int fr = lane & 15, fq = lane >> 4;
    for (int item = blockIdx.x; item < BATCH * A_H * 8; item += gridDim.x) {
        const int bh = (item & 7) * 4 + (item >> 6), js = (item >> 3) & 7, b = bh >> 2, h = bh & 3;
        __syncthreads();
        for (int i = tid; i < 2 * 64 * 200 / 2; i += NTHR) ((LAS unsigned*)CT0)[i] = 0u;
        for (int i = tid; i < 64 * 72 / 2; i += NTHR) ((LAS unsigned*)VWs)[i] = 0u;
        for (int i = tid; i < 64 * 72; i += NTHR) Vs[i] = (i % 72 == 48) ? (bf16)0x3f80 : (bf16)0;
        f32x4 cacc[6];
#pragma unroll
        for (int i = 0; i < 6; ++i) cacc[i] = (f32x4){0.f, 0.f, 0.f, 0.f};
        __syncthreads();
        const int vrow = tid / 6, vcc = tid - vrow * 6;
        const int grow = tid >> 1, ghalf = tid & 1;
        const bf16* qkbase = QK + (size_t)b * SEQ * MIXW + h * A_DK;
        const bf16* vbase = Z + (size_t)b * SEQ * NA + ZA_V + h * A_DV + js * 48 + vcc * 8;
        const float* gbase = g5 + ((size_t)b * SEQ * 4 + h) * 8;
        u32x4 pq[3], pk[3], pv; f32x4 pg; float pws;
        const int o_vfa = (wave & 1) ? 2 : 0;
        const bf16* obase = Z + ((size_t)b * SEQ + 16 * (wave >> 1) + fr) * NA + ZA_O + h * A_DV + js * 48 + 4 * fq;
        u32x2 poa, pob;
#define MLSTM_PREFETCH(c_) do { const size_t tt = (size_t)64 * (c_); int tp_ = tid; asm volatile("" : "+v"(tp_)); \
            _Pragma("unroll") for (int j = 0; j < 3; ++j) { const int i = tp_ + NTHR * j, row = i / 24, cc = i - row * 24; pq[j] = *(const u32x4*)(qkbase + (tt + row) * MIXW + cc * 8); pk[j] = *(const u32x4*)(qkbase + (tt + row) * MIXW + 768 + cc * 8); } \
            if (tid < 384) { pv = *(const u32x4*)(vbase + (tt + vrow) * NA); pws = gbase[(tt + vrow) * 32 + 3]; } \
            if (tid < 128) pg = *(const f32x4*)(gbase + (tt + grow) * 32 + 4 * ghalf); \
            poa = *(const u32x2*)(obase + tt * NA + 16 * o_vfa); pob = *(const u32x2*)(obase + tt * NA + 16); } while (0)
        MLSTM_PREFETCH(0);
        for (int c = 0; c < SEQ / 64; ++c) {
            const size_t t0 = (size_t)b * SEQ + 64 * c; const int cur = c & 1;
            LAS bf16* CTc = CT0 + cur * 64 * 200; LAS bf16* CTn = CT0 + (cur ^ 1) * 64 * 200;
            {
            int ts_ = tid; asm volatile("" : "+v"(ts_));
#pragma unroll
            for (int j = 0; j < 3; ++j) { const int i = ts_ + NTHR * j, row = i / 24, cc = i - row * 24;
                *(LAS u32x4*)(Qs + row * 200 + cc * 8) = pq[j]; *(LAS u32x4*)(Ks + row * 200 + cc * 8) = pk[j]; }
            if (tid < 384) { *(LAS u32x4*)(Vs + vrow * 72 + vcc * 8) = pv; const unsigned vv[4] = {pv.x, pv.y, pv.z, pv.w}; unsigned ww[4];
#pragma unroll
                for (int e = 0; e < 4; ++e) ww[e] = pk2(bf2f((bf16)(vv[e] & 0xffffu)) * pws, bf2f((bf16)(vv[e] >> 16)) * pws);
                *(LAS u32x4*)(VWs + vrow * 72 + vcc * 8) = (u32x4){ww[0], ww[1], ww[2], ww[3]}; }
            if (tid < 128) { if (ghalf == 0) { fu[grow] = pg[0]; fM[grow] = pg[1]; fwi[grow] = pg[2]; VWs[grow * 72 + 48] = f2bf(pg[3]); } else { fem[grow] = pg[0]; if (grow == 0) fdec[0] = pg[1]; } }
            }
            __syncthreads();
            const u32x2 coa = poa, cob = pob;
            {
                const int li = wave >> 1, half = wave & 1, l = 16 * li + fr; const float wil = fwi[l], Ml = fM[l];
                Frag<6> fqq; ldfrag(fqq, Qs + 16 * li * 200, 200, fr, fq);
                unsigned pb[4][2];
                switch (li) { case 0: mlstm_scores<0>(Ks, fu, fqq, Ml, fr, fq, pb); break; case 1: mlstm_scores<1>(Ks, fu, fqq, Ml, fr, fq, pb); break; case 2: mlstm_scores<2>(Ks, fu, fqq, Ml, fr, fq, pb); break; default: mlstm_scores<3>(Ks, fu, fqq, Ml, fr, fq, pb); break; }
                __builtin_amdgcn_sched_barrier(0);
                if (c + 1 < SEQ / 64) MLSTM_PREFETCH(c + 1);
                Frag<2> fp;
#pragma unroll
                for (int k = 0; k < 2; ++k) { const u32x4 w = (u32x4){pb[2 * k][0], pb[2 * k][1], pb[2 * k + 1][0], pb[2 * k + 1][1]}; fp.v[k] = __builtin_bit_cast(bf16x8, w); }
                const int vfa = half ? 2 : 0;
                Frag<6> ca, cd; Frag<2> va, vd; ldfrag(ca, CTc + 16 * vfa * 200, 200, fr, fq); ldfrag(cd, CTc + 16 * 3 * 200, 200, fr, fq); ldfrag_trp(va, Vs, 72, 16 * vfa, fr, fq); ldfrag_trp(vd, Vs, 72, 48, fr, fq);
                f32x4 oa = (f32x4){0.f, 0.f, 0.f, 0.f}, od = oa, ob = oa;
#pragma unroll
                for (int k = 0; k < 6; ++k) { oa = __builtin_amdgcn_mfma_f32_16x16x32_bf16(ca.v[k], fqq.v[k], oa, 0, 0, 0); od = __builtin_amdgcn_mfma_f32_16x16x32_bf16(cd.v[k], fqq.v[k], od, 0, 0, 0); }
                oa = oa * wil; od = od * wil;
#pragma unroll
                for (int k = 0; k < 2; ++k) { oa = __builtin_amdgcn_mfma_f32_16x16x32_bf16(va.v[k], fp.v[k], oa, 0, 0, 0); od = __builtin_amdgcn_mfma_f32_16x16x32_bf16(vd.v[k], fp.v[k], od, 0, 0, 0); }
                if (!half) { Frag<6> cb; Frag<2> vb; ldfrag(cb, CTc + 16 * 200, 200, fr, fq); ldfrag_trp(vb, Vs, 72, 16, fr, fq);
                    ob = mmaf<6>(cb, fqq, ob); ob = ob * wil; ob = mmaf<2>(vb, fp, ob); }
                const float den = pg8::bcast_row0(od[0]), dinv = __builtin_amdgcn_rcpf(fmaxf(fabsf(den), fem[l]));
                bf16* orow = ycat + (t0 + l) * DM + h * A_DV + js * 48 + 4 * fq;
                float ss = 0.f;
                { const float g0 = sigmoidf_(bf2f((bf16)(coa.x & 0xffffu))), g1 = sigmoidf_(bf2f((bf16)(coa.x >> 16))), g2 = sigmoidf_(bf2f((bf16)(coa.y & 0xffffu))), g3 = sigmoidf_(bf2f((bf16)(coa.y >> 16)));
                  const float h0 = oa[0] * dinv, h1 = oa[1] * dinv, h2 = oa[2] * dinv, h3 = oa[3] * dinv; ss += (h0 * h0 + h1 * h1) + (h2 * h2 + h3 * h3);
                  u32x2 w2; w2.x = pk2(h0 * g0, h1 * g1); w2.y = pk2(h2 * g2, h3 * g3); *(u32x2*)(orow + 16 * vfa) = w2; }
                if (!half) { const float g0 = sigmoidf_(bf2f((bf16)(cob.x & 0xffffu))), g1 = sigmoidf_(bf2f((bf16)(cob.x >> 16))), g2 = sigmoidf_(bf2f((bf16)(cob.y & 0xffffu))), g3 = sigmoidf_(bf2f((bf16)(cob.y >> 16)));
                  const float h0 = ob[0] * dinv, h1 = ob[1] * dinv, h2 = ob[2] * dinv, h3 = ob[3] * dinv; ss += (h0 * h0 + h1 * h1) + (h2 * h2 + h3 * h3);
                  u32x2 w2; w2.x = pk2(h0 * g0, h1 * g1); w2.y = pk2(h2 * g2, h3 * g3); *(u32x2*)(orow + 16) = w2; }
                ss = pg8::sum_fq(ss);
                if (fq == 0) ssqh[(t0 + l) * 64 + h * 16 + js * 2 + half] = ss;
            }
            {
                const float decay = fdec[0];
                Frag<2> fv[4];
#pragma unroll
                for (int vf = 0; vf < 4; ++vf) ldfrag_tr(fv[vf], VWs, 72, 16 * vf, fr, fq);
                const int dk0 = (6 * wave) >> 2;
                Frag<2> fka, fkb; ldfrag_tr(fka, Ks, 200, 16 * dk0, fr, fq); ldfrag_tr(fkb, Ks, 200, 16 * (dk0 + 1), fr, fq);
#pragma unroll
                for (int i = 0; i < 6; ++i) cacc[i] = cacc[i] * decay;
                if (wave & 1) {
                    cacc[0] = mmaf<2>(fka, fv[2], cacc[0]); cacc[1] = mmaf<2>(fka, fv[3], cacc[1]); cacc[2] = mmaf<2>(fkb, fv[0], cacc[2]); cacc[3] = mmaf<2>(fkb, fv[1], cacc[3]); cacc[4] = mmaf<2>(fkb, fv[2], cacc[4]); cacc[5] = mmaf<2>(fkb, fv[3], cacc[5]);
                } else {
                    cacc[0] = mmaf<2>(fka, fv[0], cacc[0]); cacc[1] = mmaf<2>(fka, fv[1], cacc[1]); cacc[2] = mmaf<2>(fka, fv[2], cacc[2]); cacc[3] = mmaf<2>(fka, fv[3], cacc[3]); cacc[4] = mmaf<2>(fkb, fv[0], cacc[4]); cacc[5] = mmaf<2>(fkb, fv[1], cacc[5]);
                }
#pragma unroll
                for (int i = 0; i < 6; ++i) { const int f = 6 * wave + i, dkf = f >> 2, vf = f & 3;
                    u32x2 w2; w2.x = pk2(cacc[i][0], cacc[i][1]); w2.y = pk2(cacc[i][2], cacc[i][3]);
                    *(LAS u32x2*)(CTn + (16 * vf + fr) * 200 + 16 * dkf + 4 * fq) = w2; }
            }
            __syncthreads();
        }
#undef MLSTM_PREFETCH
    }
}

template <int LI> __device__ __forceinline__ void hgrn_scores(const LAS bf16* Kg, const Frag<4>& fqq, int fr, int fq, unsigned (&pb)[4][2]) {
    Frag<4> fk[LI + 1]; f32x4 sa[LI + 1];
#pragma unroll
    for (int si = 0; si <= LI; ++si) { ldfrag(fk[si], Kg + 16 * si * 136, 136, fr, fq); sa[si] = (f32x4){0.f, 0.f, 0.f, 0.f}; }
#pragma unroll
    for (int k = 0; k < 4; ++k)
#pragma unroll
        for (int si = 0; si <= LI; ++si) sa[si] = __builtin_amdgcn_mfma_f32_16x16x32_bf16(fk[si].v[k], fqq.v[k], sa[si], 0, 0, 0);
#pragma unroll
    for (int si = 0; si < 4; ++si) {
        if (si < LI) { pb[si][0] = pk2(sa[si < LI ? si : 0][0], sa[si < LI ? si : 0][1]); pb[si][1] = pk2(sa[si < LI ? si : 0][2], sa[si < LI ? si : 0][3]); }
        else if (si == LI) { float p[4];
#pragma unroll
            for (int r = 0; r < 4; ++r) p[r] = (4 * fq + r <= fr) ? sa[LI][r] : 0.f;
            pb[si][0] = pk2(p[0], p[1]); pb[si][1] = pk2(p[2], p[3]); }
        else { pb[si][0] = 0u; pb[si][1] = 0u; } }
}
__device__ __forceinline__ void phase_hgrn(const Args& a, LAS unsigned char* lds, int tid, int lane, int wave) {
    unsigned char* ws = a.ws;
    const bf16* Z = (const bf16*)(ws + WS_Z); bf16* ycat = (bf16*)(ws + WS_YCAT); float* ssqh = (float*)(ws + WS_SSQH);
    LAS bf16* Qg0 = (LAS bf16*)lds;
    LAS bf16* Kg0 = (LAS bf16*)(lds + 34816);
    LAS bf16* VT0 = (LAS bf16*)(lds + 69632);
    LAS bf16* ST0 = (LAS bf16*)(lds + 88064);
    LAS float* eg0 = (LAS float*)(lds + 122880);
    const int fr = lane & 15, fq = lane >> 4;
    const int vrow = tid >> 3, vcc = tid & 7;
    for (int q = blockIdx.x; q < BATCH * B_H * 2; q += gridDim.x) {
        const int item = (q & 7) * (B_H * 2) + (q >> 3);
        const int bh = item >> 1, js = item & 1, b = bh / B_H, h = bh - b * B_H;
        __syncthreads();
        for (int i = tid; i < 2 * 64 * 136 / 2; i += NTHR) ((LAS unsigned*)ST0)[i] = 0u;
        const int ndk = wave < 2 ? 2 : (wave < 6 ? 1 : 0), dkf0 = wave < 2 ? 2 * wave : wave + 2;
        f32x4 sacc[2][4];
#pragma unroll
        for (int d = 0; d < 2; ++d)
#pragma unroll
            for (int i = 0; i < 4; ++i) sacc[d][i] = (f32x4){0.f, 0.f, 0.f, 0.f};
        const bf16* qbase = Z + (size_t)b * SEQ * NB + 256 * h;
        const bf16* vbase = Z + ((size_t)b * SEQ + vrow) * NB + ZB_I + h * B_DV + js * 64 + vcc * 8;
        const float* egbase = (const float*)(ws + WS_G5) + (size_t)b * (SEQ / 64) * 1536 + h * B_DK;
        u32x4 pq[2], pk[2], pv; float peg = 0.f;
        const int g_vf0 = 2 * (wave & 1);
        const bf16* gbase_ = Z + ((size_t)b * SEQ + 16 * (wave >> 1) + fr) * NB + ZB_G + h * B_DV + js * 64 + 16 * g_vf0 + 4 * fq;
        u32x2 pga, pgb;
#define HGRN_PREFETCH(c_) do { const size_t tt = (size_t)64 * (c_); \
            _Pragma("unroll") for (int j = 0; j < 2; ++j) { const int i = tid + NTHR * j, row = i >> 4, cc = i & 15; pq[j] = *(const u32x4*)(qbase + (tt + row) * NB + cc * 8); pk[j] = *(const u32x4*)(qbase + (tt + row) * NB + 128 + cc * 8); } \
            pv = *(const u32x4*)(vbase + tt * NB); if (tid < 128) peg = egbase[(size_t)(c_) * 1536 + tid]; } while (0)
#define HGRN_PREFETCH_GATE(c_) do { pga = *(const u32x2*)(gbase_ + (size_t)64 * (c_) * NB); pgb = *(const u32x2*)(gbase_ + (size_t)64 * (c_) * NB + 16); } while (0)
#define HGRN_ELEMENTWISE(bi_) do { LAS bf16* Qg_ = Qg0 + (bi_) * 64 * 136; LAS bf16* Kg_ = Kg0 + (bi_) * 64 * 136; \
            _Pragma("unroll") for (int j = 0; j < 2; ++j) { const int i = tid + NTHR * j, row = i >> 4, cc = i & 15; *(LAS u32x4*)(Qg_ + row * 136 + cc * 8) = pq[j]; *(LAS u32x4*)(Kg_ + row * 136 + cc * 8) = pk[j]; } \
            if (tid < 128) eg0[(bi_) * 128 + tid] = peg; \
            *(LAS u32x4*)(VT0 + (bi_) * 64 * 72 + vrow * 72 + vcc * 8) = pv; } while (0)
        HGRN_PREFETCH(0);
        HGRN_ELEMENTWISE(0);
        HGRN_PREFETCH(1);
        HGRN_PREFETCH_GATE(0);
        __syncthreads();
        for (int c = 0; c < SEQ / 64; ++c) {
            const size_t t0 = (size_t)b * SEQ + 64 * c; const int cur = c & 1;
            const LAS bf16* Qg = Qg0 + cur * 64 * 136; const LAS bf16* Kg = Kg0 + cur * 64 * 136; const LAS bf16* VT = VT0 + cur * 64 * 72;
            const LAS bf16* STc = ST0 + cur * 64 * 136; LAS bf16* STn = ST0 + (cur ^ 1) * 64 * 136; const LAS float* eg = eg0 + cur * 128;
            const u32x2 cga = pga, cgb = pgb;
            if (c + 1 < SEQ / 64) HGRN_PREFETCH_GATE(c + 1);
            {
                const int li = wave >> 1, l = 16 * li + fr, vf0 = 2 * (wave & 1);
                Frag<4> fqq; ldfrag(fqq, Qg + 16 * li * 136, 136, fr, fq);
                unsigned pb[4][2];
                switch (li) { case 0: hgrn_scores<0>(Kg, fqq, fr, fq, pb); break; case 1: hgrn_scores<1>(Kg, fqq, fr, fq, pb); break; case 2: hgrn_scores<2>(Kg, fqq, fr, fq, pb); break; default: hgrn_scores<3>(Kg, fqq, fr, fq, pb); break; }
                __builtin_amdgcn_sched_barrier(0);
                if (c + 1 < SEQ / 64) { HGRN_ELEMENTWISE(cur ^ 1); if (c + 2 < SEQ / 64) HGRN_PREFETCH(c + 2); }
                __builtin_amdgcn_sched_barrier(0);
                Frag<2> fp;
#pragma unroll
                for (int k = 0; k < 2; ++k) { const u32x4 w = (u32x4){pb[2 * k][0], pb[2 * k][1], pb[2 * k + 1][0], pb[2 * k + 1][1]}; fp.v[k] = __builtin_bit_cast(bf16x8, w); }
                Frag<4> sa, sb; Frag<2> va, vb;
                ldfrag(sa, STc + 16 * vf0 * 136, 136, fr, fq); ldfrag(sb, STc + 16 * (vf0 + 1) * 136, 136, fr, fq);
                ldfrag_trp(va, VT, 72, 16 * vf0, fr, fq); ldfrag_trp(vb, VT, 72, 16 * (vf0 + 1), fr, fq);
                f32x4 oa = (f32x4){0.f, 0.f, 0.f, 0.f}, ob = oa;
#pragma unroll
                for (int k = 0; k < 4; ++k) { oa = __builtin_amdgcn_mfma_f32_16x16x32_bf16(sa.v[k], fqq.v[k], oa, 0, 0, 0); ob = __builtin_amdgcn_mfma_f32_16x16x32_bf16(sb.v[k], fqq.v[k], ob, 0, 0, 0); }
#pragma unroll
                for (int k = 0; k < 2; ++k) { oa = __builtin_amdgcn_mfma_f32_16x16x32_bf16(va.v[k], fp.v[k], oa, 0, 0, 0); ob = __builtin_amdgcn_mfma_f32_16x16x32_bf16(vb.v[k], fp.v[k], ob, 0, 0, 0); }
                bf16* orow = ycat + (t0 + l) * DM + h * B_DV + js * 64 + 4 * fq;
                float ss = (oa[0] * oa[0] + oa[1] * oa[1]) + (oa[2] * oa[2] + oa[3] * oa[3]) + (ob[0] * ob[0] + ob[1] * ob[1]) + (ob[2] * ob[2] + ob[3] * ob[3]);
                { const float g0 = siluf_(bf2f((bf16)(cga.x & 0xffffu))), g1 = siluf_(bf2f((bf16)(cga.x >> 16))), g2 = siluf_(bf2f((bf16)(cga.y & 0xffffu))), g3 = siluf_(bf2f((bf16)(cga.y >> 16)));
                  u32x2 w2; w2.x = pk2(oa[0] * g0, oa[1] * g1); w2.y = pk2(oa[2] * g2, oa[3] * g3); *(u32x2*)(orow + 16 * vf0) = w2; }
                { const float g0 = siluf_(bf2f((bf16)(cgb.x & 0xffffu))), g1 = siluf_(bf2f((bf16)(cgb.x >> 16))), g2 = siluf_(bf2f((bf16)(cgb.y & 0xffffu))), g3 = siluf_(bf2f((bf16)(cgb.y >> 16)));
                  u32x2 w2; w2.x = pk2(ob[0] * g0, ob[1] * g1); w2.y = pk2(ob[2] * g2, ob[3] * g3); *(u32x2*)(orow + 16 * vf0 + 16) = w2; }
                ss = pg8::sum_fq(ss);
                if (fq == 0) ssqh[(t0 + l) * 64 + h * 4 + js * 2 + (wave & 1)] = ss;
            }
            if (ndk > 0) {
                Frag<2> fv[4];
#pragma unroll
                for (int vf = 0; vf < 4; ++vf) ldfrag_tr(fv[vf], VT, 72, 16 * vf, fr, fq);
#pragma unroll
                for (int d = 0; d < 2; ++d) if (d < ndk) { const int dkf = dkf0 + d;
                    Frag<2> fke; ldfrag_tr(fke, Kg, 136, 16 * dkf, fr, fq);
                    float egr[4];
#pragma unroll
                    for (int r = 0; r < 4; ++r) egr[r] = eg[16 * dkf + 4 * fq + r];
#pragma unroll
                    for (int i = 0; i < 4; ++i) {
                        sacc[d][i] = mmaf<2>(fke, fv[i], sacc[d][i]);
#pragma unroll
                        for (int r = 0; r < 4; ++r) sacc[d][i][r] *= egr[r];
                        u32x2 w; w.x = pk2(sacc[d][i][0], sacc[d][i][1]); w.y = pk2(sacc[d][i][2], sacc[d][i][3]);
                        *(LAS u32x2*)(STn + (16 * i + fr) * 136 + 16 * dkf + 4 * fq) = w; } }
            }
            __syncthreads();
        }
#undef HGRN_PREFETCH
#undef HGRN_PREFETCH_GATE
#undef HGRN_ELEMENTWISE
    }
}

template <int LAYER>
__device__ __forceinline__ void phase_attn(const Args& a, LAS unsigned char* lds, int tid, int lane, int wave, int item0, int istride) {
    unsigned char* ws = a.ws;
    constexpr int NZ = LAYER == 0 ? NA : NB, XQ = LAYER == 0 ? ZA_XQ : ZB_XQ;
    const bf16* Z = (const bf16*)(ws + WS_Z); const bf16* KV = (const bf16*)(ws + WS_KV); bf16* ycat = (bf16*)(ws + WS_YCAT);
    LAS bf16* Ks = (LAS bf16*)lds;
    LAS bf16* Vs = (LAS bf16*)(lds + 69632);
    const int fr = lane & 15, fq = lane >> 4;
    for (int q = item0; q < BATCH * XAH * 8; q += istride) {
        const int item = (q & 7) * (XAH * 8) + (q >> 3);
        const int bh = item >> 3, part = item & 7, b = bh >> 2, h = bh & 3;
        __syncthreads();
        const bf16* qp = Z + ((size_t)b * SEQ + part * 512 + 16 * wave + fr) * NZ + XQ + h * XAD + 8 * fq;
        bf16x8 aq[4], naq[4];
#pragma unroll
        for (int ks = 0; ks < 4; ++ks) aq[ks] = *(const bf16x8*)(qp + 32 * ks);
        { const bf16* kp = KV + (size_t)b * MEMLEN * 2048 + LAYER * 1024 + h * XAD; u32x4 kk[8], vv[8];
#pragma unroll
          for (int j = 0; j < 8; ++j) { const int i = tid + NTHR * j, key = i >> 4, c8 = i & 15; kk[j] = *(const u32x4*)(kp + (size_t)key * 2048 + c8 * 8); vv[j] = *(const u32x4*)(kp + (size_t)key * 2048 + 512 + c8 * 8); }
#pragma unroll
          for (int j = 0; j < 8; ++j) { const int i = tid + NTHR * j, key = i >> 4, c8 = i & 15; *(LAS u32x4*)(Ks + key * 136 + c8 * 8) = kk[j]; *(LAS u32x4*)(Vs + key * 136 + c8 * 8) = vv[j]; } }
        __syncthreads();
        for (int tile = 0; tile < 4; ++tile) {
            const size_t tq0 = (size_t)b * SEQ + part * 512 + tile * 128 + 16 * wave;
            if (tile < 3) {
#pragma unroll
                for (int ks = 0; ks < 4; ++ks) naq[ks] = *(const bf16x8*)(qp + (size_t)(tile + 1) * 128 * NZ + 32 * ks); }
            f32x4 s[16];
#pragma unroll
            for (int nf = 0; nf < 16; ++nf) { f32x4 acc = (f32x4){0.f, 0.f, 0.f, 0.f};
#pragma unroll
                for (int ks = 0; ks < 4; ++ks) { const bf16x8 bk = *(const LAS bf16x8*)(Ks + (16 * nf + fr) * 136 + 32 * ks + 8 * fq); acc = __builtin_amdgcn_mfma_f32_16x16x32_bf16(bk, aq[ks], acc, 0, 0, 0); }
                s[nf] = acc; }
            float mx = s[0][0];
#pragma unroll
            for (int nf = 0; nf < 16; ++nf)
#pragma unroll
                for (int r = 0; r < 4; ++r) mx = fmaxf(mx, s[nf][r]);
            mx = pg8::max_fq(mx);
            constexpr float SC = 0.08838834764831845f * 1.4426950408889634f;
            float sm = 0.f;
#pragma unroll
            for (int nf = 0; nf < 16; ++nf)
#pragma unroll
                for (int r = 0; r < 4; ++r) { const float p = __builtin_amdgcn_exp2f((s[nf][r] - mx) * SC); s[nf][r] = p; sm += p; }
            sm = pg8::sum_fq(sm);
            const float inv = __builtin_amdgcn_rcpf(sm);
            f32x4 o[8];
#pragma unroll
            for (int df = 0; df < 8; ++df) o[df] = (f32x4){0.f, 0.f, 0.f, 0.f};
#pragma unroll
            for (int k2 = 0; k2 < 8; ++k2) {
                const u32x4 w = (u32x4){pk2(s[2 * k2][0], s[2 * k2][1]), pk2(s[2 * k2][2], s[2 * k2][3]), pk2(s[2 * k2 + 1][0], s[2 * k2 + 1][1]), pk2(s[2 * k2 + 1][2], s[2 * k2 + 1][3])};
                const bf16x8 fp = __builtin_bit_cast(bf16x8, w);
#pragma unroll
                for (int df = 0; df < 8; ++df) { Frag<1> va; ldfrag_trp(va, Vs + 32 * k2 * 136, 136, 16 * df, fr, fq); o[df] = __builtin_amdgcn_mfma_f32_16x16x32_bf16(va.v[0], fp, o[df], 0, 0, 0); }
                __builtin_amdgcn_sched_barrier(0);
            }
            bf16* orow = ycat + (tq0 + fr) * DM + MIXW + h * XAD + 4 * fq;
#pragma unroll
            for (int df = 0; df < 8; ++df) { u32x2 w2; w2.x = pk2(o[df][0] * inv, o[df][1] * inv); w2.y = pk2(o[df][2] * inv, o[df][3] * inv); *(u32x2*)(orow + 16 * df) = w2; }
#pragma unroll
            for (int ks = 0; ks < 4; ++ks) aq[ks] = naq[ks];
        }
    }
}
template <int LAYER>
__device__ __forceinline__ void phase_norm(const Args& a, int lane, int wave) {
    unsigned char* ws = a.ws;
    bf16* ycat = (bf16*)(ws + WS_YCAT); const float* ssqh = (const float*)(ws + WS_SSQH);
    const int gw = blockIdx.x * NWAVES + wave, NGW = gridDim.x * NWAVES;
    for (int t = gw; t < T; t += NGW) {
        if (LAYER == 0) {
            float ss = ssqh[(size_t)t * 64 + lane];
            ss += __shfl_xor(ss, 1); ss += __shfl_xor(ss, 2); ss += __shfl_xor(ss, 4); ss += __shfl_xor(ss, 8);
            const float rstd = 1.0f / sqrtf(ss * (1.0f / A_DV) + EPS);
            bf16* yp = ycat + (size_t)t * DM + 24 * lane; u32x4 w[3];
#pragma unroll
            for (int j = 0; j < 3; ++j) w[j] = *(const u32x4*)(yp + 8 * j);
#pragma unroll
            for (int j = 0; j < 3; ++j) { const unsigned ww[4] = {w[j].x, w[j].y, w[j].z, w[j].w}; unsigned o[4];
#pragma unroll
                for (int e = 0; e < 4; ++e) o[e] = pk2(bf2f((bf16)(ww[e] & 0xffffu)) * rstd, bf2f((bf16)(ww[e] >> 16)) * rstd);
                *(u32x4*)(yp + 8 * j) = (u32x4){o[0], o[1], o[2], o[3]}; }
        } else {
            u32x4 w[3]; f32x4 p[3];
#pragma unroll
            for (int j = 0; j < 3; ++j) { w[j] = *(const u32x4*)(ycat + (size_t)t * DM + 8 * lane + 512 * j); p[j] = *(const f32x4*)(ssqh + (size_t)t * 64 + ((lane >> 4) + 4 * j) * 4); }
#pragma unroll
            for (int j = 0; j < 3; ++j) { const float rstd = 1.0f / sqrtf(((p[j][0] + p[j][1]) + (p[j][2] + p[j][3])) * (1.0f / B_DV) + EPS);
                const unsigned ww[4] = {w[j].x, w[j].y, w[j].z, w[j].w}; unsigned o[4];
#pragma unroll
                for (int e = 0; e < 4; ++e) o[e] = pk2(bf2f((bf16)(ww[e] & 0xffffu)) * rstd, bf2f((bf16)(ww[e] >> 16)) * rstd);
                *(u32x4*)(ycat + (size_t)t * DM + 8 * lane + 512 * j) = (u32x4){o[0], o[1], o[2], o[3]}; }
        }
    }
}

__device__ __forceinline__ void phase_ffn_fixup(const Args& a, int layer, int tid) {
    unsigned char* ws = a.ws; const bf16* side = (const bf16*)(ws + WS_SIDE); bf16* act = (bf16*)(ws + WS_Z);
    const float* cw = a.in[IN_FCW] + (size_t)layer * 3 * DFF; const float* cb = a.in[IN_FCB] + (size_t)layer * DFF;
    const int G = gridDim.x, gend = (((int)blockIdx.x & 7) + 1) * 128;
    for (int o8 = tid; o8 < DFF / 8; o8 += NTHR) { const int f = o8 * 8;
        float w0[8], w1[8], w2[8], bb[8];
        { const f32x4 x0 = *(const f32x4*)(cw + f), x1 = *(const f32x4*)(cw + f + 4), y0 = *(const f32x4*)(cw + DFF + f), y1 = *(const f32x4*)(cw + DFF + f + 4),
                      z0 = *(const f32x4*)(cw + 2 * DFF + f), z1 = *(const f32x4*)(cw + 2 * DFF + f + 4), c0 = *(const f32x4*)(cb + f), c1 = *(const f32x4*)(cb + f + 4);
#pragma unroll
          for (int e = 0; e < 4; ++e) { w0[e] = x0[e]; w0[4 + e] = x1[e]; w1[e] = y0[e]; w1[4 + e] = y1[e]; w2[e] = z0[e]; w2[4 + e] = z1[e]; bb[e] = c0[e]; bb[4 + e] = c1[e]; } }
        for (int base = ((int)blockIdx.x & 7) * 128 + ((int)blockIdx.x >> 3); base < (((int)blockIdx.x & 7) + 1) * 128; base += 4 * (G >> 3)) {
            u32x4 vg0[4], vu0[4], vg1[4], vg2[4];
#pragma unroll
            for (int k = 0; k < 4; ++k) { const int gr = base + k * (G >> 3); const u32x4 zz = (u32x4){0u, 0u, 0u, 0u}; vg0[k] = zz; vu0[k] = zz; vg1[k] = zz; vg2[k] = zz;
                if (gr < gend) { const int grp = gr >> 1, r = gr & 1; const bool start = (grp & 63) == 0;
                    const bf16* sg = side + (size_t)grp * 6 * DFF + f; const bf16* sp = sg - (size_t)6 * DFF;
                    vg0[k] = *(const u32x4*)(sg + (size_t)r * DFF); vu0[k] = *(const u32x4*)(sg + (size_t)(2 + r) * DFF);
                    if (r == 0) { if (!start) { vg1[k] = *(const u32x4*)(sp + (size_t)5 * DFF); vg2[k] = *(const u32x4*)(sp + (size_t)4 * DFF); } }
                    else { vg1[k] = *(const u32x4*)sg; if (!start) vg2[k] = *(const u32x4*)(sp + (size_t)5 * DFF); } } }
#pragma unroll
            for (int k = 0; k < 4; ++k) { const int gr = base + k * (G >> 3);
                if (gr < gend) { const int grp = gr >> 1, r = gr & 1; const int t = grp * 64 + r;
                    const unsigned a0[4] = {vg0[k].x, vg0[k].y, vg0[k].z, vg0[k].w}, au[4] = {vu0[k].x, vu0[k].y, vu0[k].z, vu0[k].w}, a1[4] = {vg1[k].x, vg1[k].y, vg1[k].z, vg1[k].w}, a2[4] = {vg2[k].x, vg2[k].y, vg2[k].z, vg2[k].w};
                    unsigned o[4];
#pragma unroll
                    for (int e = 0; e < 4; ++e) { float y[2];
#pragma unroll
                        for (int hh = 0; hh < 2; ++hh) { const int j = 2 * e + hh;
                            const float g0 = __builtin_bit_cast(float, hh ? (a0[e] & 0xffff0000u) : (a0[e] << 16)), u0 = __builtin_bit_cast(float, hh ? (au[e] & 0xffff0000u) : (au[e] << 16));
                            const float g1 = __builtin_bit_cast(float, hh ? (a1[e] & 0xffff0000u) : (a1[e] << 16)), g2 = __builtin_bit_cast(float, hh ? (a2[e] & 0xffff0000u) : (a2[e] << 16));
                            const float c = bb[j] + w0[j] * g2 + w1[j] * g1 + w2[j] * g0;
                            y[hh] = siluf_(c) * u0 * 1.4426950408889634f; }
                        o[e] = pk2(y[0], y[1]); }
                    *(u32x4*)(act + ((((size_t)(t >> 8) * 88 + (f >> 6)) * 256 + (t & 255)) << 6) + (f & 63)) = (u32x4){o[0], o[1], o[2], o[3]}; } }
        }
    }
}
__device__ __forceinline__ void phase_final_norm(const Args& a, int lane, int wave) {
    const float* ssq = (const float*)(a.ws + WS_SSQ); const float* g = a.in[IN_NOUT]; float* out = a.out; const bf16* hb = (const bf16*)(a.ws + WS_HB);
    const int bx = (int)blockIdx.x & 7, NGW = ((int)gridDim.x >> 3) * NWAVES;
    f32x4 gg[4][2];
#pragma unroll
    for (int j = 0; j < 4; ++j) { const int c8 = 8 * (lane + 64 * j); gg[j][0] = *(const f32x4*)(g + c8); gg[j][1] = *(const f32x4*)(g + c8 + 4); }
    const int rend = (bx + 1) * SEQ; int row = bx * SEQ + ((int)blockIdx.x >> 3) * NWAVES + wave;
    u32x4 w[4], nw[4]; float sp = 0.f, nsp = 0.f;
    if (row < rend) { const u32x4* hr = (const u32x4*)(hb + (size_t)row * DM) + lane;
#pragma unroll
        for (int j = 0; j < 4; ++j) w[j] = hr[64 * j];
        sp = lane < 32 ? ssq[(size_t)row * 32 + lane] : 0.f; }
    for (; row < rend; row += NGW) {
        if (row + NGW < rend) { const u32x4* hn = (const u32x4*)(hb + (size_t)(row + NGW) * DM) + lane;
#pragma unroll
            for (int j = 0; j < 4; ++j) nw[j] = hn[64 * j];
            nsp = lane < 32 ? ssq[(size_t)(row + NGW) * 32 + lane] : 0.f; }
        const float s = wave_sum(sp);
        const float rstd = 1.0f / sqrtf(s * (1.0f / DM) + EPS);
        f32x4* xr = (f32x4*)(out + (size_t)row * DM);
#pragma unroll
        for (int j = 0; j < 4; ++j) { const int c8 = 8 * (lane + 64 * j);
            f32x4 v0 = (f32x4){__builtin_bit_cast(float, w[j].x << 16), __builtin_bit_cast(float, w[j].x & 0xffff0000u), __builtin_bit_cast(float, w[j].y << 16), __builtin_bit_cast(float, w[j].y & 0xffff0000u)};
            f32x4 v1 = (f32x4){__builtin_bit_cast(float, w[j].z << 16), __builtin_bit_cast(float, w[j].z & 0xffff0000u), __builtin_bit_cast(float, w[j].w << 16), __builtin_bit_cast(float, w[j].w & 0xffff0000u)};
            xr[c8 / 4] = v0 * rstd * gg[j][0]; xr[c8 / 4 + 1] = v1 * rstd * gg[j][1]; }
#pragma unroll
        for (int j = 0; j < 4; ++j) w[j] = nw[j];
        sp = nsp;
    }
}

#define XB_TMO      128
#define XB_XCNT(j)  (256  + 64 * (j))
#define XB_XSUB(j)  (1280 + 64 * (j))
#define XB_XGEN(j)  (2304 + 64 * (j))
#define XB_TOP      3328
#define XB_TOPGEN   3392
#define XCD_BAR_WORDS 3456
#define XB_SPIN_CAP (1u << 18)

__device__ __forceinline__ unsigned xb_ld(unsigned* p)              { return __hip_atomic_load(p, __ATOMIC_RELAXED, __HIP_MEMORY_SCOPE_AGENT); }
__device__ __forceinline__ unsigned xb_add(unsigned* p, unsigned v) { return __hip_atomic_fetch_add(p, v, __ATOMIC_RELAXED, __HIP_MEMORY_SCOPE_AGENT); }
__device__ __forceinline__ unsigned xb_xcc_id() { return (unsigned)__builtin_amdgcn_s_getreg((3 << 11) | 20) & 0xFu; }
#define XB_SPIN(cond, bar) do { unsigned _sp = 0; while (cond) { __builtin_amdgcn_s_sleep(1); \
    if ((++_sp & 255u) == 0u) { if (xb_ld(&(bar)[XB_TMO])) break; if (_sp > XB_SPIN_CAP) { atomicAdd(&(bar)[XB_TMO], 1u); break; } } } } while (0)

struct XcdBarrier {
    unsigned* bar; unsigned x;
    volatile LAS unsigned* st;
};

__device__ __forceinline__ XcdBarrier xcd_barrier_post(unsigned* bar, volatile LAS unsigned* st) {
    XcdBarrier b; b.bar = bar; b.x = xb_xcc_id(); b.st = st;
    if (threadIdx.x == 0) (void)xb_add(&bar[XB_XCNT(b.x)], 1u);
    return b;
}
__device__ __forceinline__ void xcd_barrier_complete(unsigned* bar, unsigned x, unsigned& nloc, unsigned& nx) {
    const unsigned G = gridDim.x * gridDim.y * gridDim.z;
    unsigned sum, cnt, mine, sp = 0u;
    for (;;) {
        sum = 0u; cnt = 0u; mine = 0u;
#pragma unroll
        for (unsigned j = 0; j < 16; ++j) { const unsigned c = xb_ld(&bar[XB_XCNT(j)]); sum += c; cnt += (c > 0u) ? 1u : 0u; mine = (j == x) ? c : mine; }
        if (sum == G) break;
        __builtin_amdgcn_s_sleep(1);
        if ((++sp & 255u) == 0u) { if (xb_ld(&bar[XB_TMO])) break; if (sp > XB_SPIN_CAP) { atomicAdd(&bar[XB_TMO], 1u); break; } }
    }
    nloc = mine > 0u ? mine : 1u; nx = cnt > 0u ? cnt : 1u;
}

__device__ __forceinline__ void xcd_barrier(const XcdBarrier& b) {
    asm volatile("s_waitcnt vmcnt(0)" ::: "memory");
    __syncthreads();
    if (threadIdx.x == 0) {
        unsigned* bar = b.bar;
        __builtin_amdgcn_s_waitcnt(0);
        unsigned nloc = b.st[0], nx = b.st[1];
        if (nloc == 0u) { xcd_barrier_complete(bar, b.x, nloc, nx); b.st[0] = nloc; b.st[1] = nx; }
        const unsigned old = xb_add(&bar[XB_XSUB(b.x)], 1u);
        const unsigned gen = old / nloc;
        if (old + 1u == (gen + 1u) * nloc) {
            __builtin_amdgcn_fence(__ATOMIC_RELEASE, "agent");
            asm volatile("s_waitcnt vmcnt(0)" ::: "memory");
            const unsigned og = xb_add(&bar[XB_TOP], 1u);
            const unsigned tg = og / nx;
            if (og + 1u == (tg + 1u) * nx) xb_add(&bar[XB_TOPGEN], 1u);
            else XB_SPIN(xb_ld(&bar[XB_TOPGEN]) == tg, bar);
            __builtin_amdgcn_fence(__ATOMIC_ACQUIRE, "agent");
            xb_add(&bar[XB_XGEN(b.x)], 1u);
            asm volatile("s_waitcnt vmcnt(0)" ::: "memory");
        } else {
            XB_SPIN(xb_ld(&bar[XB_XGEN(b.x)]) == gen, bar);
            __builtin_amdgcn_fence(__ATOMIC_ACQUIRE, "agent");
            asm volatile("s_waitcnt vmcnt(0)" ::: "memory");
        }
    }
    __syncthreads();
}

#define GB_WORD(x) (3584 + 64 * (x))
__device__ __forceinline__ void group_barrier(unsigned* bar, volatile LAS unsigned* st) {
    asm volatile("s_waitcnt vmcnt(0)" ::: "memory");
    __syncthreads();
    if (threadIdx.x == 0) {
        __builtin_amdgcn_s_waitcnt(0);
        unsigned* ctr = bar + GB_WORD(blockIdx.x & 7u);
        const unsigned e = st[4] + 1u; st[4] = e;
        const unsigned target = e * (gridDim.x >> 3);
        __builtin_amdgcn_fence(__ATOMIC_RELEASE, "agent");
        asm volatile("s_waitcnt vmcnt(0)" ::: "memory");
        (void)xb_add(ctr, 1u);
        XB_SPIN(xb_ld(ctr) < target, bar);
        __builtin_amdgcn_fence(__ATOMIC_ACQUIRE, "agent");
        asm volatile("s_waitcnt vmcnt(0)" ::: "memory");
    }
    __syncthreads();
}

constexpr int NPHASES = 19;
typedef const Args __attribute__((address_space(4))) CArgs;
__device__ __forceinline__ void load_args(Args& a, CArgs* p) {
#pragma unroll
    for (int i = 0; i < 21; ++i) a.in[i] = p->in[i];
    a.out = p->out; a.ws = p->ws; a.ph_lo = p->ph_lo; a.ph_hi = p->ph_hi; }
__device__ __forceinline__ bool in_range(int k) { CArgs* p = (CArgs*)__builtin_amdgcn_kernarg_segment_ptr(); asm volatile("" : "+s"(p)); return p->ph_lo <= k && k < p->ph_hi; }
#define PHASE_BEGIN() CArgs* ap_ = (CArgs*)__builtin_amdgcn_kernarg_segment_ptr(); asm volatile("" : "+s"(ap_)); Args a; load_args(a, ap_); \
    int tid = threadIdx.x; asm volatile("" : "+v"(tid)); const int lane = tid & 63, wave = __builtin_amdgcn_readfirstlane(tid >> 6); unsigned char* ws = a.ws; const int G = gridDim.x; (void)lane; (void)wave; (void)ws; (void)G;
#ifdef ONLY_PH
#define IN(k) (((k) == ONLY_PH || ((k) >= 2 && (k) - 8 == ONLY_PH)) && in_range(k))
#else
#define IN(k) in_range(k)
#endif
#ifndef REPEAT_PH
#define REPEAT_PH -1
#endif
#define REP(k) for (int rep_ = 0; rep_ < 1 + (REPEAT_PH == (k) ? 1 : 0); ++rep_)
#define SEAM_IS_GRID(k) ((k) == 0 || (k) == 2 || (k) == 5 || (k) == 9 || (k) == 12)
#define SEAM(k) do { if (IN(k) && IN((k) + 1)) { if (hi > 1000) cg::this_grid().sync(); CArgs* apb_ = (CArgs*)__builtin_amdgcn_kernarg_segment_ptr(); asm volatile("" : "+s"(apb_)); \
        if (SEAM_IS_GRID(k) || gridDim.x != 256u) { XcdBarrier b_; b_.bar = (unsigned*)(apb_->ws + WS_CTL) + CW_BAR; b_.x = xb_xcc_id(); b_.st = (volatile LAS unsigned*)(lds + MISC_OFF); xcd_barrier(b_); } \
        else group_barrier((unsigned*)(apb_->ws + WS_CTL) + CW_BAR, (volatile LAS unsigned*)(lds + MISC_OFF)); } } while (0)

#ifndef STAGGER_SCALE
#define STAGGER_SCALE 0
#endif
__device__ __forceinline__ void stagger_start(int spread_us) {
    if (spread_us * STAGGER_SCALE > 0) {
        if (threadIdx.x == 0) { const unsigned b = blockIdx.x & 255u, rank = __brev(b) >> 24;
            const long long t0 = wall_clock64(), dl = (long long)rank * spread_us * STAGGER_SCALE / 256;
            while (wall_clock64() - t0 < dl) __builtin_amdgcn_s_sleep(8); }
        __syncthreads();
    }
}
template <int layer> __device__ __forceinline__ void layer_phases(LAS unsigned char* lds, const int hi) {
        const int pb = 2 + 8 * layer;
        if (IN(pb)) REP(pb) { __syncthreads();
            PHASE_BEGIN();
            const int N = layer ? NB : NA;
            stagger_start(7);
            pg8::Gemm g{(const bf16*)(ws + WS_HB), (const bf16*)(ws + (layer ? WS_WIN1 : WS_WIN0)), T, N, DM}; pg8::StaticOrder S; S.init(T, N, G, (int)blockIdx.x);
            const pg8::RstdTab rt = pg8::rstd_table_build(lds, (const float*)(ws + WS_SSQ), S, T / 256);
            if constexpr (layer == 0) { pg8::EpiScaleBf16 E{(bf16*)(ws + WS_Z), N, rt};
                pg8::gemm_phase<pg8::EpiScaleBf16, pg8::StaticOrder, PG8_ALIGN, PG8_SP2>(lds, g, S, E); }
            else { pg8::EpiZ1 E{(bf16*)(ws + WS_Z), N, rt, pg8::lb_table_build(lds, a.in[IN_BLB]), (float*)(ws + WS_G5)};
                pg8::gemm_phase<pg8::EpiZ1, pg8::StaticOrder, PG8_ALIGN, PG8_SP2>(lds, g, S, E); }
        }
        SEAM(pb);
        if (layer == 0) {
            if (IN(pb + 1)) REP(pb + 1) { __syncthreads(); PHASE_BEGIN();
                const int nkv = (TM / 256) * (2048 / 256), ngs = BATCH * A_H;
                if (G >= 2 * nkv + 2 * ngs) {
                    const int bid = (int)blockIdx.x;
                    if (bid >= G - ngs) { const int q = bid - (G - ngs); mlstm_gate_scan(a, (q & 7) * 4 + (q >> 3), lane, wave, (LAS float*)lds); }
                    else if (bid >= nkv) { const int q = bid - nkv, nper = (G - nkv - ngs) >> 3; phase_mlstm_conv(a, tid, (q & 7) * (SEQ / 16) + (q >> 3), nper, ((q & 7) + 1) * (SEQ / 16)); }
                } else {
                    for (int bh = G - 1 - (int)blockIdx.x; bh < ngs; bh += G) { __syncthreads(); mlstm_gate_scan(a, bh, lane, wave, (LAS float*)lds); }
                    phase_mlstm_conv(a, tid, (int)blockIdx.x, G, T / 16);
                }
                __syncthreads();
                pg8::Gemm g{(const bf16*)(ws + WS_MEMB), (const bf16*)(ws + WS_WKV), TM, 2048, DM}; pg8::KvOrder S{(int)blockIdx.x};
                pg8::EpiScaleBf16 E{(bf16*)(ws + WS_KV), 2048, pg8::rstd_table_build(lds, (const float*)(ws + WS_SSQM), S, TM / 256)};
                pg8::gemm_phase<pg8::EpiScaleBf16, pg8::KvOrder, PG8_ALIGN, PG8_SP2>(lds, g, S, E);
            }
            SEAM(pb + 1);
        }
        if (IN(pb + 2)) REP(pb + 2) { __syncthreads(); PHASE_BEGIN();
            if (layer == 0) phase_mlstm(a, lds, tid, lane, wave);
            else {
                phase_hgrn(a, lds, tid, lane, wave);
                const int nscan = BATCH * B_H * 2;
                if (G > nscan) { if ((int)blockIdx.x >= nscan) phase_attn<1>(a, lds, tid, lane, wave, (int)blockIdx.x - nscan, G - nscan); }
                else phase_attn<1>(a, lds, tid, lane, wave, (int)blockIdx.x, G);
            } }
        SEAM(pb + 2);
        if (layer == 0) {
            if (IN(pb + 3)) REP(pb + 3) { __syncthreads(); PHASE_BEGIN(); phase_attn<0>(a, lds, tid, lane, wave, (int)blockIdx.x, G); }
            SEAM(pb + 3);
        }
        if (IN(pb + 4)) REP(pb + 4) { __syncthreads();
            PHASE_BEGIN();
            stagger_start(0);
            pg8::Gemm g{(const bf16*)(ws + WS_YCAT), (const bf16*)(ws + (layer ? WS_WOUT1 : WS_WOUT0)), T, DM, DM}; pg8::StaticOrder S; S.init(T, DM, G, (int)blockIdx.x);
            if constexpr (layer == 0) { typedef pg8::EpiRes<false, false, true> EpiR; EpiR E{a.in[IN_X], nullptr, nullptr, (bf16*)(ws + WS_HB), (float*)(ws + WS_SSQ)};
                typedef pg8::HeadScaleHook<A_H, A_DV / 64, 16, A_DV> HK; HK hk{(const float*)(ws + WS_SSQH)};
                pg8::gemm_phase<EpiR, pg8::StaticOrder, PG8_ALIGN, PG8_SP2, HK>(lds, g, S, E, hk); }
            else { typedef pg8::EpiRes<true, false, true> EpiR; EpiR E{nullptr, (const bf16*)(ws + WS_HB), nullptr, (bf16*)(ws + WS_HB), (float*)(ws + WS_SSQ)};
                typedef pg8::HeadScaleHook<B_H, B_DV / 64, 4, B_DV> HK; HK hk{(const float*)(ws + WS_SSQH)};
                pg8::gemm_phase<EpiR, pg8::StaticOrder, PG8_ALIGN, PG8_SP2, HK>(lds, g, S, E, hk); }
        }
        SEAM(pb + 4);
        if (IN(pb + 5)) REP(pb + 5) { __syncthreads();
            PHASE_BEGIN();
            stagger_start(4);
            pg8::Gemm g{(const bf16*)(ws + WS_HB), (const bf16*)(ws + (layer ? WS_WUP1 : WS_WUP0)), T, 2 * DFF, DM}; pg8::StaticOrder S; S.init(T, 2 * DFF, G, (int)blockIdx.x);
            pg8::EpiUp E{(bf16*)(ws + WS_Z), (bf16*)(ws + WS_SIDE), pg8::rstd_table_build(lds, (const float*)(ws + WS_SSQ), S, T / 256), pg8::tap_table_build(lds, a.in[IN_FCW] + (size_t)layer * 3 * DFF, a.in[IN_FCB] + (size_t)layer * DFF, S)};
            pg8::gemm_phase<pg8::EpiUp, pg8::StaticOrder, PG8_ALIGN, PG8_SP2>(lds, g, S, E);
        }
        SEAM(pb + 5);
        if (IN(pb + 6)) REP(pb + 6) { __syncthreads(); PHASE_BEGIN(); phase_ffn_fixup(a, layer, tid); }
        SEAM(pb + 6);
        if (IN(pb + 7)) REP(pb + 7) { __syncthreads();
            PHASE_BEGIN();
            stagger_start(0);
            pg8::Gemm g{(const bf16*)(ws + WS_Z), (const bf16*)(ws + (layer ? WS_WDN1 : WS_WDN0)), T, DM, DFF}; pg8::StaticOrder S; S.init(T, DM, G, (int)blockIdx.x);
            if constexpr (layer == 0) { typedef pg8::EpiRes<true, false, true> EpiR; EpiR E{nullptr, (const bf16*)(ws + WS_HB), nullptr, (bf16*)(ws + WS_HB), (float*)(ws + WS_SSQ)};
                pg8::gemm_phase<EpiR, pg8::StaticOrder, PG8_ALIGN, PG8_SP2, pg8::NoHook, true>(lds, g, S, E); }
            else { typedef pg8::EpiRes<true, false, true> EpiR; EpiR E{nullptr, (const bf16*)(ws + WS_HB), nullptr, (bf16*)(ws + WS_HB), (float*)(ws + WS_SSQ)};
                pg8::gemm_phase<EpiR, pg8::StaticOrder, PG8_ALIGN, PG8_SP2, pg8::NoHook, true>(lds, g, S, E); }
        }
        SEAM(pb + 7);
    }
__global__ void __launch_bounds__(NTHR, 2) mk_fwd(Args a_unused) {
    extern __shared__ __attribute__((aligned(16))) unsigned char lds_raw[];
    LAS unsigned char* lds = (LAS unsigned char*)lds_raw;
    int lo, hi; unsigned* barw; { CArgs* ap0 = (CArgs*)__builtin_amdgcn_kernarg_segment_ptr(); lo = ap0->ph_lo; hi = ap0->ph_hi; barw = (unsigned*)(ap0->ws + WS_CTL) + CW_BAR; }
    volatile LAS unsigned* misc = (volatile LAS unsigned*)(lds + MISC_OFF);
    if (threadIdx.x < 16) misc[threadIdx.x] = 0u;
    __syncthreads();
    if (hi - lo > 1) (void)xcd_barrier_post(barw, misc);
    if (IN(0)) REP(0) { __syncthreads(); PHASE_BEGIN(); phase_prologue(a, lds, tid, lane, wave); }
    SEAM(0);
    layer_phases<0>(lds, hi);
    layer_phases<1>(lds, hi);
    if (IN(18)) REP(18) { __syncthreads(); PHASE_BEGIN(); phase_final_norm(a, lane, wave); }
#undef IN
#undef SEAM
}

#ifndef MK_N_LAUNCHES
#define MK_N_LAUNCHES 1
#endif
extern "C" void kernel_launch(void* const* d_in, const int* in_sizes, int n_in, void* d_out, int out_size, void* d_ws, size_t ws_size, hipStream_t stream) {
    static int grid = 0;
    if (grid == 0) {
        if (n_in != 21 || in_sizes[0] != T * DM || out_size != T * DM || ws_size < WS_END) { fprintf(stderr, "kernel_launch: unexpected sizes n_in %d in0 %d out %d ws %zu (need %zu)\n", n_in, n_in > 0 ? in_sizes[0] : -1, out_size, ws_size, (size_t)WS_END); grid = -1; return; }
        int dev = 0, cus = 0, per_cu = 0;
        if (hipGetDevice(&dev) != hipSuccess || hipDeviceGetAttribute(&cus, hipDeviceAttributeMultiprocessorCount, dev) != hipSuccess) { grid = -1; return; }
        if (hipFuncSetAttribute((const void*)mk_fwd, hipFuncAttributeMaxDynamicSharedMemorySize, LDS_BYTES) != hipSuccess) { fprintf(stderr, "kernel_launch: hipFuncSetAttribute failed\n"); grid = -1; return; }
        if (hipOccupancyMaxActiveBlocksPerMultiprocessor(&per_cu, (const void*)mk_fwd, NTHR, LDS_BYTES) != hipSuccess || per_cu < 1) { fprintf(stderr, "kernel_launch: occupancy query says %d blocks per CU\n", per_cu); (void)hipGetLastError(); grid = -1; return; }
        grid = cus;
    }
    if (grid < 0) return;
    Args a{};
    for (int i = 0; i < 21; ++i) a.in[i] = (const float*)d_in[i];
    a.out = (float*)d_out; a.ws = (unsigned char*)d_ws;
#if MK_N_LAUNCHES == 1
    if (hipMemsetAsync((char*)d_ws + WS_CTL, 0, CTL_ZERO_BYTES, stream) != hipSuccess) { fprintf(stderr, "kernel_launch: memset failed\n"); return; }
    a.ph_lo = 0; a.ph_hi = NPHASES;
    void* args[] = {&a};
    hipError_t e = hipLaunchCooperativeKernel((const void*)mk_fwd, dim3(grid), dim3(NTHR), args, LDS_BYTES, stream);
    if (e != hipSuccess) fprintf(stderr, "kernel_launch: cooperative launch failed: %s (grid %d)\n", hipGetErrorString(e), grid);
#else
    for (int p = 0; p < NPHASES; ++p) { a.ph_lo = p; a.ph_hi = p + 1; hipLaunchKernelGGL(mk_fwd, dim3(grid), dim3(NTHR), LDS_BYTES, stream, a); }
#endif
}
```
